# Optimizing an MI355X kernel written in HIP

```python
import math
import jax, jax.numpy as jnp
from jax import lax
import numpy as np

D_MODEL = 1024
BATCH = 8
SEQ = 4096
DEPTH = 2

DSWA_PATTERNS = ((128, 1), (512, 4), (2048, 16))
DSWA_GROUPS = 3
DSWA_HEADS = 4
DSWA_HEAD_DIM = 64
DSWA_BLOCK = 128
CONV_CH = 256
CONV_WIDTH = 31
GLA_HEADS = 4
GLA_DK = 64
GLA_DV = 128
GLA_GATE_RANK = 16
GLA_TAU = 16.0
GLA_CHUNK = 64
SB_HEADS = 4
SB_HEAD_DIM = 64
SB_BLOCK = 128
N_BRANCH = 4
D_FF = 4 * D_MODEL
NORM_EPS = 1e-6

A_QK = DSWA_GROUPS * DSWA_HEADS * DSWA_HEAD_DIM
A_OUT = DSWA_HEADS * DSWA_HEAD_DIM
C_QK = GLA_HEADS * GLA_DK
C_V = GLA_HEADS * GLA_DV
D_W = SB_HEADS * SB_HEAD_DIM
IN_SPLITS = (A_QK, A_QK, A_QK, 2 * CONV_CH, C_QK, C_QK, C_V, C_V, GLA_GATE_RANK, D_W, D_W, D_W, N_BRANCH * D_MODEL)
IN_WIDTH = sum(IN_SPLITS)

kernel_name = "hybrid_gated_parallel_mixer_block"


def rms_norm(x, g):
    xf = x.astype(jnp.float32)
    y = xf * lax.rsqrt(jnp.mean(xf * xf, axis=-1, keepdims=True) + NORM_EPS)
    return (y * g.astype(jnp.float32)).astype(x.dtype)


def layer_norm(x, g, b):
    xf = x.astype(jnp.float32)
    mu = jnp.mean(xf, axis=-1, keepdims=True)
    var = jnp.mean(jnp.square(xf - mu), axis=-1, keepdims=True)
    y = (xf - mu) * lax.rsqrt(var + NORM_EPS)
    return (y * g.astype(jnp.float32) + b.astype(jnp.float32)).astype(x.dtype)


def alibi_slopes(n):
    return jnp.asarray(2.0 ** (-8.0 * np.arange(1, n + 1) / n), dtype=jnp.float32)


def dilated_window_group(q, k, v, dilation, window, slopes):
    bsz, seq, nh, hd = q.shape
    span = dilation * DSWA_BLOCK
    seq_pad = -(-seq // span) * span
    pad = seq_pad - seq
    m = seq_pad // dilation
    nb = m // DSWA_BLOCK

    def to_blocks(t):
        t = jnp.pad(t, ((0, 0), (0, pad), (0, 0), (0, 0)))
        t = t.reshape(bsz, m, dilation, nh, hd).transpose(0, 2, 1, 3, 4)
        return t.reshape(bsz, dilation, nb, DSWA_BLOCK, nh, hd)

    def band(t):
        prev = jnp.pad(t, ((0, 0), (0, 0), (1, 0), (0, 0), (0, 0), (0, 0)))[:, :, :-1]
        return jnp.concatenate([prev, t], axis=3)

    qb, kb, vb = to_blocks(q), to_blocks(k), to_blocks(v)
    kk, vv = band(kb), band(vb)
    scores = jnp.einsum('bdnqhe,bdnkhe->bdnhqk', qb, kk).astype(jnp.float32) * (hd ** -0.5)
    qi = jnp.arange(DSWA_BLOCK)
    ki = jnp.arange(2 * DSWA_BLOCK) - DSWA_BLOCK
    rel = qi[:, None] - ki[None, :]
    blk = jnp.arange(nb)
    valid = ((rel >= 0) & (rel <= window // dilation))[None] & (
        (blk[:, None, None] * DSWA_BLOCK + ki[None, None, :]) >= 0)
    bias = -slopes[:, None, None] * (dilation * rel).astype(jnp.float32)
    scores = jnp.where(valid[None, None, :, None], scores + bias, -jnp.inf)
    mx = jnp.max(scores, axis=-1, keepdims=True)
    p = jnp.exp(scores - mx)
    den = jnp.sum(p, axis=-1)
    o = jnp.einsum('bdnhqk,bdnkhe->bdnqhe', p, vv.astype(jnp.float32))
    o = o / jnp.swapaxes(den, 3, 4)[..., None]
    lse = jnp.swapaxes(mx[..., 0] + jnp.log(den), 3, 4)

    def from_blocks(t):
        rest = t.shape[4:]
        t = jnp.swapaxes(t.reshape((bsz, dilation, m) + rest), 1, 2)
        return t.reshape((bsz, seq_pad) + rest)[:, :seq]

    return from_blocks(o), from_blocks(lse)


def dilated_attention_mixer(q, k, v, q_gain, k_gain):
    b, s, _ = q.shape
    shp = (b, s, DSWA_GROUPS, DSWA_HEADS, DSWA_HEAD_DIM)
    q = rms_norm(q.reshape(shp), q_gain)
    k = rms_norm(k.reshape(shp), k_gain)
    v = v.reshape(shp)
    slopes = alibi_slopes(DSWA_GROUPS * DSWA_HEADS).reshape(DSWA_GROUPS, DSWA_HEADS)
    outs, lses = [], []
    for g, (window, dilation) in enumerate(DSWA_PATTERNS):
        o, lse = dilated_window_group(q[:, :, g], k[:, :, g], v[:, :, g], dilation, window, slopes[g])
        outs.append(o)
        lses.append(lse)
    wts = jax.nn.softmax(jnp.stack(lses), axis=0)
    o = jnp.sum(wts[..., None] * jnp.stack(outs), axis=0)
    return o.reshape(b, s, A_OUT).astype(q.dtype)


def conformer_conv_mixer(u, conv_w, conv_b, ln_g, ln_b):
    a, gate = jnp.split(u, 2, axis=-1)
    y = a * jax.nn.sigmoid(gate)
    y = lax.conv_general_dilated(y, conv_w[:, None, :].astype(y.dtype), window_strides=(1,),
                                 padding=((CONV_WIDTH - 1, 0),),
                                 dimension_numbers=('NWC', 'WIO', 'NWC'),
                                 feature_group_count=CONV_CH) + conv_b
    return jax.nn.silu(layer_norm(y, ln_g, ln_b))


def gla_mixer(q, k, v, r, g_low, w_gate, b_gate, o_gain):
    f32 = jnp.float32
    b, s, _ = q.shape
    n = s // GLA_CHUNK
    log_a = jax.nn.log_sigmoid((g_low @ w_gate + b_gate).astype(f32)) / GLA_TAU

    def chunks(t, e):
        return t.reshape(b, n, GLA_CHUNK, GLA_HEADS, e).transpose(1, 0, 3, 2, 4)

    qc = chunks(q.astype(f32) * (GLA_DK ** -0.5), GLA_DK)
    kc = chunks(k.astype(f32), GLA_DK)
    vc = chunks(v.astype(f32), GLA_DV)
    gc = chunks(log_a, GLA_DK)
    causal = jnp.tril(jnp.ones((GLA_CHUNK, GLA_CHUNK), dtype=bool))

    def step(state, xs):
        qt, kt, vt, gt = xs
        cum = jnp.cumsum(gt, axis=2)
        o_inter = jnp.einsum('bhtk,bhkv->bhtv', qt * jnp.exp(cum), state)
        diff = cum[:, :, :, None, :] - cum[:, :, None, :, :]
        decay = jnp.exp(jnp.where(causal[:, :, None], diff, -jnp.inf))
        att = jnp.einsum('bhtk,bhsk,bhtsk->bhts', qt, kt, decay)
        o = o_inter + jnp.einsum('bhts,bhsv->bhtv', att, vt)
        last = cum[:, :, -1:, :]
        state = jnp.exp(last[:, :, 0, :, None]) * state + jnp.einsum(
            'bhsk,bhsv->bhkv', kt * jnp.exp(last - cum), vt)
        return state, o

    state0 = jnp.zeros((b, GLA_HEADS, GLA_DK, GLA_DV), f32)
    _, o = lax.scan(step, state0, (qc, kc, vc, gc))
    o = o.transpose(1, 0, 3, 2, 4).reshape(b, s, GLA_HEADS, GLA_DV)
    o = rms_norm(o, o_gain).reshape(b, s, C_V)
    return (jax.nn.silu(r.astype(f32)) * o).astype(q.dtype)


def stick_breaking_mixer(q, k, v):
    f32 = jnp.float32
    b, s, _ = q.shape

    def heads(t):
        return t.reshape(b, s, SB_HEADS, SB_HEAD_DIM).transpose(0, 2, 1, 3)

    q, k, v = heads(q), heads(k), heads(v)
    vf = v.astype(f32)
    nb = s // SB_BLOCK
    q_blocks = q.reshape(b, SB_HEADS, nb, SB_BLOCK, SB_HEAD_DIM).transpose(2, 0, 1, 3, 4)
    key_pos = jnp.arange(s)
    scale = SB_HEAD_DIM ** -0.5

    def block(args):
        qb, i = args
        z = jnp.einsum('bhqe,bhke->bhqk', qb, k).astype(f32) * scale
        q_pos = i * SB_BLOCK + jnp.arange(SB_BLOCK)
        mask = key_pos[None, :] < q_pos[:, None]
        log_keep = jnp.where(mask, jax.nn.log_sigmoid(-z), 0.0)
        after = lax.cumsum(log_keep, axis=3, reverse=True) - log_keep
        w = jnp.where(mask, jnp.exp(jax.nn.log_sigmoid(z) + after), 0.0)
        return jnp.einsum('bhqk,bhke->bhqe', w, vf)

    o = lax.map(block, (q_blocks, jnp.arange(nb)))
    return o.transpose(1, 0, 3, 2, 4).reshape(b, s, D_W).astype(q.dtype)


def setup_inputs(seed: int = 0) -> dict:
    key = jax.random.key(seed)
    ks = jax.random.split(key, 26)
    L, D = DEPTH, D_MODEL

    def nrm(k, shape, scale):
        return jax.random.normal(k, shape, jnp.float32) * scale

    def gain(k, shape):
        return 1.0 + nrm(k, shape, 0.05)

    return {
        "x": nrm(ks[0], (BATCH, SEQ, D), 1.0),
        "c": nrm(ks[1], (BATCH, D), 1.0),
        "w_ada": nrm(ks[2], (L, D, 6 * D), 0.5 * D ** -0.5),
        "b_ada": nrm(ks[3], (L, 6 * D), 0.02),
        "g_mix": gain(ks[4], (L, D)),
        "w_in": nrm(ks[5], (L, D, IN_WIDTH), D ** -0.5),
        "q_gain": gain(ks[6], (L, DSWA_HEAD_DIM)),
        "k_gain": gain(ks[7], (L, DSWA_HEAD_DIM)),
        "conv_w": nrm(ks[8], (L, CONV_WIDTH, CONV_CH), CONV_WIDTH ** -0.5),
        "conv_b": nrm(ks[9], (L, CONV_CH), 0.02),
        "conv_ln_g": gain(ks[10], (L, CONV_CH)),
        "conv_ln_b": nrm(ks[11], (L, CONV_CH), 0.02),
        "gla_w_gate": nrm(ks[12], (L, GLA_GATE_RANK, C_QK), GLA_GATE_RANK ** -0.5),
        "gla_b_gate": nrm(ks[13], (L, C_QK), 0.1),
        "gla_o_gain": gain(ks[14], (L, GLA_DV)),
        "w_br_a": nrm(ks[15], (L, A_OUT, D), A_OUT ** -0.5),
        "w_br_b": nrm(ks[16], (L, CONV_CH, D), CONV_CH ** -0.5),
        "w_br_c": nrm(ks[17], (L, C_V, D), C_V ** -0.5),
        "w_br_d": nrm(ks[18], (L, D_W, D), D_W ** -0.5),
        "w_out": nrm(ks[19], (L, D, D), D ** -0.5),
        "g_mlp": gain(ks[20], (L, D)),
        "w_up": nrm(ks[21], (L, D, D_FF), D ** -0.5),
        "w_down": nrm(ks[22], (L, D_FF, D), D_FF ** -0.5),
    }


def reference(x, c, w_ada, b_ada, g_mix, w_in, q_gain, k_gain, conv_w, conv_b, conv_ln_g, conv_ln_b,
              gla_w_gate, gla_b_gate, gla_o_gain, w_br_a, w_br_b, w_br_c, w_br_d, w_out,
              g_mlp, w_up, w_down):
    bsz, seq, _ = x.shape
    split_points = np.cumsum(IN_SPLITS)[:-1].tolist()
    for l in range(DEPTH):
        mod = (c @ w_ada[l] + b_ada[l])[:, None, :]
        sh1, sc1, gt1, sh2, sc2, gt2 = jnp.split(mod, 6, axis=-1)

        h = rms_norm(x, g_mix[l]) * (1.0 + sc1) + sh1
        (a_q, a_k, a_v, conv_in, c_q, c_k, c_v, c_r, c_low,
         d_q, d_k, d_v, gate_logits) = jnp.split(h @ w_in[l], split_points, axis=-1)

        y_a = dilated_attention_mixer(a_q, a_k, a_v, q_gain[l], k_gain[l]) @ w_br_a[l]
        y_b = conformer_conv_mixer(conv_in, conv_w[l], conv_b[l], conv_ln_g[l], conv_ln_b[l]) @ w_br_b[l]
        y_c = gla_mixer(c_q, c_k, c_v, c_r, c_low, gla_w_gate[l], gla_b_gate[l], gla_o_gain[l]) @ w_br_c[l]
        y_d = stick_breaking_mixer(d_q, d_k, d_v) @ w_br_d[l]

        gates = jax.nn.sigmoid(gate_logits).reshape(bsz, seq, N_BRANCH, D_MODEL)
        merged = (gates[:, :, 0] * y_a + gates[:, :, 1] * y_b
                  + gates[:, :, 2] * y_c + gates[:, :, 3] * y_d)
        x = x + gt1 * (merged @ w_out[l])

        h = rms_norm(x, g_mlp[l]) * (1.0 + sc2) + sh2
        x = x + gt2 * (jnp.square(jax.nn.relu(h @ w_up[l])) @ w_down[l])
    return x
```

```cpp
#include <hip/hip_runtime.h>
#include <hip/hip_bf16.h>
#include <hip/hip_cooperative_groups.h>
#include <cstdio>
namespace cg = cooperative_groups;

#define DEVI __device__ __forceinline__
typedef unsigned short u16;
using bf16x8 = __attribute__((ext_vector_type(8))) short;
using bf16x4 = __attribute__((ext_vector_type(4))) short;
using f32x4 = __attribute__((ext_vector_type(4))) float;

constexpr int DM = 1024, NB = 8, SEQ = 4096, MTOK = NB * SEQ, NL = 2;
constexpr int MH = MTOK / 2;
constexpr int INW = 9232;
constexpr int NPROJ = 9216;
constexpr int OFF_AQ = 0, OFF_AK = 768, OFF_AV = 1536, OFF_CONV = 2304, OFF_CQ = 2816, OFF_CK = 3072, OFF_CV = 3328,
              OFF_CR = 3840, OFF_DQ = 4352, OFF_DK = 4608, OFF_DV = 4864, OFF_GATE = 5120;
constexpr int BRW = 1280;
constexpr float EPS = 1e-6f;

constexpr size_t WT_IN = 0, WT_BR = (size_t)NPROJ * 1024, WT_OUT = WT_BR + 1024 * 1280, WT_UP = WT_OUT + 1024 * 1024,
                 WT_DOWN = WT_UP + 4096 * 1024, WT_LOW = WT_DOWN + 1024 * 4096, WT_L = WT_LOW + 16 * 1024;
constexpr size_t O_WT = 0;
constexpr size_t O_MODP = O_WT + 2 * WT_L * 2;
constexpr size_t O_MODF = O_MODP + (size_t)2 * 16 * 8 * 6144 * 4;
constexpr size_t O_LSE = O_MODF + (size_t)2 * 8 * 6144 * 4;
constexpr size_t O_GDEC = O_LSE + (size_t)MH * 12 * 4;
constexpr size_t O_H = O_GDEC + (size_t)1024 * 64 * 4;
constexpr size_t O_PROJ = O_H + (size_t)MH * 1024 * 2;
constexpr size_t O_BR = O_PROJ + (size_t)MH * NPROJ * 2;
constexpr size_t O_S = O_BR + (size_t)MH * BRW * 2;
constexpr size_t O_BAR = O_S + (size_t)1024 * 8192 * 4;
constexpr size_t O_C0 = O_BAR + 16384;
constexpr size_t O_GLOW = O_C0 + (size_t)16 * 2 * 16 * 64 * 4;
constexpr size_t WS_END = O_GLOW + (size_t)MH * 256 * 4;

constexpr int LDS_BYTES = 131072 + 16;
#ifndef PROBE
#define PROBE 0
#endif
#define PREP(bit) for (int _rep = 0; _rep < (((PROBE) >> (bit)) & 1) + 1; ++_rep)

struct Params {
  const float *x, *c, *w_ada, *b_ada, *g_mix, *w_in, *q_gain, *k_gain, *conv_w, *conv_b, *conv_ln_g, *conv_ln_b,
      *gla_w_gate, *gla_b_gate, *gla_o_gain, *w_br_a, *w_br_b, *w_br_c, *w_br_d, *w_out, *g_mlp, *w_up, *w_down;
  float* out;
  unsigned char* ws;
};

template <int OFF> DEVI const void* kptr() {
  unsigned long long r;
  auto ka = __builtin_amdgcn_kernarg_segment_ptr();
  asm volatile("s_load_dwordx2 %0, %1, %2\n\ts_waitcnt lgkmcnt(0)" : "=s"(r) : "s"(ka), "i"(OFF) : "memory");
  return (const void*)(__attribute__((address_space(1))) const void*)r;
}
#define KP(field) ((const float*)kptr<(int)offsetof(Params, field)>())
#define KWS() ((unsigned char*)kptr<(int)offsetof(Params, ws)>())
#define KOUT() ((float*)kptr<(int)offsetof(Params, out)>())

DEVI int otid(int wv) { int z = 0; asm volatile("" : "+v"(z)); int lane = __builtin_amdgcn_mbcnt_hi(-1, __builtin_amdgcn_mbcnt_lo(-1, z)); return wv * 64 + lane; }
DEVI int oblk() { int b = blockIdx.x; asm volatile("" : "+s"(b)); return b; }
DEVI int ogrd() { int g = gridDim.x; asm volatile("" : "+s"(g)); return g; }

DEVI float shfl_l(float v, int src) { return __int_as_float(__builtin_amdgcn_ds_bpermute(src << 2, __float_as_int(v))); }
DEVI float shfl_xor_l(float v, int k, int lane) { return shfl_l(v, lane ^ k); }
DEVI float shfl_up_l(float v, int d, int lane) { return shfl_l(v, lane >= d ? lane - d : lane); }

DEVI u16 f2bf(float f) { unsigned r; asm("v_cvt_pk_bf16_f32 %0, %1, %1" : "=v"(r) : "v"(f)); return (u16)(r & 0xffffu); }
DEVI float bf2f(u16 h) { return __uint_as_float(((unsigned)h) << 16); }
DEVI unsigned pk2(float a, float b) { unsigned r; asm("v_cvt_pk_bf16_f32 %0, %1, %2" : "=v"(r) : "v"(a), "v"(b)); return r; }
DEVI unsigned pk2_sw(float a, float b) {
  unsigned ua = __float_as_uint(a), ub = __float_as_uint(b);
  ua += 0x7fffu + ((ua >> 16) & 1u); ub += 0x7fffu + ((ub >> 16) & 1u);
  return (ua >> 16) | (ub & 0xffff0000u);
}
DEVI float bflo(unsigned u) { return __uint_as_float(u << 16); }
DEVI float bfhi(unsigned u) { return __uint_as_float(u & 0xffff0000u); }
DEVI float sigmoidf_(float x) { return 1.f / (1.f + __expf(-x)); }
DEVI float logsigf_(float z) { return fminf(z, 0.f) - __logf(1.f + __expf(-fabsf(z))); }
typedef unsigned u32x4_t __attribute__((ext_vector_type(4)));
DEVI bf16x8 mk8(uint2 lo, uint2 hi) { u32x4_t v = {lo.x, lo.y, hi.x, hi.y}; return __builtin_bit_cast(bf16x8, v); }
DEVI f32x4 mfma16(bf16x8 a, bf16x8 b, f32x4 c) { return __builtin_amdgcn_mfma_f32_16x16x32_bf16(a, b, c, 0, 0, 0); }

constexpr int BM = 256, BK = 64, HALF = 128, HT = HALF * BK;

DEVI int lds_byte(int r, int c) {
  int st = (r >> 4) * 2 + (c >> 5), rr = r & 15, cc = c & 31, ob = rr * 64 + cc * 2;
  return st * 1024 + (ob ^ (((ob >> 9) & 1) << 5));
}
DEVI void stage_rc(int b, int& R, int& C) {
  int st = b / 1024, sb = b % 1024, swz = sb ^ (((sb >> 9) & 1) << 5);
  R = (st >> 1) * 16 + swz / 64; C = (st & 1) * 32 + (swz % 64) / 2;
}

#define G_SA(b, h) (shm + ((b) * 2 + (h)) * HT)
#define G_SB(b, h) (shm + (4 + (b) * 2 + (h)) * HT)
#define G_STAGE(P, BASE, LD, br, kt) do { const u16* _p = (BASE) + (size_t)(br) * (size_t)(LD) + (size_t)(kt) * BK; \
    __builtin_amdgcn_global_load_lds((const unsigned*)(_p + soff0), (unsigned*)((char*)(P) + tid * 16), 16, 0, 0); \
    __builtin_amdgcn_global_load_lds((const unsigned*)(_p + soff1), (unsigned*)((char*)(P) + tid * 16 + 8192), 16, 0, 0); } while (0)
#define G_LDA(dst, b, h) for (int m = 0; m < 4; ++m) for (int k = 0; k < 2; ++k) \
    dst[m][k] = *reinterpret_cast<const bf16x8*>((char*)G_SA(b, h) + lds_byte(wr * 64 + m * 16 + fr, k * 32 + fq * 8))
#define G_LDB(dst, b, h) for (int n = 0; n < 2; ++n) for (int k = 0; k < 2; ++k) \
    dst[n][k] = *reinterpret_cast<const bf16x8*>((char*)G_SB(b, h) + ldsb_base + n * 256 + k * 1024)
#define G_MMA(ai, bj, At, Bf) do { __builtin_amdgcn_s_setprio(1); \
    for (int m = 0; m < 4; ++m) for (int n = 0; n < 2; ++n) for (int k = 0; k < 2; ++k) \
      acc[ai][bj][m][n] = __builtin_amdgcn_mfma_f32_16x16x32_bf16(Bf[n][k], At[m][k], acc[ai][bj][m][n], 0, 0, 0); \
    __builtin_amdgcn_s_setprio(0); } while (0)
#define G_WAIT_V(n) asm volatile("s_waitcnt vmcnt(" #n ")" ::: "memory")
#define G_WAIT_L(n) asm volatile("s_waitcnt lgkmcnt(" #n ")" ::: "memory")
#define G_BAR __builtin_amdgcn_s_barrier()
#define G_SCHED __builtin_amdgcn_sched_barrier(0)

template <int LD, class Epi>
DEVI void gemm_tile(int wv, u16* shm, const u16* A, const u16* Bt, int K, int brow, int bcol, const Epi& epi,
                    bool pre, bool has_next, int nshift, int nbrow, int nbcol) {
  constexpr int lda = LD, ldb = LD;
  const u16* nA = A + nshift; const u16* nB = Bt + nshift;
  const int tid = otid(wv);
  int wid = tid >> 6, lane = tid & 63, wr = wid >> 2, wc = wid & 3, fr = lane & 15, fq = lane >> 4;
  const int ldsb_base = lds_byte(wc * 32 + 8 * (fr >> 2) + (fr & 3), fq * 8);
  f32x4 acc[2][2][4][2] = {};
  bf16x8 At[4][2], B0[2][2], B1[2][2];
  int nt = K / BK;
  unsigned soff0, soff1;
  { int _r, _c; stage_rc(tid * 16, _r, _c); soff0 = (unsigned)(_r * lda + _c); stage_rc(tid * 16 + 8192, _r, _c); soff1 = (unsigned)(_r * lda + _c); }
  if (!pre) {
    G_STAGE(G_SB(0, 0), Bt, ldb, bcol, 0); G_STAGE(G_SA(0, 0), A, lda, brow, 0);
    G_STAGE(G_SB(0, 1), Bt, ldb, bcol + HALF, 0); G_STAGE(G_SA(0, 1), A, lda, brow + HALF, 0);
  }
  if (wr == 1) G_BAR;
  if (pre) { if (Epi::NSTORE == 32) { G_WAIT_V(36); } else { G_WAIT_V(20); } } else { G_WAIT_V(4); } G_BAR;
  G_STAGE(G_SB(1, 0), Bt, ldb, bcol, 1); G_STAGE(G_SA(1, 0), A, lda, brow, 1); G_STAGE(G_SB(1, 1), Bt, ldb, bcol + HALF, 1);
  if (pre) { if (Epi::NSTORE == 32) { G_WAIT_V(38); } else { G_WAIT_V(22); } } else { G_WAIT_V(6); } G_BAR;
  for (int t = 0; t < nt - 2; t += 2) {
    G_LDB(B0, 0, 0); G_SCHED; G_LDA(At, 0, 0); G_STAGE(G_SA(1, 1), A, lda, brow + HALF, t + 1);
    G_WAIT_L(8); G_BAR; G_WAIT_L(0); G_MMA(0, 0, At, B0); G_BAR; G_SCHED;
    G_LDB(B1, 0, 1); G_STAGE(G_SB(0, 0), Bt, ldb, bcol, t + 2);
    G_BAR; G_WAIT_L(0); G_MMA(0, 1, At, B1); G_BAR;
    G_LDA(At, 0, 1); G_STAGE(G_SA(0, 0), A, lda, brow, t + 2);
    G_BAR; G_WAIT_L(0); G_MMA(1, 0, At, B0); G_BAR; G_SCHED;
    G_STAGE(G_SB(0, 1), Bt, ldb, bcol + HALF, t + 2);
    G_WAIT_V(6); G_BAR; G_MMA(1, 1, At, B1); G_BAR;
    G_LDB(B0, 1, 0); G_SCHED; G_LDA(At, 1, 0); G_STAGE(G_SA(0, 1), A, lda, brow + HALF, t + 2);
    G_WAIT_L(8); G_BAR; G_WAIT_L(0); G_MMA(0, 0, At, B0); G_BAR; G_SCHED;
    G_LDB(B1, 1, 1); G_STAGE(G_SB(1, 0), Bt, ldb, bcol, t + 3);
    G_BAR; G_WAIT_L(0); G_MMA(0, 1, At, B1); G_BAR;
    G_LDA(At, 1, 1); G_STAGE(G_SA(1, 0), A, lda, brow, t + 3);
    G_BAR; G_WAIT_L(0); G_MMA(1, 0, At, B0); G_BAR; G_SCHED;
    G_STAGE(G_SB(1, 1), Bt, ldb, bcol + HALF, t + 3);
    G_WAIT_V(6); G_BAR; G_MMA(1, 1, At, B1); G_BAR;
  }
  { G_LDB(B0, 0, 0); G_LDA(At, 0, 0); G_STAGE(G_SA(1, 1), A, lda, brow + HALF, nt - 1);
    G_BAR; G_WAIT_L(0); G_MMA(0, 0, At, B0); G_BAR;
    G_LDB(B1, 0, 1); G_BAR; G_WAIT_L(0); G_MMA(0, 1, At, B1); G_BAR;
    G_LDA(At, 0, 1); G_WAIT_V(4); G_BAR; G_WAIT_L(0); G_MMA(1, 0, At, B0); G_MMA(1, 1, At, B1); G_BAR; }
  { G_LDB(B0, 1, 0); G_LDA(At, 1, 0); G_WAIT_V(2); G_BAR;
    if (has_next) {
      G_STAGE(G_SB(0, 0), nB, ldb, nbcol, 0); G_STAGE(G_SA(0, 0), nA, lda, nbrow, 0);
      G_STAGE(G_SB(0, 1), nB, ldb, nbcol + HALF, 0); G_STAGE(G_SA(0, 1), nA, lda, nbrow + HALF, 0);
    }
    G_WAIT_L(0); G_MMA(0, 0, At, B0); G_BAR;
    G_LDB(B1, 1, 1); if (has_next) { G_WAIT_V(8); } else { G_WAIT_V(0); } G_BAR; G_WAIT_L(0); G_MMA(0, 1, At, B1); G_BAR;
    G_LDA(At, 1, 1); G_BAR; G_WAIT_L(0); G_MMA(1, 0, At, B0); G_MMA(1, 1, At, B1); G_BAR; }
  if (wr == 0) G_BAR;
  epi(acc, brow, bcol, wr, wc, fr, fq);
}

struct EpiBf16 {
  static constexpr int NSTORE = 16;
  u16* C; int ldc; int relu2;
  DEVI void operator()(const f32x4 (&acc)[2][2][4][2], int brow, int bcol, int wr, int wc, int fr, int fq) const {
#pragma unroll
    for (int ai = 0; ai < 2; ++ai)
#pragma unroll
      for (int bj = 0; bj < 2; ++bj)
#pragma unroll
        for (int m = 0; m < 4; ++m) {
          int row = brow + ai * HALF + wr * 64 + m * 16 + fr, col = bcol + bj * HALF + wc * 32 + fq * 8;
          f32x4 v0 = acc[ai][bj][m][0], v1 = acc[ai][bj][m][1];
          if (relu2) {
#pragma unroll
            for (int j = 0; j < 4; ++j) { float t0 = fmaxf(v0[j], 0.f), t1 = fmaxf(v1[j], 0.f); v0[j] = t0 * t0; v1[j] = t1 * t1; }
          }
          uint4 o; o.x = pk2(v0[0], v0[1]); o.y = pk2(v0[2], v0[3]); o.z = pk2(v1[0], v1[1]); o.w = pk2(v1[2], v1[3]);
          *(uint4*)(C + (size_t)row * ldc + col) = o;
        }
  }
};
struct EpiGate {
  const u16* G; int gcol0; u16* Mg; int first;
  DEVI void operator()(const f32x4 (&acc)[2][2][4][2], int brow, int bcol, int wr, int wc, int fr, int fq) const {
#pragma unroll
    for (int ai = 0; ai < 2; ++ai)
#pragma unroll
      for (int bj = 0; bj < 2; ++bj)
#pragma unroll
      for (int mh = 0; mh < 2; ++mh) {
        uint2 g[4][2], o[4][2];
#pragma unroll
        for (int m = 2 * mh; m < 2 * mh + 2; ++m)
#pragma unroll
          for (int n = 0; n < 2; ++n) {
            int row = brow + ai * HALF + wr * 64 + m * 16 + fr, col = bcol + bj * HALF + wc * 32 + n * 16 + fq * 4;
            g[m][n] = *(const uint2*)(G + (size_t)row * NPROJ + gcol0 + col);
            if (!first) o[m][n] = *(const uint2*)(Mg + (size_t)row * 1024 + col);
          }
#pragma unroll
        for (int m = 2 * mh; m < 2 * mh + 2; ++m)
#pragma unroll
          for (int n = 0; n < 2; ++n) {
            int row = brow + ai * HALF + wr * 64 + m * 16 + fr, col = bcol + bj * HALF + wc * 32 + n * 16 + fq * 4;
            f32x4 v = acc[ai][bj][m][n];
            float r0 = v[0] * sigmoidf_(bflo(g[m][n].x)), r1 = v[1] * sigmoidf_(bfhi(g[m][n].x)), r2 = v[2] * sigmoidf_(bflo(g[m][n].y)), r3 = v[3] * sigmoidf_(bfhi(g[m][n].y));
            if (!first) { r0 += bflo(o[m][n].x); r1 += bfhi(o[m][n].x); r2 += bflo(o[m][n].y); r3 += bfhi(o[m][n].y); }
            uint2 o2; o2.x = pk2(r0, r1); o2.y = pk2(r2, r3);
            *(uint2*)(Mg + (size_t)row * 1024 + col) = o2;
          }
      }
  }
};
struct EpiRes {
  const float* xin; float* xout; const float* gate; int row0;
  static constexpr int NSTORE = 32;
  DEVI void load_batch(int q, float4 (&xi)[2][2], int brow, int bcol, int wr, int wc, int fr, int fq) const {
    const int ai = q >> 2, bj = (q >> 1) & 1, mh = q & 1, col = bcol + bj * HALF + wc * 32 + fq * 8;
#pragma unroll
    for (int mm = 0; mm < 2; ++mm) {
      const int row = row0 + brow + ai * HALF + wr * 64 + (2 * mh + mm) * 16 + fr;
      xi[mm][0] = *(const float4*)(xin + (size_t)row * 1024 + col); xi[mm][1] = *(const float4*)(xin + (size_t)row * 1024 + col + 4);
    }
  }
  DEVI void operator()(const f32x4 (&acc)[2][2][4][2], int brow, int bcol, int wr, int wc, int fr, int fq) const {
    const int b = (row0 + brow) >> 12;
    float4 gt[2][2];
#pragma unroll
    for (int bj = 0; bj < 2; ++bj) {
      const int col = bcol + bj * HALF + wc * 32 + fq * 8;
      gt[bj][0] = *(const float4*)(gate + (size_t)b * 6144 + col); gt[bj][1] = *(const float4*)(gate + (size_t)b * 6144 + col + 4);
    }
    float4 xa[2][2], xb[2][2];
    load_batch(0, xa, brow, bcol, wr, wc, fr, fq);
#pragma unroll
    for (int q = 0; q < 8; ++q) {
      const int ai = q >> 2, bj = (q >> 1) & 1, mh = q & 1, col = bcol + bj * HALF + wc * 32 + fq * 8;
      if (q + 1 < 8) { if (q & 1) load_batch(q + 1, xa, brow, bcol, wr, wc, fr, fq); else load_batch(q + 1, xb, brow, bcol, wr, wc, fr, fq); }
#pragma unroll
      for (int mm = 0; mm < 2; ++mm) {
        const int row = row0 + brow + ai * HALF + wr * 64 + (2 * mh + mm) * 16 + fr;
#pragma unroll
        for (int n = 0; n < 2; ++n) {
          const f32x4 v = acc[ai][bj][2 * mh + mm][n];
          const float4 xv = (q & 1) ? xb[mm][n] : xa[mm][n];
          float4 o; o.x = xv.x + gt[bj][n].x * v[0]; o.y = xv.y + gt[bj][n].y * v[1]; o.z = xv.z + gt[bj][n].z * v[2]; o.w = xv.w + gt[bj][n].w * v[3];
          *(float4*)(xout + (size_t)row * 1024 + col + 4 * n) = o;
        }
      }
    }
  }
};

template <int LD, class Epi>
DEVI void gemm_phase(int wv, u16* shm, const u16* A, const u16* Bt, int Mrows, int N, int K, const Epi& epi) {
  int nM = Mrows / BM, nN = N / BM, ntiles = nM * nN;
  int G = ogrd(), b = oblk();
  int vb = (G % 8 == 0) ? (b % 8) * (G / 8) + b / 8 : b;
  const int nig = 8 * nN;
  bool pre = false;
  for (int base = 0; base < ntiles; base += G) {
    int id = base + vb;
    if (id >= ntiles) break;
    int gid = id / nig, rem = id % nig, pm = gid * 8 + rem % 8, pn = rem / 8;
    int nid = id + G; bool has_next = nid < ntiles;
    int ngid = nid / nig, nrem = nid % nig, npm = ngid * 8 + nrem % 8, npn = nrem / 8;
    gemm_tile<LD>(wv, shm, A, Bt, K, pm * BM, pn * BM, epi, pre, has_next, 0, npm * BM, npn * BM);
    pre = has_next;
    if (has_next) { G_BAR; } else { __syncthreads(); }
  }
}

#define BR_LDB(dst, b, h) for (int n = 0; n < 2; ++n) for (int k = 0; k < 2; ++k) \
    dst[n][k] = *reinterpret_cast<const bf16x8*>((char*)G_SB(b, h) + ldsb_base + n * 256 + k * 1024)
DEVI void branch_phase(int wv, u16* shm, const u16* br, const u16* WbrT, const u16* G, u16* Mg) {
  const int tid = otid(wv);
  const int wid = tid >> 6, lane = tid & 63, wr = wid >> 2, wc = wid & 3, fr = lane & 15, fq = lane >> 4;
  constexpr int lda = BRW, ldb = BRW;
  unsigned soff0, soff1;
  { int _r, _c; stage_rc(tid * 16, _r, _c); soff0 = (unsigned)(_r * BRW + _c); stage_rc(tid * 16 + 8192, _r, _c); soff1 = (unsigned)(_r * BRW + _c); }
  const unsigned goff = (unsigned)((wr * 64 + fr) * NPROJ + wc * 32 + fq * 8), moff = (unsigned)((wr * 64 + fr) * 1024 + wc * 32 + fq * 8);
  const int ldsb_base = lds_byte(wc * 32 + 8 * (fr >> 2) + (fr & 3), fq * 8);
  const int Gd = ogrd();
  for (int tile = oblk(); tile < (MH / 128) * 4; tile += Gd) {
    const int pm = tile >> 2, pn = tile & 3, brow = pm * 128, bcol = pn * 256;
    f32x4 mg[2][4][2];
#pragma unroll
    for (int bj = 0; bj < 2; ++bj)
#pragma unroll
      for (int m = 0; m < 4; ++m)
#pragma unroll
        for (int n = 0; n < 2; ++n) mg[bj][m][n] = (f32x4){0.f, 0.f, 0.f, 0.f};
    for (int i = 0; i < 4; ++i) {
      const int koff = (i == 3) ? 1024 : i * 256, nt = (i == 2) ? 8 : 4;
      const u16* A = br + koff; const u16* Bt = WbrT + koff;
      f32x4 acc[2][4][2];
#pragma unroll
      for (int bj = 0; bj < 2; ++bj)
#pragma unroll
        for (int m = 0; m < 4; ++m)
#pragma unroll
          for (int n = 0; n < 2; ++n) acc[bj][m][n] = (f32x4){0.f, 0.f, 0.f, 0.f};
      G_STAGE(G_SA(0, 0), A, lda, brow, 0); G_STAGE(G_SB(0, 0), Bt, ldb, bcol, 0); G_STAGE(G_SB(0, 1), Bt, ldb, bcol + HALF, 0);
      for (int kt = 0; kt < nt; ++kt) {
        const int b = kt & 1;
        if (kt + 1 < nt) {
          if (b) { G_STAGE(G_SA(0, 0), A, lda, brow, kt + 1); G_STAGE(G_SB(0, 0), Bt, ldb, bcol, kt + 1); G_STAGE(G_SB(0, 1), Bt, ldb, bcol + HALF, kt + 1); }
          else   { G_STAGE(G_SA(1, 0), A, lda, brow, kt + 1); G_STAGE(G_SB(1, 0), Bt, ldb, bcol, kt + 1); G_STAGE(G_SB(1, 1), Bt, ldb, bcol + HALF, kt + 1); }
          G_WAIT_V(6);
        } else { G_WAIT_V(0); }
        G_BAR;
        bf16x8 At[4][2], B0[2][2];
        if (b) { G_LDA(At, 1, 0); BR_LDB(B0, 1, 0); } else { G_LDA(At, 0, 0); BR_LDB(B0, 0, 0); }
        G_WAIT_L(0);
        __builtin_amdgcn_s_setprio(1);
#pragma unroll
        for (int m = 0; m < 4; ++m)
#pragma unroll
          for (int n = 0; n < 2; ++n)
#pragma unroll
            for (int k = 0; k < 2; ++k) acc[0][m][n] = __builtin_amdgcn_mfma_f32_16x16x32_bf16(B0[n][k], At[m][k], acc[0][m][n], 0, 0, 0);
        __builtin_amdgcn_s_setprio(0);
        if (b) { BR_LDB(B0, 1, 1); } else { BR_LDB(B0, 0, 1); }
        G_WAIT_L(0);
        __builtin_amdgcn_s_setprio(1);
#pragma unroll
        for (int m = 0; m < 4; ++m)
#pragma unroll
          for (int n = 0; n < 2; ++n)
#pragma unroll
            for (int k = 0; k < 2; ++k) acc[1][m][n] = __builtin_amdgcn_mfma_f32_16x16x32_bf16(B0[n][k], At[m][k], acc[1][m][n], 0, 0, 0);
        __builtin_amdgcn_s_setprio(0);
        G_BAR;
      }
#pragma unroll
      for (int bj = 0; bj < 2; ++bj) {
        uint4 g[4];
#pragma unroll
        for (int m = 0; m < 4; ++m) {
          const u16* gp = G + (size_t)(brow + m * 16) * NPROJ + OFF_GATE + i * 1024 + bcol + bj * HALF;
          g[m] = *(const uint4*)(gp + goff);
        }
#pragma unroll
        for (int m = 0; m < 4; ++m) {
          const uint4 gv = g[m];
          mg[bj][m][0][0] += acc[bj][m][0][0] * sigmoidf_(bflo(gv.x)); mg[bj][m][0][1] += acc[bj][m][0][1] * sigmoidf_(bfhi(gv.x));
          mg[bj][m][0][2] += acc[bj][m][0][2] * sigmoidf_(bflo(gv.y)); mg[bj][m][0][3] += acc[bj][m][0][3] * sigmoidf_(bfhi(gv.y));
          mg[bj][m][1][0] += acc[bj][m][1][0] * sigmoidf_(bflo(gv.z)); mg[bj][m][1][1] += acc[bj][m][1][1] * sigmoidf_(bfhi(gv.z));
          mg[bj][m][1][2] += acc[bj][m][1][2] * sigmoidf_(bflo(gv.w)); mg[bj][m][1][3] += acc[bj][m][1][3] * sigmoidf_(bfhi(gv.w));
        }
      }
    }
#pragma unroll
    for (int bj = 0; bj < 2; ++bj)
#pragma unroll
      for (int m = 0; m < 4; ++m) {
        u16* mp = Mg + (size_t)(brow + m * 16) * 1024 + bcol + bj * HALF;
        uint4 o; o.x = pk2(mg[bj][m][0][0], mg[bj][m][0][1]); o.y = pk2(mg[bj][m][0][2], mg[bj][m][0][3]);
        o.z = pk2(mg[bj][m][1][0], mg[bj][m][1][1]); o.w = pk2(mg[bj][m][1][2], mg[bj][m][1][3]);
        *(uint4*)(mp + moff) = o;
      }
  }
}
#undef BR_LDB

DEVI void transpose_tile(int wv, const float* src, int lds_, int col0, int k0, u16* dst, int ldd, int drow0, int dk0, float* sm) {
  const int t = otid(wv);
  {
    const int k = t >> 4, n4 = (t & 15) * 4;
    float4 a = *(const float4*)(src + (size_t)(k0 + k) * lds_ + col0 + n4);
    float4 b = *(const float4*)(src + (size_t)(k0 + 32 + k) * lds_ + col0 + n4);
    float* p = sm + k * 65 + n4; p[0] = a.x; p[1] = a.y; p[2] = a.z; p[3] = a.w;
    p += 32 * 65; p[0] = b.x; p[1] = b.y; p[2] = b.z; p[3] = b.w;
  }
  __syncthreads();
  {
    const int n = t >> 3, kc = (t & 7) * 8;
    const float* p = sm + kc * 65 + n;
    uint4 o; o.x = pk2(p[0], p[65]); o.y = pk2(p[2 * 65], p[3 * 65]); o.z = pk2(p[4 * 65], p[5 * 65]); o.w = pk2(p[6 * 65], p[7 * 65]);
    *(uint4*)(dst + (size_t)(drow0 + n) * ldd + dk0 + kc) = o;
  }
  __syncthreads();
}

DEVI void prep_phase(int wv, unsigned char* smem) {
  float* sm = (float*)smem;
  u16* WT = (u16*)(KWS() + O_WT);
  constexpr int T1 = 16 * 68, T2 = 16 * 76, T3 = 64, T4 = 64, T5 = 128, T6 = 64, T7 = 256, T8 = 1024, T9 = 1024;
  constexpr int TL = T1 + T2 + T3 + T4 + T5 + T6 + T7 + T8 + T9;
  for (int it = oblk(); it < 2 * TL; it += ogrd()) {
    int l = it / TL, r = it % TL;
    u16* W = WT + (size_t)l * WT_L;
    if (r < T1) { int kt = r / 68, nt = r % 68; transpose_tile(wv, KP(w_in) + (size_t)l * 1024 * INW, INW, nt * 64, kt * 64, W + WT_IN, 1024, nt * 64, kt * 64, sm); continue; } r -= T1;
    if (r < T2) { int kt = r / 76, nt = r % 76; transpose_tile(wv, KP(w_in) + (size_t)l * 1024 * INW, INW, 4368 + nt * 64, kt * 64, W + WT_IN, 1024, 4352 + nt * 64, kt * 64, sm); continue; } r -= T2;
    if (r < T3) { int kt = r / 16, nt = r % 16; transpose_tile(wv, KP(w_br_a) + (size_t)l * 256 * 1024, 1024, nt * 64, kt * 64, W + WT_BR, BRW, nt * 64, 0 + kt * 64, sm); continue; } r -= T3;
    if (r < T4) { int kt = r / 16, nt = r % 16; transpose_tile(wv, KP(w_br_b) + (size_t)l * 256 * 1024, 1024, nt * 64, kt * 64, W + WT_BR, BRW, nt * 64, 256 + kt * 64, sm); continue; } r -= T4;
    if (r < T5) { int kt = r / 16, nt = r % 16; transpose_tile(wv, KP(w_br_c) + (size_t)l * 512 * 1024, 1024, nt * 64, kt * 64, W + WT_BR, BRW, nt * 64, 512 + kt * 64, sm); continue; } r -= T5;
    if (r < T6) { int kt = r / 16, nt = r % 16; transpose_tile(wv, KP(w_br_d) + (size_t)l * 256 * 1024, 1024, nt * 64, kt * 64, W + WT_BR, BRW, nt * 64, 1024 + kt * 64, sm); continue; } r -= T6;
    if (r < T7) { int kt = r / 16, nt = r % 16; transpose_tile(wv, KP(w_out) + (size_t)l * 1024 * 1024, 1024, nt * 64, kt * 64, W + WT_OUT, 1024, nt * 64, kt * 64, sm); continue; } r -= T7;
    if (r < T8) { int kt = r / 64, nt = r % 64; transpose_tile(wv, KP(w_up) + (size_t)l * 1024 * 4096, 4096, nt * 64, kt * 64, W + WT_UP, 1024, nt * 64, kt * 64, sm); continue; } r -= T8;
    { int kt = r / 16, nt = r % 16; transpose_tile(wv, KP(w_down) + (size_t)l * 4096 * 1024, 1024, nt * 64, kt * 64, W + WT_DOWN, 4096, nt * 64, kt * 64, sm); }
  }
  long gtid = (long)oblk() * 512 + otid(wv), gsz = (long)ogrd() * 512;
  for (long idx = gtid; idx < 2L * 16 * 1024; idx += gsz) {
    int l = (int)(idx >> 14), r = (int)((idx >> 10) & 15), k = (int)(idx & 1023);
    WT[(size_t)l * WT_L + WT_LOW + (size_t)r * 1024 + k] = f2bf(KP(w_in)[(size_t)l * 1024 * INW + (size_t)k * INW + 4352 + r]);
  }
  float* modp = (float*)(KWS() + O_MODP);
  const float* cvec = KP(c);
  for (int it = oblk(); it < 2 * 16 * 12; it += ogrd()) {
    int l = it / 192, kp = (it / 12) % 16, cgp = it % 12;
    int j = cgp * 512 + otid(wv);
    float a[8];
#pragma unroll
    for (int b = 0; b < 8; ++b) a[b] = 0.f;
    const float* w = KP(w_ada) + (size_t)l * 1024 * 6144 + (size_t)(kp * 64) * 6144 + j;
    for (int k = 0; k < 64; ++k) {
      float wv = w[(size_t)k * 6144];
#pragma unroll
      for (int b = 0; b < 8; ++b) a[b] += cvec[b * 1024 + kp * 64 + k] * wv;
    }
#pragma unroll
    for (int b = 0; b < 8; ++b) modp[(((size_t)l * 16 + kp) * 8 + b) * 6144 + j] = a[b];
  }
}

DEVI void modfinal_phase(int wv) {
  long gtid = (long)oblk() * 512 + otid(wv), gsz = (long)ogrd() * 512;
  unsigned char* ws_ = KWS();
  const float* modp = (const float*)(ws_ + O_MODP);
  float* modf = (float*)(ws_ + O_MODF);
  for (long idx = gtid; idx < 2L * 8 * 1024; idx += gsz) {
    int l = (int)(idx >> 13), b = (int)((idx >> 10) & 7), col = (int)(idx & 1023);
    float v[6];
#pragma unroll
    for (int s = 0; s < 6; ++s) {
      float a = KP(b_ada)[l * 6144 + s * 1024 + col];
      for (int kp = 0; kp < 16; ++kp) a += modp[(((size_t)l * 16 + kp) * 8 + b) * 6144 + s * 1024 + col];
      v[s] = a;
    }
    float* o = modf + ((size_t)l * 8 + b) * 6144 + col;
    o[0] = KP(g_mix)[l * 1024 + col] * (1.f + v[1]); o[1024] = v[0]; o[2048] = v[2];
    o[3072] = KP(g_mlp)[l * 1024 + col] * (1.f + v[4]); o[4096] = v[3]; o[5120] = v[5];
  }
}

DEVI void norm_phase(int wv, const float* xsrc, int row0, int nrows, const float* modl  , int slot, u16* hout) {
  const int tid = otid(wv); int wave = tid >> 6, lane = tid & 63;
  int gw = oblk() * 8 + wave, NGW = ogrd() * 8;
  for (int r0 = gw * 8; r0 < nrows; r0 += NGW * 8) {
    float4 v[8][4];
#pragma unroll
    for (int q = 0; q < 8; ++q) {
      const float4* xr = (const float4*)(xsrc + (size_t)(row0 + r0 + q) * 1024);
#pragma unroll
      for (int j = 0; j < 4; ++j) v[q][j] = xr[lane + 64 * j];
    }
    const int b = (row0 + r0) >> 12;
    const float4* sc = (const float4*)(modl + (size_t)b * 6144 + slot * 1024);
    const float4* sh = (const float4*)(modl + (size_t)b * 6144 + (slot + 1) * 1024);
    float4 s4[4], h4[4];
#pragma unroll
    for (int j = 0; j < 4; ++j) { s4[j] = sc[lane + 64 * j]; h4[j] = sh[lane + 64 * j]; }
#pragma unroll
    for (int q = 0; q < 8; ++q) {
      float ss = 0.f;
#pragma unroll
      for (int j = 0; j < 4; ++j) ss += v[q][j].x * v[q][j].x + v[q][j].y * v[q][j].y + v[q][j].z * v[q][j].z + v[q][j].w * v[q][j].w;
#pragma unroll
      for (int o = 1; o < 64; o <<= 1) ss += shfl_xor_l(ss, o, lane);
      const float rs = rsqrtf(ss * (1.f / 1024.f) + EPS);
      uint2* o2 = (uint2*)(hout + (size_t)(r0 + q) * 1024);
#pragma unroll
      for (int j = 0; j < 4; ++j) {
        uint2 o; o.x = pk2(v[q][j].x * rs * s4[j].x + h4[j].x, v[q][j].y * rs * s4[j].y + h4[j].y);
        o.y = pk2(v[q][j].z * rs * s4[j].z + h4[j].z, v[q][j].w * rs * s4[j].w + h4[j].w);
        o2[lane + 64 * j] = o;
      }
    }
  }
}

DEVI void glow_phase(int wv, int l, const u16* hbuf, const u16* WlowT, float* xgout) {
  const int tid = otid(wv), w = tid >> 6, lane = tid & 63, fr = lane & 15, fq = lane >> 4;
  const float* wg = KP(gla_w_gate) + (size_t)l * 16 * 256; const float* bg = KP(gla_b_gate) + l * 256;
  for (int u = oblk() * 8 + w; u < MH / 16; u += ogrd() * 8) {
    const u16* ap = WlowT + (size_t)fr * 1024 + fq * 8;
    const u16* bp = hbuf + (size_t)(u * 16 + fr) * 1024 + fq * 8;
    f32x4 acc = {0.f, 0.f, 0.f, 0.f};
#pragma unroll 8
    for (int ks = 0; ks < 32; ++ks) acc = mfma16(*(const bf16x8*)(ap + ks * 32), *(const bf16x8*)(bp + ks * 32), acc);
    u32x4_t pbu = {pk2_sw(acc[0], acc[1]), pk2_sw(acc[2], acc[3]), 0u, 0u};
    const bf16x8 pb = __builtin_bit_cast(bf16x8, pbu);
    float* orow = xgout + (size_t)(u * 16 + fr) * 256 + fq * 4;
#pragma unroll
    for (int nt = 0; nt < 16; ++nt) {
      const float* wp = wg + (size_t)(fq * 4) * 256 + nt * 16 + fr;
      u32x4_t pau = {pk2_sw(wp[0], wp[256]), pk2_sw(wp[512], wp[768]), 0u, 0u};
      f32x4 d = mfma16(__builtin_bit_cast(bf16x8, pau), pb, (f32x4){0.f, 0.f, 0.f, 0.f});
      const float4 bb = *(const float4*)(bg + nt * 16 + fq * 4);
      *(float4*)(orow + nt * 16) = make_float4(d[0] + bb.x, d[1] + bb.y, d[2] + bb.z, d[3] + bb.w);
    }
  }
}

struct MixCtx { int wv; int l; int hf; u16* proj; u16* br; float* lse; float* S; float* gdec; float* glow; };
DEVI MixCtx make_ctx(int wv, int l, int hf) { unsigned char* ws = KWS(); MixCtx c; c.wv = wv; c.l = l; c.hf = hf; c.proj = (u16*)(ws + O_PROJ); c.br = (u16*)(ws + O_BR); c.lse = (float*)(ws + O_LSE); c.S = (float*)(ws + O_S); c.gdec = (float*)(ws + O_GDEC); c.glow = (float*)(ws + O_GLOW); return c; }

DEVI void unpack8(uint4 r, float (&v)[8]) {
  v[0] = bflo(r.x); v[1] = bfhi(r.x); v[2] = bflo(r.y); v[3] = bfhi(r.y); v[4] = bflo(r.z); v[5] = bfhi(r.z); v[6] = bflo(r.w); v[7] = bfhi(r.w);
}

DEVI void dswa_item(const MixCtx& c, int item, unsigned char* smem, bool do_store = true, bool stage_only = false) {
  const int tid = otid(c.wv), w = tid >> 6, lane = tid & 63, fr = lane & 15, fq = lane >> 4;
  int blk = item & 31, h = (item >> 5) & 3, gb = item >> 7, g = gb % 3, bl = gb / 3;
  int d = (g == 0) ? 1 : (g == 1 ? 4 : 16), nbr = 32 / d, r = blk / nbr, nbi = blk % nbr;
  u16* Qs = (u16*)smem; u16* Ks = Qs + 128 * 72; u16* VT = Ks + 256 * 72;
  u16* pj = c.proj + (size_t)bl * 4096 * NPROJ;
  const float* qg = KP(q_gain) + c.l * 64; const float* kg = KP(k_gain) + c.l * 64;
#pragma unroll
  for (int i = 0; i < 2; ++i) {
    int ci = tid + 512 * i, row = ci >> 3, ch = ci & 7, tok = (nbi * 128 + row) * d + r;
    uint4 raw = *(const uint4*)(pj + (size_t)tok * NPROJ + OFF_AQ + g * 256 + h * 64 + ch * 8);
    float v[8]; unpack8(raw, v);
    float ss = 0.f;
#pragma unroll
    for (int j = 0; j < 8; ++j) ss += v[j] * v[j];
    ss += shfl_xor_l(ss, 1, lane); ss += shfl_xor_l(ss, 2, lane); ss += shfl_xor_l(ss, 4, lane);
    float sc = rsqrtf(ss * (1.f / 64.f) + EPS);
    uint4 o; o.x = pk2(v[0] * sc * qg[ch * 8 + 0], v[1] * sc * qg[ch * 8 + 1]); o.y = pk2(v[2] * sc * qg[ch * 8 + 2], v[3] * sc * qg[ch * 8 + 3]);
    o.z = pk2(v[4] * sc * qg[ch * 8 + 4], v[5] * sc * qg[ch * 8 + 5]); o.w = pk2(v[6] * sc * qg[ch * 8 + 6], v[7] * sc * qg[ch * 8 + 7]);
    *(uint4*)(Qs + row * 72 + ch * 8) = o;
  }
#pragma unroll
  for (int i = 0; i < 4; ++i) {
    int ci = tid + 512 * i, row = ci >> 3, ch = ci & 7, sub = (nbi - 1) * 128 + row;
    bool ok = sub >= 0; int tok = ok ? sub * d + r : 0;
    uint4 raw = *(const uint4*)(pj + (size_t)tok * NPROJ + OFF_AK + g * 256 + h * 64 + ch * 8);
    uint4 rv = *(const uint4*)(pj + (size_t)tok * NPROJ + OFF_AV + g * 256 + h * 64 + ch * 8);
    if (!ok) { raw = make_uint4(0, 0, 0, 0); rv = raw; }
    float v[8]; unpack8(raw, v);
    float ss = 0.f;
#pragma unroll
    for (int j = 0; j < 8; ++j) ss += v[j] * v[j];
    ss += shfl_xor_l(ss, 1, lane); ss += shfl_xor_l(ss, 2, lane); ss += shfl_xor_l(ss, 4, lane);
    float sc = rsqrtf(ss * (1.f / 64.f) + EPS);
    uint4 o; o.x = pk2(v[0] * sc * kg[ch * 8 + 0], v[1] * sc * kg[ch * 8 + 1]); o.y = pk2(v[2] * sc * kg[ch * 8 + 2], v[3] * sc * kg[ch * 8 + 3]);
    o.z = pk2(v[4] * sc * kg[ch * 8 + 4], v[5] * sc * kg[ch * 8 + 5]); o.w = pk2(v[6] * sc * kg[ch * 8 + 6], v[7] * sc * kg[ch * 8 + 7]);
    *(uint4*)(Ks + row * 72 + ch * 8) = o;
    u16* vt = VT + (ch * 8) * 264 + row;
    vt[0 * 264] = (u16)(rv.x & 0xffff); vt[1 * 264] = (u16)(rv.x >> 16); vt[2 * 264] = (u16)(rv.y & 0xffff); vt[3 * 264] = (u16)(rv.y >> 16);
    vt[4 * 264] = (u16)(rv.z & 0xffff); vt[5 * 264] = (u16)(rv.z >> 16); vt[6 * 264] = (u16)(rv.w & 0xffff); vt[7 * 264] = (u16)(rv.w >> 16);
  }
  __syncthreads();
  if (stage_only) return;
  bf16x8 qf[2];
#pragma unroll
  for (int ks = 0; ks < 2; ++ks) qf[ks] = *(const bf16x8*)(Qs + (16 * w + fr) * 72 + ks * 32 + fq * 8);
  const int pair0 = w >> 1;
  f32x4 st[5][2];
#pragma unroll
  for (int s5 = 0; s5 < 5; ++s5)
#pragma unroll
    for (int sub = 0; sub < 2; ++sub) {
      f32x4 a = {0.f, 0.f, 0.f, 0.f};
      int kb = 32 * (pair0 + s5) + 16 * sub;
#pragma unroll
      for (int ks = 0; ks < 2; ++ks) a = mfma16(*(const bf16x8*)(Ks + (kb + fr) * 72 + ks * 32 + fq * 8), qf[ks], a);
      st[s5][sub] = a;
    }
  const float slope_d = exp2f(-8.f * (float)(g * 4 + h + 1) / 12.f) * (float)d;
  const int qi = 16 * w + fr;
  float mx = -3.0e38f;
#pragma unroll
  for (int s5 = 0; s5 < 5; ++s5)
#pragma unroll
    for (int sub = 0; sub < 2; ++sub)
#pragma unroll
      for (int j = 0; j < 4; ++j) {
        int kb = 32 * (pair0 + s5) + 16 * sub + 4 * fq + j, rel = 128 + qi - kb;
        bool ok = (rel >= 0) && (rel <= 128) && (nbi > 0 || kb >= 128);
        float s = st[s5][sub][j] * 0.125f - slope_d * (float)rel;
        s = ok ? s : -3.0e38f;
        st[s5][sub][j] = s; mx = fmaxf(mx, s);
      }
  mx = fmaxf(mx, shfl_xor_l(mx, 16, lane)); mx = fmaxf(mx, shfl_xor_l(mx, 32, lane));
  float den = 0.f;
#pragma unroll
  for (int s5 = 0; s5 < 5; ++s5)
#pragma unroll
    for (int sub = 0; sub < 2; ++sub)
#pragma unroll
      for (int j = 0; j < 4; ++j) {
        float s = st[s5][sub][j];
        float pv = (s > -1.0e38f) ? __expf(s - mx) : 0.f;
        st[s5][sub][j] = pv; den += pv;
      }
  den += shfl_xor_l(den, 16, lane); den += shfl_xor_l(den, 32, lane);
  f32x4 ot[4];
#pragma unroll
  for (int et = 0; et < 4; ++et) ot[et] = (f32x4){0.f, 0.f, 0.f, 0.f};
#pragma unroll
  for (int s5 = 0; s5 < 5; ++s5) {
    union { bf16x8 v; unsigned u[4]; } pb;
    pb.u[0] = pk2_sw(st[s5][0][0], st[s5][0][1]); pb.u[1] = pk2_sw(st[s5][0][2], st[s5][0][3]);
    pb.u[2] = pk2_sw(st[s5][1][0], st[s5][1][1]); pb.u[3] = pk2_sw(st[s5][1][2], st[s5][1][3]);
    int kb0 = 32 * (pair0 + s5);
#pragma unroll
    for (int et = 0; et < 4; ++et) {
      union { bf16x8 v; uint2 h[2]; } av;
      av.h[0] = *(const uint2*)(VT + (et * 16 + fr) * 264 + kb0 + fq * 4);
      av.h[1] = *(const uint2*)(VT + (et * 16 + fr) * 264 + kb0 + 16 + fq * 4);
      ot[et] = mfma16(av.v, pb.v, ot[et]);
    }
  }
  float inv = 1.f / den;
  int tokq = (nbi * 128 + qi) * d + r;
  if (!do_store) { if (inv == 123.456f) c.lse[0] = ot[0][0] + ot[1][1] + ot[2][2] + ot[3][3]; return; }
#pragma unroll
  for (int et = 0; et < 4; ++et) {
    uint2 o; o.x = pk2(ot[et][0] * inv, ot[et][1] * inv); o.y = pk2(ot[et][2] * inv, ot[et][3] * inv);
    *(uint2*)(pj + (size_t)tokq * NPROJ + OFF_AQ + g * 256 + h * 64 + et * 16 + fq * 4) = o;
  }
  if (fq == 0) c.lse[((size_t)bl * 4096 + tokq) * 12 + g * 4 + h] = mx + __logf(den);
}

typedef short v4i16_t __attribute__((ext_vector_type(4)));
DEVI uint2 lds_tr16(const u16* p) {
  return __builtin_bit_cast(uint2, __builtin_amdgcn_ds_read_tr16_b64_v4i16((__attribute__((address_space(3))) v4i16_t*)p));
}


DEVI void sb_wave_phase(const MixCtx& c, unsigned char* smem) {
  const int tid = otid(c.wv), w = tid >> 6, lane = tid & 63, fr = lane & 15, fq = lane >> 4;
  u16* Vs = (u16*)smem + w * (32 * 72);
  for (int wi = oblk() * 8 + w; wi < 4096; wi += ogrd() * 8) {
    const int qg = 255 - (wi & 255), h = (wi >> 8) & 3, bl = wi >> 10;
    const u16* pj = c.proj + (size_t)bl * 4096 * NPROJ;
    const int t0 = qg * 16, t = t0 + fr;
    bf16x8 qf[2];
#pragma unroll
    for (int ks = 0; ks < 2; ++ks) qf[ks] = *(const bf16x8*)(pj + (size_t)t * NPROJ + OFF_DQ + h * 64 + ks * 32 + fq * 8);
    float carry = 0.f;
    f32x4 ot[4];
#pragma unroll
    for (int et = 0; et < 4; ++et) ot[et] = (f32x4){0.f, 0.f, 0.f, 0.f};
    const int s0 = (t0 + 14) >> 5;
    bf16x8 kn00, kn01, kn10, kn11; uint4 vn0, vn1, vn2, vn3;
    {
      const u16* kp = pj + (size_t)(s0 * 32 + fr) * NPROJ + OFF_DK + h * 64 + fq * 8;
      kn00 = *(const bf16x8*)(kp); kn01 = *(const bf16x8*)(kp + 32);
      kn10 = *(const bf16x8*)(kp + (size_t)16 * NPROJ); kn11 = *(const bf16x8*)(kp + (size_t)16 * NPROJ + 32);
      const u16* vp = pj + (size_t)(s0 * 32 + (lane >> 1)) * NPROJ + OFF_DV + h * 64 + (lane & 1) * 32;
      vn0 = *(const uint4*)(vp); vn1 = *(const uint4*)(vp + 8); vn2 = *(const uint4*)(vp + 16); vn3 = *(const uint4*)(vp + 24);
    }
    for (int step = s0; step >= 0; --step) {
      const bf16x8 kf00 = kn00, kf01 = kn01, kf10 = kn10, kf11 = kn11;
      {
        u16* vd = Vs + (lane >> 1) * 72 + (lane & 1) * 32;
        *(uint4*)(vd) = vn0; *(uint4*)(vd + 8) = vn1; *(uint4*)(vd + 16) = vn2; *(uint4*)(vd + 24) = vn3;
      }
      if (step > 0) {
        const u16* kp = pj + (size_t)((step - 1) * 32 + fr) * NPROJ + OFF_DK + h * 64 + fq * 8;
        kn00 = *(const bf16x8*)(kp); kn01 = *(const bf16x8*)(kp + 32);
        kn10 = *(const bf16x8*)(kp + (size_t)16 * NPROJ); kn11 = *(const bf16x8*)(kp + (size_t)16 * NPROJ + 32);
        const u16* vp = pj + (size_t)((step - 1) * 32 + (lane >> 1)) * NPROJ + OFF_DV + h * 64 + (lane & 1) * 32;
        vn0 = *(const uint4*)(vp); vn1 = *(const uint4*)(vp + 8); vn2 = *(const uint4*)(vp + 16); vn3 = *(const uint4*)(vp + 24);
      }
      f32x4 z[2];
      z[0] = mfma16(kf01, qf[1], mfma16(kf00, qf[0], (f32x4){0.f, 0.f, 0.f, 0.f}));
      z[1] = mfma16(kf11, qf[1], mfma16(kf10, qf[0], (f32x4){0.f, 0.f, 0.f, 0.f}));
      float ls[2][4], lk[2][4], L[2];
#pragma unroll
      for (int sub = 0; sub < 2; ++sub) {
        L[sub] = 0.f;
#pragma unroll
        for (int j = 0; j < 4; ++j) {
          int key = step * 32 + 16 * sub + 4 * fq + j;
          float zz = z[sub][j] * 0.125f;
          float l_ = logsigf_(zz);
          bool m = key < t;
          ls[sub][j] = m ? l_ : -3.0e38f;
          lk[sub][j] = m ? (l_ - zz) : 0.f;
          L[sub] += lk[sub][j];
        }
      }
      float a0[4], a1[4];
#pragma unroll
      for (int gq = 0; gq < 4; ++gq) { a0[gq] = shfl_l(L[0], fr + 16 * gq); a1[gq] = shfl_l(L[1], fr + 16 * gq); }
      float tot0 = a0[0] + a0[1] + a0[2] + a0[3], tot1 = a1[0] + a1[1] + a1[2] + a1[3];
      float suf0 = 0.f, suf1 = 0.f;
#pragma unroll
      for (int gq = 1; gq < 4; ++gq) { if (gq > fq) { suf0 += a0[gq]; suf1 += a1[gq]; } }
      float base[2]; base[1] = carry + suf1; base[0] = carry + tot1 + suf0;
      float wv[2][4];
#pragma unroll
      for (int sub = 0; sub < 2; ++sub) {
        float run = base[sub];
#pragma unroll
        for (int j = 3; j >= 0; --j) {
          float e = ls[sub][j] + run;
          wv[sub][j] = (ls[sub][j] > -1.0e38f) ? __expf(e) : 0.f;
          run += lk[sub][j];
        }
      }
      carry += tot0 + tot1;
      union { bf16x8 v; unsigned u[4]; } pb;
      pb.u[0] = pk2_sw(wv[0][0], wv[0][1]); pb.u[1] = pk2_sw(wv[0][2], wv[0][3]); pb.u[2] = pk2_sw(wv[1][0], wv[1][1]); pb.u[3] = pk2_sw(wv[1][2], wv[1][3]);
      const u16* vb = Vs + (fq * 4 + (fr >> 2)) * 72 + 4 * (fr & 3);
#pragma unroll
      for (int et = 0; et < 4; ++et) {
        union { bf16x8 v; uint2 h[2]; } av;
        av.h[0] = lds_tr16(vb + et * 16);
        av.h[1] = lds_tr16(vb + 16 * 72 + et * 16);
        ot[et] = mfma16(av.v, pb.v, ot[et]);
      }
      if (__all(carry < -104.f)) break;
    }
    u16* brp = c.br + ((size_t)bl * 4096 + t) * BRW + 1024 + h * 64;
    float one = 1.f; asm volatile("" : "+v"(one));
#pragma unroll
    for (int et = 0; et < 4; ++et) {
      uint2 o; o.x = pk2(ot[et][0] * one, ot[et][1] * one); o.y = pk2(ot[et][2] * one, ot[et][3] * one);
      *(uint2*)(brp + et * 16 + fq * 4) = o;
    }
  }
}

struct DswaIt { int bl, g, h, d, r, nbi; };
DEVI DswaIt dswa_decode(int item) {
  DswaIt q; int blk = item & 31; q.h = (item >> 5) & 3; int gb = item >> 7; q.g = gb % 3; q.bl = gb / 3;
  q.d = (q.g == 0) ? 1 : (q.g == 1 ? 4 : 16); int nbr = 32 / q.d; q.r = blk / nbr; q.nbi = blk % nbr; return q;
}
#define DSWA_RAW_LOAD(ITEM)                                                                                          \
  {                                                                                                                    \
    const DswaIt q_ = dswa_decode(ITEM);                                                                               \
    const u16* pj_ = c.proj + (size_t)q_.bl * 4096 * NPROJ + q_.g * 256 + q_.h * 64 + (tid & 7) * 8;                    \
    _Pragma("unroll") for (int i_ = 0; i_ < 2; ++i_) {                                                                 \
      int row_ = (tid + 512 * i_) >> 3, tok_ = (q_.nbi * 128 + row_) * q_.d + q_.r;                                    \
      rq[i_] = *(const uint4*)(pj_ + (size_t)tok_ * NPROJ + OFF_AQ); }                                                 \
    _Pragma("unroll") for (int i_ = 0; i_ < 4; ++i_) {                                                                 \
      int row_ = (tid + 512 * i_) >> 3, sub_ = (q_.nbi - 1) * 128 + row_; bool ok_ = sub_ >= 0;                        \
      int tok_ = ok_ ? sub_ * q_.d + q_.r : 0;                                                                         \
      rk[i_] = *(const uint4*)(pj_ + (size_t)tok_ * NPROJ + OFF_AK); rv[i_] = *(const uint4*)(pj_ + (size_t)tok_ * NPROJ + OFF_AV); \
      if (!ok_) { rk[i_] = make_uint4(0, 0, 0, 0); rv[i_] = rk[i_]; } }                                                \
  }

DEVI void dswa_block_phase(const MixCtx& c, unsigned char* smem) {
  const int tid = otid(c.wv), w = tid >> 6, lane = tid & 63, fr = lane & 15, fq = lane >> 4, ch = tid & 7;
  u16* Qs = (u16*)smem; u16* Ks = Qs + 128 * 72; u16* Vs = Ks + 256 * 72;
  const float* qgp = KP(q_gain) + c.l * 64 + ch * 8; const float* kgp = KP(k_gain) + c.l * 64 + ch * 8;
  float qg[8], kg[8];
#pragma unroll
  for (int j = 0; j < 8; ++j) { qg[j] = qgp[j]; kg[j] = kgp[j]; }
  const int G = ogrd();
  int it = oblk();
  uint4 rq[2], rk[4], rv[4];
  if (it < 1536) DSWA_RAW_LOAD(it)
  for (; it < 1536; it += G) {
    const DswaIt q = dswa_decode(it);
#pragma unroll
    for (int i = 0; i < 2; ++i) {
      int row = (tid + 512 * i) >> 3;
      float v[8]; unpack8(rq[i], v);
      float ss = 0.f;
#pragma unroll
      for (int j = 0; j < 8; ++j) ss += v[j] * v[j];
      ss += shfl_xor_l(ss, 1, lane); ss += shfl_xor_l(ss, 2, lane); ss += shfl_xor_l(ss, 4, lane);
      float sc = rsqrtf(ss * (1.f / 64.f) + EPS);
      uint4 o; o.x = pk2(v[0] * sc * qg[0], v[1] * sc * qg[1]); o.y = pk2(v[2] * sc * qg[2], v[3] * sc * qg[3]);
      o.z = pk2(v[4] * sc * qg[4], v[5] * sc * qg[5]); o.w = pk2(v[6] * sc * qg[6], v[7] * sc * qg[7]);
      *(uint4*)(Qs + row * 72 + ch * 8) = o;
    }
#pragma unroll
    for (int i = 0; i < 4; ++i) {
      int row = (tid + 512 * i) >> 3;
      float v[8]; unpack8(rk[i], v);
      float ss = 0.f;
#pragma unroll
      for (int j = 0; j < 8; ++j) ss += v[j] * v[j];
      ss += shfl_xor_l(ss, 1, lane); ss += shfl_xor_l(ss, 2, lane); ss += shfl_xor_l(ss, 4, lane);
      float sc = rsqrtf(ss * (1.f / 64.f) + EPS);
      uint4 o; o.x = pk2(v[0] * sc * kg[0], v[1] * sc * kg[1]); o.y = pk2(v[2] * sc * kg[2], v[3] * sc * kg[3]);
      o.z = pk2(v[4] * sc * kg[4], v[5] * sc * kg[5]); o.w = pk2(v[6] * sc * kg[6], v[7] * sc * kg[7]);
      *(uint4*)(Ks + row * 72 + ch * 8) = o;
      *(uint4*)(Vs + row * 72 + ch * 8) = rv[i];
    }
    __syncthreads();
    if (it + G < 1536) DSWA_RAW_LOAD(it + G)
    bf16x8 qf[2];
#pragma unroll
    for (int ks = 0; ks < 2; ++ks) qf[ks] = *(const bf16x8*)(Qs + (16 * w + fr) * 72 + ks * 32 + fq * 8);
    const int pair0 = w >> 1;
    f32x4 st[5][2];
#pragma unroll
    for (int s5 = 0; s5 < 5; ++s5)
#pragma unroll
      for (int sub = 0; sub < 2; ++sub) {
        f32x4 a = {0.f, 0.f, 0.f, 0.f};
        int kb = 32 * (pair0 + s5) + 16 * sub;
        if (!(q.nbi == 0 && kb + 16 <= 128)) {
#pragma unroll
          for (int ks = 0; ks < 2; ++ks) a = mfma16(*(const bf16x8*)(Ks + (kb + fr) * 72 + ks * 32 + fq * 8), qf[ks], a);
        }
        st[s5][sub] = a;
      }
    const float slope_d = exp2f(-8.f * (float)(q.g * 4 + q.h + 1) / 12.f) * (float)q.d;
    int qi = 16 * w + fr;
    asm volatile("" : "+v"(qi));
    float mx = -3.0e38f;
#pragma unroll
    for (int s5 = 0; s5 < 5; ++s5)
#pragma unroll
      for (int sub = 0; sub < 2; ++sub)
#pragma unroll
        for (int j = 0; j < 4; ++j) {
          int kb = 32 * (pair0 + s5) + 16 * sub + 4 * fq + j, rel = 128 + qi - kb;
          bool ok = (rel >= 0) && (rel <= 128) && (q.nbi > 0 || kb >= 128);
          float sv = st[s5][sub][j] * 0.125f - slope_d * (float)rel;
          sv = ok ? sv : -3.0e38f;
          st[s5][sub][j] = sv; mx = fmaxf(mx, sv);
        }
    mx = fmaxf(mx, shfl_xor_l(mx, 16, lane)); mx = fmaxf(mx, shfl_xor_l(mx, 32, lane));
    float den = 0.f;
#pragma unroll
    for (int s5 = 0; s5 < 5; ++s5)
#pragma unroll
      for (int sub = 0; sub < 2; ++sub)
#pragma unroll
        for (int j = 0; j < 4; ++j) {
          float sv = st[s5][sub][j];
          float pv = (sv > -1.0e38f) ? __expf(sv - mx) : 0.f;
          st[s5][sub][j] = pv; den += pv;
        }
    den += shfl_xor_l(den, 16, lane); den += shfl_xor_l(den, 32, lane);
    f32x4 ot[4];
#pragma unroll
    for (int et = 0; et < 4; ++et) ot[et] = (f32x4){0.f, 0.f, 0.f, 0.f};
#pragma unroll
    for (int s5 = 0; s5 < 5; ++s5) {
      u32x4_t pbu = {pk2_sw(st[s5][0][0], st[s5][0][1]), pk2_sw(st[s5][0][2], st[s5][0][3]), pk2_sw(st[s5][1][0], st[s5][1][1]), pk2_sw(st[s5][1][2], st[s5][1][3])};
      const bf16x8 pb = __builtin_bit_cast(bf16x8, pbu);
      const u16* vb = Vs + (32 * (pair0 + s5) + fq * 4 + (fr >> 2)) * 72 + 4 * (fr & 3);
      if (!(q.nbi == 0 && 32 * (pair0 + s5) + 32 <= 128)) {
#pragma unroll
        for (int et = 0; et < 4; ++et) ot[et] = mfma16(mk8(lds_tr16(vb + et * 16), lds_tr16(vb + 16 * 72 + et * 16)), pb, ot[et]);
      }
    }
    const float inv = 1.f / den;
    const int tokq = (q.nbi * 128 + qi) * q.d + q.r;
    u16* pj = c.proj + (size_t)q.bl * 4096 * NPROJ;
#pragma unroll
    for (int et = 0; et < 4; ++et) {
      uint2 o; o.x = pk2(ot[et][0] * inv, ot[et][1] * inv); o.y = pk2(ot[et][2] * inv, ot[et][3] * inv);
      *(uint2*)(pj + (size_t)tokq * NPROJ + OFF_AQ + q.g * 256 + q.h * 64 + et * 16 + fq * 4) = o;
    }
    if (fq == 0) c.lse[((size_t)q.bl * 4096 + tokq) * 12 + q.g * 4 + q.h] = mx + __logf(den);
    __syncthreads();
  }
}
#undef DSWA_RAW_LOAD

DEVI void dswa_wave_phase(const MixCtx& c, unsigned char* smem) {
  const int tid = otid(c.wv), w = tid >> 6, lane = tid & 63, fr = lane & 15, fq = lane >> 4;
  u16* Vs = (u16*)smem + w * (32 * 72);
  const float* qgp = KP(q_gain) + c.l * 64; const float* kgp = KP(k_gain) + c.l * 64;
  float qg[16], kg[16];
#pragma unroll
  for (int ks = 0; ks < 2; ++ks)
#pragma unroll
    for (int j = 0; j < 8; ++j) { qg[ks * 8 + j] = qgp[ks * 32 + fq * 8 + j]; kg[ks * 8 + j] = kgp[ks * 32 + fq * 8 + j]; }
  for (int wi = oblk() * 8 + w; wi < 12288; wi += ogrd() * 8) {
    const int wq = wi & 7, blk = (wi >> 3) & 31, h = (wi >> 8) & 3, gb = wi >> 10, g = gb % 3, bl = gb / 3;
    const int d = (g == 0) ? 1 : (g == 1 ? 4 : 16), nbr = 32 / d, r = blk / nbr, nbi = blk % nbr;
    u16* pj = c.proj + (size_t)bl * 4096 * NPROJ;
    const int qi = 16 * wq + fr, tokq = (nbi * 128 + qi) * d + r;
    const int colq = OFF_AQ + g * 256 + h * 64, colk = OFF_AK + g * 256 + h * 64, colv = OFF_AV + g * 256 + h * 64;
    bf16x8 qf0, qf1;
    {
      uint4 r0 = *(const uint4*)(pj + (size_t)tokq * NPROJ + colq + fq * 8), r1 = *(const uint4*)(pj + (size_t)tokq * NPROJ + colq + 32 + fq * 8);
      float a[8], b[8]; unpack8(r0, a); unpack8(r1, b);
      float ss = 0.f;
#pragma unroll
      for (int j = 0; j < 8; ++j) ss += a[j] * a[j] + b[j] * b[j];
      ss += shfl_xor_l(ss, 16, lane); ss += shfl_xor_l(ss, 32, lane);
      float sc = rsqrtf(ss * (1.f / 64.f) + EPS);
      u32x4_t p0 = {pk2(a[0] * sc * qg[0], a[1] * sc * qg[1]), pk2(a[2] * sc * qg[2], a[3] * sc * qg[3]), pk2(a[4] * sc * qg[4], a[5] * sc * qg[5]), pk2(a[6] * sc * qg[6], a[7] * sc * qg[7])};
      u32x4_t p1 = {pk2(b[0] * sc * qg[8], b[1] * sc * qg[9]), pk2(b[2] * sc * qg[10], b[3] * sc * qg[11]), pk2(b[4] * sc * qg[12], b[5] * sc * qg[13]), pk2(b[6] * sc * qg[14], b[7] * sc * qg[15])};
      qf0 = __builtin_bit_cast(bf16x8, p0); qf1 = __builtin_bit_cast(bf16x8, p1);
    }
    const int pair0 = wq >> 1, sub0 = (nbi - 1) * 128;
    const float slope_d = exp2f(-8.f * (float)(g * 4 + h + 1) / 12.f) * (float)d;
    uint4 kn00, kn01, kn10, kn11, vn0, vn1, vn2, vn3;
#define DSWA_LOAD(P)                                                                                              \
    {                                                                                                               \
      const int kbA = 32 * (pair0 + (P)) + fr, sA = sub0 + kbA, sB = sA + 16;                                        \
      const u16* pa = pj + (size_t)((sA >= 0 ? sA : 0) * d + r) * NPROJ + colk + fq * 8;                             \
      const u16* pb_ = pj + (size_t)((sB >= 0 ? sB : 0) * d + r) * NPROJ + colk + fq * 8;                            \
      kn00 = *(const uint4*)(pa); kn01 = *(const uint4*)(pa + 32); kn10 = *(const uint4*)(pb_); kn11 = *(const uint4*)(pb_ + 32); \
      if (sA < 0) { kn00 = make_uint4(0, 0, 0, 0); kn01 = kn00; }                                                    \
      if (sB < 0) { kn10 = make_uint4(0, 0, 0, 0); kn11 = kn10; }                                                    \
      const int sV = sub0 + 32 * (pair0 + (P)) + (lane >> 1);                                                        \
      const u16* pv = pj + (size_t)((sV >= 0 ? sV : 0) * d + r) * NPROJ + colv + (lane & 1) * 32;                    \
      vn0 = *(const uint4*)(pv); vn1 = *(const uint4*)(pv + 8); vn2 = *(const uint4*)(pv + 16); vn3 = *(const uint4*)(pv + 24); \
      if (sV < 0) { vn0 = make_uint4(0, 0, 0, 0); vn1 = vn0; vn2 = vn0; vn3 = vn0; }                                 \
    }
    DSWA_LOAD(0)
    float mrun = -3.0e38f, den = 0.f;
    f32x4 ot[4];
#pragma unroll
    for (int et = 0; et < 4; ++et) ot[et] = (f32x4){0.f, 0.f, 0.f, 0.f};
    for (int p = 0; p < 5; ++p) {
      const uint4 k00 = kn00, k01 = kn01, k10 = kn10, k11 = kn11;
      {
        u16* vd = Vs + (lane >> 1) * 72 + (lane & 1) * 32;
        *(uint4*)(vd) = vn0; *(uint4*)(vd + 8) = vn1; *(uint4*)(vd + 16) = vn2; *(uint4*)(vd + 24) = vn3;
      }
      if (p < 4) DSWA_LOAD(p + 1)
      bf16x8 kf[2][2];
#pragma unroll
      for (int sub = 0; sub < 2; ++sub) {
        float a[8], b[8]; unpack8(sub ? k10 : k00, a); unpack8(sub ? k11 : k01, b);
        float ss = 0.f;
#pragma unroll
        for (int j = 0; j < 8; ++j) ss += a[j] * a[j] + b[j] * b[j];
        ss += shfl_xor_l(ss, 16, lane); ss += shfl_xor_l(ss, 32, lane);
        float sc = rsqrtf(ss * (1.f / 64.f) + EPS);
        u32x4_t p0 = {pk2(a[0] * sc * kg[0], a[1] * sc * kg[1]), pk2(a[2] * sc * kg[2], a[3] * sc * kg[3]), pk2(a[4] * sc * kg[4], a[5] * sc * kg[5]), pk2(a[6] * sc * kg[6], a[7] * sc * kg[7])};
        u32x4_t p1 = {pk2(b[0] * sc * kg[8], b[1] * sc * kg[9]), pk2(b[2] * sc * kg[10], b[3] * sc * kg[11]), pk2(b[4] * sc * kg[12], b[5] * sc * kg[13]), pk2(b[6] * sc * kg[14], b[7] * sc * kg[15])};
        kf[sub][0] = __builtin_bit_cast(bf16x8, p0); kf[sub][1] = __builtin_bit_cast(bf16x8, p1);
      }
      f32x4 z[2];
      z[0] = mfma16(kf[0][1], qf1, mfma16(kf[0][0], qf0, (f32x4){0.f, 0.f, 0.f, 0.f}));
      z[1] = mfma16(kf[1][1], qf1, mfma16(kf[1][0], qf0, (f32x4){0.f, 0.f, 0.f, 0.f}));
      float sv[2][4], mx = mrun;
#pragma unroll
      for (int sub = 0; sub < 2; ++sub)
#pragma unroll
        for (int j = 0; j < 4; ++j) {
          const int kb = 32 * (pair0 + p) + 16 * sub + 4 * fq + j, rel = 128 + qi - kb;
          const bool ok = (rel >= 0) && (rel <= 128) && (nbi > 0 || kb >= 128);
          float sc_ = z[sub][j] * 0.125f - slope_d * (float)rel;
          sc_ = ok ? sc_ : -3.0e38f;
          sv[sub][j] = sc_; mx = fmaxf(mx, sc_);
        }
      mx = fmaxf(mx, shfl_xor_l(mx, 16, lane)); mx = fmaxf(mx, shfl_xor_l(mx, 32, lane));
      const float alpha = __expf(mrun - mx);
      mrun = mx;
      float ps = 0.f;
#pragma unroll
      for (int sub = 0; sub < 2; ++sub)
#pragma unroll
        for (int j = 0; j < 4; ++j) { float pv = (sv[sub][j] > -1.0e38f) ? __expf(sv[sub][j] - mx) : 0.f; sv[sub][j] = pv; ps += pv; }
      ps += shfl_xor_l(ps, 16, lane); ps += shfl_xor_l(ps, 32, lane);
      den = den * alpha + ps;
#pragma unroll
      for (int et = 0; et < 4; ++et) { ot[et][0] *= alpha; ot[et][1] *= alpha; ot[et][2] *= alpha; ot[et][3] *= alpha; }
      u32x4_t pbu = {pk2_sw(sv[0][0], sv[0][1]), pk2_sw(sv[0][2], sv[0][3]), pk2_sw(sv[1][0], sv[1][1]), pk2_sw(sv[1][2], sv[1][3])};
      const bf16x8 pb = __builtin_bit_cast(bf16x8, pbu);
      const u16* vb = Vs + (fq * 4 + (fr >> 2)) * 72 + 4 * (fr & 3);
#pragma unroll
      for (int et = 0; et < 4; ++et) ot[et] = mfma16(mk8(lds_tr16(vb + et * 16), lds_tr16(vb + 16 * 72 + et * 16)), pb, ot[et]);
    }
#undef DSWA_LOAD
    const float inv = 1.f / den;
#pragma unroll
    for (int et = 0; et < 4; ++et) {
      uint2 o; o.x = pk2(ot[et][0] * inv, ot[et][1] * inv); o.y = pk2(ot[et][2] * inv, ot[et][3] * inv);
      *(uint2*)(pj + (size_t)tokq * NPROJ + colq + et * 16 + fq * 4) = o;
    }
    if (fq == 0) c.lse[((size_t)bl * 4096 + tokq) * 12 + g * 4 + h] = mrun + __logf(den);
  }
}

DEVI void conv_item(const MixCtx& c, int item, unsigned char* smem) {
  const int tid = otid(c.wv), w = tid >> 6, lane = tid & 63;
  int bl = item >> 7, t0 = (item & 127) * 32;
  float* ys = (float*)smem; float* cs = ys + 62 * 256;
  const u16* pj = c.proj + (size_t)bl * 4096 * NPROJ;
#pragma unroll
  for (int q = 0; q < 4; ++q) {
    int ci = tid + 512 * q;
    if (ci < 62 * 32) {
      int i = ci >> 5, c8 = (ci & 31) * 8, t = t0 - 30 + i;
      float y[8];
      if (t >= 0) {
        float a[8], g[8];
        unpack8(*(const uint4*)(pj + (size_t)t * NPROJ + OFF_CONV + c8), a);
        unpack8(*(const uint4*)(pj + (size_t)t * NPROJ + OFF_CONV + 256 + c8), g);
#pragma unroll
        for (int e = 0; e < 8; ++e) y[e] = a[e] * sigmoidf_(g[e]);
      } else {
#pragma unroll
        for (int e = 0; e < 8; ++e) y[e] = 0.f;
      }
      *(float4*)(ys + i * 256 + c8) = make_float4(y[0], y[1], y[2], y[3]);
      *(float4*)(ys + i * 256 + c8 + 4) = make_float4(y[4], y[5], y[6], y[7]);
    }
  }
  __syncthreads();
  {
    int ch = tid & 255, tg = tid >> 8;
    float wj[31];
    const float* cw = KP(conv_w) + (size_t)c.l * 31 * 256 + ch;
#pragma unroll
    for (int j = 0; j < 31; ++j) wj[j] = cw[j * 256];
    float bias = KP(conv_b)[c.l * 256 + ch];
    float acc[16];
#pragma unroll
    for (int tl = 0; tl < 16; ++tl) acc[tl] = bias;
#pragma unroll
    for (int i = 0; i < 46; ++i) {
      float v = ys[(tg * 16 + i) * 256 + ch];
#pragma unroll
      for (int tl = 0; tl < 16; ++tl) { const int d = i - tl, dc = d < 0 ? 0 : (d > 30 ? 30 : d); if (d >= 0 && d <= 30) acc[tl] += wj[dc] * v; }
    }
#pragma unroll
    for (int tl = 0; tl < 16; ++tl) cs[(tg * 16 + tl) * 256 + ch] = acc[tl];
  }
  __syncthreads();
  const float* lng = KP(conv_ln_g) + c.l * 256; const float* lnb = KP(conv_ln_b) + c.l * 256;
#pragma unroll
  for (int q = 0; q < 4; ++q) {
    int tok = w * 4 + q;
    float v[4], s = 0.f;
#pragma unroll
    for (int i = 0; i < 4; ++i) { v[i] = cs[tok * 256 + lane + 64 * i]; s += v[i]; }
#pragma unroll
    for (int o = 1; o < 64; o <<= 1) s += shfl_xor_l(s, o, lane);
    float mu = s * (1.f / 256.f), s2 = 0.f;
#pragma unroll
    for (int i = 0; i < 4; ++i) { v[i] -= mu; s2 += v[i] * v[i]; }
#pragma unroll
    for (int o = 1; o < 64; o <<= 1) s2 += shfl_xor_l(s2, o, lane);
    float rs = rsqrtf(s2 * (1.f / 256.f) + EPS);
    u16* o = c.br + ((size_t)bl * 4096 + t0 + tok) * BRW + 256;
#pragma unroll
    for (int i = 0; i < 4; ++i) {
      int ch = lane + 64 * i;
      float y = v[i] * rs * lng[ch] + lnb[ch];
      o[ch] = f2bf(y * sigmoidf_(y));
    }
  }
}

DEVI void gla_cum8(const float (&xg)[8], float* segtot, float (&cum)[8], int tid) {
  const int lane = tid & 63, w = tid >> 6, kc = tid & 7;
#pragma unroll
  for (int j = 0; j < 8; ++j) cum[j] = logsigf_(xg[j]) * (1.f / 16.f);
#pragma unroll
  for (int j = 0; j < 8; ++j) {
    float o = shfl_up_l(cum[j], 8, lane); if (lane >= 8) cum[j] += o;
    o = shfl_up_l(cum[j], 16, lane); if (lane >= 16) cum[j] += o;
    o = shfl_up_l(cum[j], 32, lane); if (lane >= 32) cum[j] += o;
  }
  if (lane >= 56) {
    *(float4*)(segtot + w * 64 + kc * 8) = make_float4(cum[0], cum[1], cum[2], cum[3]);
    *(float4*)(segtot + w * 64 + kc * 8 + 4) = make_float4(cum[4], cum[5], cum[6], cum[7]);
  }
  __syncthreads();
#pragma unroll
  for (int ww = 0; ww < 7; ++ww) {
    float4 a = *(const float4*)(segtot + ww * 64 + kc * 8), b = *(const float4*)(segtot + ww * 64 + kc * 8 + 4);
    if (ww < w) { cum[0] += a.x; cum[1] += a.y; cum[2] += a.z; cum[3] += a.w; cum[4] += b.x; cum[5] += b.y; cum[6] += b.z; cum[7] += b.w; }
  }
}

DEVI void gla_gate8(const float4 (&gl)[4], const float* wgS, const float* bgp, int kc, float (&xg)[8]) {
  const float g[16] = {gl[0].x, gl[0].y, gl[0].z, gl[0].w, gl[1].x, gl[1].y, gl[1].z, gl[1].w, gl[2].x, gl[2].y, gl[2].z, gl[2].w, gl[3].x, gl[3].y, gl[3].z, gl[3].w};
#pragma unroll
  for (int j = 0; j < 8; ++j) xg[j] = bgp[kc * 8 + j];
#pragma unroll
  for (int r = 0; r < 16; ++r) {
    float4 a = *(const float4*)(wgS + r * 64 + kc * 8), b = *(const float4*)(wgS + r * 64 + kc * 8 + 4);
    xg[0] += g[r] * a.x; xg[1] += g[r] * a.y; xg[2] += g[r] * a.z; xg[3] += g[r] * a.w;
    xg[4] += g[r] * b.x; xg[5] += g[r] * b.y; xg[6] += g[r] * b.z; xg[7] += g[r] * b.w;
  }
}

DEVI void gla_local_item(const MixCtx& c, int unit, unsigned char* smem) {
  const int tid = otid(c.wv), w = tid >> 6, lane = tid & 63, fr = lane & 15, fq = lane >> 4;
  int ch = unit & 63, h = (unit >> 6) & 3, bl = unit >> 8, tok0 = ch * 64;
  float* segtot = (float*)smem;
  u16* keS = (u16*)(smem + 2048);
  u16* vS = (u16*)(smem + 20480);
  const u16* pj = c.proj + (size_t)bl * 4096 * NPROJ;
  const float* bgp = KP(gla_b_gate) + c.l * 256 + h * 64;
  const int t = tid >> 3, kc = tid & 7;
  const float4* glp = (const float4*)(c.glow + ((size_t)bl * 4096 + tok0 + t) * 256 + h * 64 + kc * 8);
  const float4 xg0 = glp[0], xg1 = glp[1];
  uint4 kraw = *(const uint4*)(pj + (size_t)(tok0 + t) * NPROJ + OFF_CK + h * 64 + kc * 8);
  const uint4 vraw0 = *(const uint4*)(pj + (size_t)(tok0 + (tid >> 4)) * NPROJ + OFF_CV + h * 128 + (tid & 15) * 8);
  const uint4 vraw1 = *(const uint4*)(pj + (size_t)(tok0 + 32 + (tid >> 4)) * NPROJ + OFF_CV + h * 128 + (tid & 15) * 8);
  const float xg[8] = {xg0.x, xg0.y, xg0.z, xg0.w, xg1.x, xg1.y, xg1.z, xg1.w};
  float cum[8];
  gla_cum8(xg, segtot, cum, tid);
  {
    float last[8];
#pragma unroll
    for (int j = 0; j < 8; ++j) last[j] = 0.f;
#pragma unroll
    for (int ww = 0; ww < 8; ++ww) {
      float4 a = *(const float4*)(segtot + ww * 64 + kc * 8), b = *(const float4*)(segtot + ww * 64 + kc * 8 + 4);
      last[0] += a.x; last[1] += a.y; last[2] += a.z; last[3] += a.w; last[4] += b.x; last[5] += b.y; last[6] += b.z; last[7] += b.w;
    }
    float kv[8]; unpack8(kraw, kv);
    uint4 o;
    o.x = pk2(kv[0] * __expf(last[0] - cum[0]), kv[1] * __expf(last[1] - cum[1])); o.y = pk2(kv[2] * __expf(last[2] - cum[2]), kv[3] * __expf(last[3] - cum[3]));
    o.z = pk2(kv[4] * __expf(last[4] - cum[4]), kv[5] * __expf(last[5] - cum[5])); o.w = pk2(kv[6] * __expf(last[6] - cum[6]), kv[7] * __expf(last[7] - cum[7]));
    *(uint4*)(keS + t * 72 + kc * 8) = o;
    if (tid < 8) {
      float4 e0 = make_float4(__expf(last[0]), __expf(last[1]), __expf(last[2]), __expf(last[3])), e1 = make_float4(__expf(last[4]), __expf(last[5]), __expf(last[6]), __expf(last[7]));
      *(float4*)(c.gdec + (size_t)unit * 64 + kc * 8) = e0; *(float4*)(c.gdec + (size_t)unit * 64 + kc * 8 + 4) = e1;
    }
    *(uint4*)(vS + (tid >> 4) * 136 + (tid & 15) * 8) = vraw0;
    *(uint4*)(vS + (32 + (tid >> 4)) * 136 + (tid & 15) * 8) = vraw1;
  }
  __syncthreads();
  bf16x8 af[2];
#pragma unroll
  for (int ks = 0; ks < 2; ++ks) {
    const u16* vb = vS + (ks * 32 + fq * 8 + (fr >> 2)) * 136 + 16 * w + 4 * (fr & 3);
    af[ks] = mk8(lds_tr16(vb), lds_tr16(vb + 4 * 136));
  }
  float* S = c.S + (size_t)unit * 8192;
#pragma unroll
  for (int jt = 0; jt < 4; ++jt) {
    f32x4 a = {0.f, 0.f, 0.f, 0.f};
#pragma unroll
    for (int ks = 0; ks < 2; ++ks) {
      const u16* kb = keS + (ks * 32 + fq * 8 + (fr >> 2)) * 72 + 16 * jt + 4 * (fr & 3);
      a = mfma16(af[ks], mk8(lds_tr16(kb), lds_tr16(kb + 4 * 72)), a);
    }
#pragma unroll
    for (int j = 0; j < 4; ++j) S[(16 * w + fq * 4 + j) * 64 + 16 * jt + fr] = a[j];
  }
}

DEVI void gla_scan_phase(const MixCtx& c) {
  long gtid = (long)oblk() * 512 + otid(c.wv), gsz = (long)ogrd() * 512;
  for (long idx = gtid; idx < 16L * 8192; idx += gsz) {
    int bh = (int)(idx >> 13), e = (int)(idx & 8191), k = e & 63;
    float* __restrict__ S = c.S + (size_t)bh * 64 * 8192 + e;
    const float* __restrict__ gd = c.gdec + (size_t)bh * 64 * 64 + k;
    float run = 0.f;
    for (int c0 = 0; c0 < 64; c0 += 32) {
      float loc[32], g[32];
#pragma unroll
      for (int i = 0; i < 32; ++i) { loc[i] = S[(size_t)(c0 + i) * 8192]; g[i] = gd[(c0 + i) * 64]; }
#pragma unroll
      for (int i = 0; i < 32; ++i) { S[(size_t)(c0 + i) * 8192] = run; run = g[i] * run + loc[i]; }
    }
  }
}

DEVI void gla_tok0_partials(const MixCtx& c) {
  const int tid = otid(c.wv), w = tid >> 6, lane = tid & 63;
  float* c0p = (float*)(KWS() + O_C0);
  for (int wi = oblk() * 8 + w; wi < 512; wi += ogrd() * 8) {
    int ks = wi & 15, qk = (wi >> 4) & 1, h = (wi >> 5) & 3, bl = wi >> 7, b = c.hf * 4 + bl;
    const float* xr = ((c.l == 0) ? KP(x) : (const float*)KOUT()) + (size_t)b * 4096 * 1024;
    const float* mf = (const float*)(KWS() + O_MODF) + ((size_t)c.l * 8 + b) * 6144;
    float ss = 0.f;
#pragma unroll
    for (int j = 0; j < 4; ++j) { float4 v = ((const float4*)xr)[lane + 64 * j]; ss += v.x * v.x + v.y * v.y + v.z * v.z + v.w * v.w; }
#pragma unroll
    for (int o = 1; o < 64; o <<= 1) ss += shfl_xor_l(ss, o, lane);
    float rs = rsqrtf(ss * (1.f / 1024.f) + EPS);
    int i0 = ks * 64 + lane;
    float h0 = xr[i0] * rs * mf[i0] + mf[1024 + i0];
    const float* wp = KP(w_in) + (size_t)c.l * 1024 * INW + (size_t)(ks * 64) * INW + (qk ? 3072 : 2816) + h * 64 + lane;
    float a = 0.f;
    float wrow[64];
#pragma unroll
    for (int i = 0; i < 64; ++i) wrow[i] = wp[(size_t)i * INW];
#pragma unroll
    for (int i = 0; i < 64; ++i) a += shfl_l(h0, i) * wrow[i];
    c0p[(size_t)wi * 64 + lane] = a;
  }
}

#define GLA_OUT_LOAD(U)                                                                                                  \
  {                                                                                                                        \
    const int ch_ = (U) & 63, h_ = ((U) >> 6) & 3, bl_ = (U) >> 8, tok0_ = ch_ * 64;                                        \
    const u16* pj_ = c.proj + (size_t)bl_ * 4096 * NPROJ;                                                                  \
    const u16* rowp_ = pj_ + (size_t)(tok0_ + t) * NPROJ + h_ * 64 + kc * 8;                                                \
    qraw = *(const uint4*)(rowp_ + OFF_CQ); kraw = *(const uint4*)(rowp_ + OFF_CK);                                         \
    const float4* glp_ = (const float4*)(c.glow + ((size_t)bl_ * 4096 + tok0_ + t) * 256 + h_ * 64 + kc * 8);               \
    xg0 = glp_[0]; xg1 = glp_[1];                                                                                          \
    vraw0 = *(const uint4*)(pj_ + (size_t)(tok0_ + (tid >> 4)) * NPROJ + OFF_CV + h_ * 128 + (tid & 15) * 8);               \
    vraw1 = *(const uint4*)(pj_ + (size_t)(tok0_ + 32 + (tid >> 4)) * NPROJ + OFF_CV + h_ * 128 + (tid & 15) * 8);          \
    rraw0 = *(const uint4*)(pj_ + (size_t)(tok0_ + t) * NPROJ + OFF_CR + h_ * 128 + kc * 16);                               \
    rraw1 = *(const uint4*)(pj_ + (size_t)(tok0_ + t) * NPROJ + OFF_CR + h_ * 128 + kc * 16 + 8);                           \
    const float4* Sg_ = (const float4*)(c.S + (size_t)(U) * 8192);                                                          \
    sraw0 = Sg_[tid]; sraw1 = Sg_[tid + 512]; sraw2 = Sg_[tid + 1024]; sraw3 = Sg_[tid + 1536];                             \
  }

DEVI void gla_out_phase(const MixCtx& c, unsigned char* smem) {
  const int tid = otid(c.wv), w = tid >> 6, lane = tid & 63, fr = lane & 15, fq = lane >> 4;
  float* segtot = (float*)smem;
  u16* qt = (u16*)(smem + 2048); u16* kt = (u16*)(smem + 11264); u16* vS = (u16*)(smem + 20480);
  u16* stT = (u16*)(smem + 37888); u16* att = (u16*)(smem + 56320); float* oS = (float*)(smem + 65536);
  const float* og = KP(gla_o_gain) + c.l * 128;
  const float* c0p = (const float*)(KWS() + O_C0);
  const int t = tid >> 3, kc = tid & 7;
  const int Gd = ogrd();
  uint4 qraw, kraw, vraw0, vraw1, rraw0, rraw1; float4 xg0, xg1, sraw0, sraw1, sraw2, sraw3;
  int unit = oblk();
  if (unit < 1024) GLA_OUT_LOAD(unit)
  for (; unit < 1024; unit += Gd) {
  const int ch = unit & 63, h = (unit >> 6) & 3, bl = unit >> 8, tok0 = ch * 64;
  const float xg[8] = {xg0.x, xg0.y, xg0.z, xg0.w, xg1.x, xg1.y, xg1.z, xg1.w};
  float cum[8];
  gla_cum8(xg, segtot, cum, tid);
  {
    float qv[8], kv[8]; unpack8(qraw, qv); unpack8(kraw, kv);
    float eq[8], ek[8];
#pragma unroll
    for (int j = 0; j < 8; ++j) { float e = __expf(cum[j]); eq[j] = qv[j] * 0.125f * e; ek[j] = kv[j] * __expf(-cum[j]); }
    uint4 o;
    o.x = pk2(eq[0], eq[1]); o.y = pk2(eq[2], eq[3]); o.z = pk2(eq[4], eq[5]); o.w = pk2(eq[6], eq[7]);
    *(uint4*)(qt + t * 72 + kc * 8) = o;
    o.x = pk2(ek[0], ek[1]); o.y = pk2(ek[2], ek[3]); o.z = pk2(ek[4], ek[5]); o.w = pk2(ek[6], ek[7]);
    *(uint4*)(kt + t * 72 + kc * 8) = o;
    *(uint4*)(vS + (tid >> 4) * 136 + (tid & 15) * 8) = vraw0;
    *(uint4*)(vS + (32 + (tid >> 4)) * 136 + (tid & 15) * 8) = vraw1;
    *(uint2*)(stT + (tid >> 4) * 72 + (tid & 15) * 4) = make_uint2(pk2(sraw0.x, sraw0.y), pk2(sraw0.z, sraw0.w));
    *(uint2*)(stT + (32 + (tid >> 4)) * 72 + (tid & 15) * 4) = make_uint2(pk2(sraw1.x, sraw1.y), pk2(sraw1.z, sraw1.w));
    *(uint2*)(stT + (64 + (tid >> 4)) * 72 + (tid & 15) * 4) = make_uint2(pk2(sraw2.x, sraw2.y), pk2(sraw2.z, sraw2.w));
    *(uint2*)(stT + (96 + (tid >> 4)) * 72 + (tid & 15) * 4) = make_uint2(pk2(sraw3.x, sraw3.y), pk2(sraw3.z, sraw3.w));
  }
  __syncthreads();
  const uint4 rc0 = rraw0, rc1 = rraw1;
  if (unit + Gd < 1024) GLA_OUT_LOAD(unit + Gd)
  {
    int it = w >> 1;
    bf16x8 af[2];
#pragma unroll
    for (int ks = 0; ks < 2; ++ks) af[ks] = *(const bf16x8*)(qt + (16 * it + fr) * 72 + ks * 32 + fq * 8);
#pragma unroll
    for (int jj = 0; jj < 2; ++jj) {
      int jt = 2 * (w & 1) + jj;
      f32x4 a = {0.f, 0.f, 0.f, 0.f};
#pragma unroll
      for (int ks = 0; ks < 2; ++ks) a = mfma16(af[ks], *(const bf16x8*)(kt + (16 * jt + fr) * 72 + ks * 32 + fq * 8), a);
#pragma unroll
      for (int j = 0; j < 4; ++j) { int tt = 16 * it + fq * 4 + j, ss = 16 * jt + fr; att[tt * 72 + ss] = f2bf(ss <= tt ? a[j] : 0.f); }
    }
  }
  __syncthreads();
  {
    int it = w >> 1;
    bf16x8 a1[2], a2[2];
#pragma unroll
    for (int ks = 0; ks < 2; ++ks) { a1[ks] = *(const bf16x8*)(att + (16 * it + fr) * 72 + ks * 32 + fq * 8); a2[ks] = *(const bf16x8*)(qt + (16 * it + fr) * 72 + ks * 32 + fq * 8); }
#pragma unroll
    for (int jj = 0; jj < 4; ++jj) {
      int jt = 4 * (w & 1) + jj;
      f32x4 a = {0.f, 0.f, 0.f, 0.f};
#pragma unroll
      for (int ks = 0; ks < 2; ++ks) {
        const u16* vb = vS + (ks * 32 + fq * 8 + (fr >> 2)) * 136 + 16 * jt + 4 * (fr & 3);
        a = mfma16(a1[ks], mk8(lds_tr16(vb), lds_tr16(vb + 4 * 136)), a);
        a = mfma16(a2[ks], *(const bf16x8*)(stT + (16 * jt + fr) * 72 + ks * 32 + fq * 8), a);
      }
#pragma unroll
      for (int j = 0; j < 4; ++j) oS[(16 * it + fq * 4 + j) * 132 + 16 * jt + fr] = a[j];
    }
  }
  __syncthreads();
  if (ch == 0) {
    const float* cp = c0p + (size_t)((bl * 4 + h) * 2) * 16 * 64;
    float qv = 0.f, kv = 0.f;
#pragma unroll
    for (int ks = 0; ks < 16; ++ks) { qv += cp[ks * 64 + lane]; kv += cp[1024 + ks * 64 + lane]; }
    float pr = qv * kv;
#pragma unroll
    for (int o = 1; o < 64; o <<= 1) pr += shfl_xor_l(pr, o, lane);
    if (tid < 128) oS[tid] = pr * 0.125f * bf2f(vS[tid]);
    __syncthreads();
  }
  {
    const float* ogp = og + kc * 16;
    float ov[16];
#pragma unroll
    for (int i = 0; i < 4; ++i) { float4 a = *(const float4*)(oS + t * 132 + kc * 16 + 4 * i); ov[4 * i] = a.x; ov[4 * i + 1] = a.y; ov[4 * i + 2] = a.z; ov[4 * i + 3] = a.w; }
    float ss = 0.f;
#pragma unroll
    for (int i = 0; i < 16; ++i) ss += ov[i] * ov[i];
    ss += shfl_xor_l(ss, 1, lane); ss += shfl_xor_l(ss, 2, lane); ss += shfl_xor_l(ss, 4, lane);
    float rs = rsqrtf(ss * (1.f / 128.f) + EPS);
    u16* op = c.br + ((size_t)bl * 4096 + tok0 + t) * BRW + 512 + h * 128 + kc * 16;
#pragma unroll
    for (int i = 0; i < 2; ++i) {
      float r[8]; unpack8(i ? rc1 : rc0, r);
      float y[8];
#pragma unroll
      for (int e = 0; e < 8; ++e) y[e] = ov[8 * i + e] * rs * ogp[8 * i + e] * r[e] * sigmoidf_(r[e]);
      uint4 o; o.x = pk2(y[0], y[1]); o.y = pk2(y[2], y[3]); o.z = pk2(y[4], y[5]); o.w = pk2(y[6], y[7]);
      *(uint4*)(op + 8 * i) = o;
    }
  }
  __syncthreads();
  }
}
#undef GLA_OUT_LOAD

DEVI void dswa_merge_phase(const MixCtx& c) {
  long gtid = (long)oblk() * 512 + otid(c.wv), gsz = (long)ogrd() * 512;
  for (long idx0 = gtid; idx0 < (long)MH * 32; idx0 += 2 * gsz) {
    float l0[2], l1[2], l2[2]; uint4 ra[2], rb[2], rd[2]; bool ok[2];
#pragma unroll
    for (int q = 0; q < 2; ++q) {
      const long idx = idx0 + q * gsz; ok[q] = idx < (long)MH * 32;
      const long ii = ok[q] ? idx : idx0;
      const long tok = ii >> 5; const int chunk = (int)(ii & 31), h = chunk >> 3, e0 = (chunk & 7) * 8;
      const float* ls = c.lse + tok * 12 + h;
      l0[q] = ls[0]; l1[q] = ls[4]; l2[q] = ls[8];
      const u16* pr = c.proj + tok * NPROJ + h * 64 + e0;
      ra[q] = *(const uint4*)(pr); rb[q] = *(const uint4*)(pr + 256); rd[q] = *(const uint4*)(pr + 512);
    }
#pragma unroll
    for (int q = 0; q < 2; ++q) {
      if (!ok[q]) continue;
      const long idx = idx0 + q * gsz;
      const long tok = idx >> 5; const int chunk = (int)(idx & 31), h = chunk >> 3, e0 = (chunk & 7) * 8;
      float m = fmaxf(l0[q], fmaxf(l1[q], l2[q]));
      float w0 = __expf(l0[q] - m), w1 = __expf(l1[q] - m), w2 = __expf(l2[q] - m), inv = 1.f / (w0 + w1 + w2);
      w0 *= inv; w1 *= inv; w2 *= inv;
      float a[8], b[8], d[8];
      unpack8(ra[q], a); unpack8(rb[q], b); unpack8(rd[q], d);
      uint4 o;
      o.x = pk2(w0 * a[0] + w1 * b[0] + w2 * d[0], w0 * a[1] + w1 * b[1] + w2 * d[1]);
      o.y = pk2(w0 * a[2] + w1 * b[2] + w2 * d[2], w0 * a[3] + w1 * b[3] + w2 * d[3]);
      o.z = pk2(w0 * a[4] + w1 * b[4] + w2 * d[4], w0 * a[5] + w1 * b[5] + w2 * d[5]);
      o.w = pk2(w0 * a[6] + w1 * b[6] + w2 * d[6], w0 * a[7] + w1 * b[7] + w2 * d[7]);
      *(uint4*)(c.br + tok * BRW + h * 64 + e0) = o;
    }
  }
}

#define XB_TMO      128
#define XB_XCNT(j)  (256  + 64 * (j))
#define XB_XSUB(j)  (1280 + 64 * (j))
#define XB_XGEN(j)  (2304 + 64 * (j))
#define XB_TOP      3328
#define XB_TOPGEN   3392
#define XCD_BAR_WORDS 3456
#define XB_SPIN_CAP (1u << 22)
#define LAS __attribute__((address_space(3)))
DEVI unsigned xb_ld(unsigned* p) { return __hip_atomic_load(p, __ATOMIC_RELAXED, __HIP_MEMORY_SCOPE_AGENT); }
DEVI unsigned xb_add(unsigned* p, unsigned v) { return __hip_atomic_fetch_add(p, v, __ATOMIC_RELAXED, __HIP_MEMORY_SCOPE_AGENT); }
DEVI unsigned xb_xcc_id() { return (unsigned)__builtin_amdgcn_s_getreg((3 << 11) | 20) & 0xFu; }
#define XB_SPIN(cond, bar) do { unsigned _sp = 0; while (cond) { __builtin_amdgcn_s_sleep(1); \
    if ((++_sp & 255u) == 0u) { if (xb_ld(&(bar)[XB_TMO])) break; if (_sp > XB_SPIN_CAP) { atomicAdd(&(bar)[XB_TMO], 1u); break; } } } } while (0)

DEVI void xb_complete(unsigned* bar, unsigned x, unsigned G, unsigned& nloc, unsigned& nx) {
  unsigned sum, cnt, mine, sp = 0u;
  for (;;) {
    sum = 0u; cnt = 0u; mine = 0u;
#pragma unroll
    for (unsigned j = 0; j < 16; ++j) { const unsigned cc = xb_ld(&bar[XB_XCNT(j)]); sum += cc; cnt += (cc > 0u) ? 1u : 0u; mine = (j == x) ? cc : mine; }
    if (sum == G) break;
    __builtin_amdgcn_s_sleep(1);
    if ((++sp & 255u) == 0u) { if (xb_ld(&bar[XB_TMO])) break; if (sp > XB_SPIN_CAP) { atomicAdd(&bar[XB_TMO], 1u); break; } }
  }
  nloc = mine > 0u ? mine : 1u; nx = cnt > 0u ? cnt : 1u;
}

DEVI void gbar1(int wv, unsigned& nbar, unsigned char* smem) {
  asm volatile("s_waitcnt vmcnt(0)" ::: "memory");
  __syncthreads();
  unsigned* bar = (unsigned*)(KWS() + O_BAR);
  const unsigned x = xb_xcc_id();
  if (otid(wv) == 0) {
    volatile LAS unsigned* st = (volatile LAS unsigned*)(smem + 131072);
    __builtin_amdgcn_s_waitcnt(0);
    unsigned nloc = st[0], nx = st[1];
    if (nloc == 0u) { xb_complete(bar, x, (unsigned)ogrd(), nloc, nx); st[0] = nloc; st[1] = nx; }
    const unsigned old = xb_add(&bar[XB_XSUB(x)], 1u);
    const unsigned gen = old / nloc;
    if (old + 1u == (gen + 1u) * nloc) {
      __builtin_amdgcn_fence(__ATOMIC_RELEASE, "agent");
      asm volatile("s_waitcnt vmcnt(0)" ::: "memory");
      const unsigned og = xb_add(&bar[XB_TOP], 1u);
      const unsigned tg = og / nx;
      if (og + 1u == (tg + 1u) * nx) xb_add(&bar[XB_TOPGEN], 1u);
      else XB_SPIN(xb_ld(&bar[XB_TOPGEN]) == tg, bar);
      __builtin_amdgcn_fence(__ATOMIC_ACQUIRE, "agent");
      xb_add(&bar[XB_XGEN(x)], 1u);
      asm volatile("s_waitcnt vmcnt(0)" ::: "memory");
    } else {
      XB_SPIN(xb_ld(&bar[XB_XGEN(x)]) == gen, bar);
      __builtin_amdgcn_fence(__ATOMIC_ACQUIRE, "agent");
      asm volatile("s_waitcnt vmcnt(0)" ::: "memory");
    }
  }
  __syncthreads();
}
DEVI void gbar(int wv, unsigned& nbar, unsigned char* smem) { PREP(7) gbar1(wv, nbar, smem); }

__global__ void __launch_bounds__(512) mega(Params p_unused) {
  extern __shared__ __attribute__((aligned(16))) unsigned char smem[];
  cg::grid_group grid = cg::this_grid();
  u16* shm = (u16*)smem;
  unsigned nbar = 0;
  const int wv = __builtin_amdgcn_readfirstlane((int)(threadIdx.x >> 6));
  {
    unsigned* bar0 = (unsigned*)(KWS() + O_BAR);
    const unsigned xcc0 = xb_xcc_id();
    if (otid(wv) == 0) {
      volatile LAS unsigned* st = (volatile LAS unsigned*)(smem + 131072);
      st[0] = 0u; st[1] = 0u;
      (void)xb_add(bar0 + XB_XCNT(xcc0), 1u);
    }
  }
  __syncthreads();

  PREP(0) prep_phase(wv, smem);
  grid.sync();
  PREP(0) modfinal_phase(wv);
  gbar(wv, nbar, smem);

  for (int l = 0; l < NL; ++l) {
    for (int hf = 0; hf < 2; ++hf) {
      const int row0 = hf * MH;
      const size_t o_h = (hf == 0) ? O_H : O_BR;
      if (hf == 0) {
        unsigned char* ws = KWS();
        const float* xin = (l == 0) ? KP(x) : (const float*)KOUT();
        PREP(1) norm_phase(wv, xin, row0, MH, (const float*)(ws + O_MODF) + (size_t)l * 8 * 6144, 0, (u16*)(ws + O_H));
        gbar(wv, nbar, smem);
      }
      {
        unsigned char* ws = KWS();
        EpiBf16 e; e.C = (u16*)(ws + O_PROJ); e.ldc = NPROJ; e.relu2 = 0;
        PREP(2) gemm_phase<1024>(wv, shm, (const u16*)(ws + o_h), (const u16*)(ws + O_WT) + (size_t)l * WT_L + WT_IN, MH, NPROJ, 1024, e);
        glow_phase(wv, l, (const u16*)(ws + o_h), (const u16*)(ws + O_WT) + (size_t)l * WT_L + WT_LOW, (float*)(ws + O_GLOW));
      }
      gbar(wv, nbar, smem);
      {
        MixCtx c = make_ctx(wv, l, hf);
        dswa_block_phase(c, smem);
        for (int it = oblk(); it < 1024 + 512; it += ogrd()) {
          if (it < 1024) gla_local_item(c, it, smem);
          else conv_item(c, it - 1024, smem);
          __syncthreads();
        }
        PREP(10) sb_wave_phase(c, smem);
        gla_tok0_partials(c);
      }
      gbar(wv, nbar, smem);
      { MixCtx c = make_ctx(wv, l, hf); gla_scan_phase(c); }
      gbar(wv, nbar, smem);
      {
        MixCtx c = make_ctx(wv, l, hf);
        PREP(4) { gla_out_phase(c, smem);
        dswa_merge_phase(c); }
      }
      gbar(wv, nbar, smem);
      {
        unsigned char* ws = KWS();
        PREP(5) branch_phase(wv, shm, (const u16*)(ws + O_BR), (const u16*)(ws + O_WT) + (size_t)l * WT_L + WT_BR, (const u16*)(ws + O_PROJ), (u16*)(ws + O_S));
      }
      gbar(wv, nbar, smem);
      {
        unsigned char* ws = KWS();
        EpiRes e; e.xin = (l == 0) ? KP(x) : (const float*)KOUT(); e.xout = KOUT(); e.gate = (const float*)(ws + O_MODF) + (size_t)l * 8 * 6144 + 2048; e.row0 = row0;
        gemm_phase<1024>(wv, shm, (const u16*)(ws + O_S), (const u16*)(ws + O_WT) + (size_t)l * WT_L + WT_OUT, MH, 1024, 1024, e);
        if (hf == 0) {
          const float* xin2 = (l == 0) ? KP(x) : (const float*)KOUT();
          norm_phase(wv, xin2, MH, MH, (const float*)(ws + O_MODF) + (size_t)l * 8 * 6144, 0, (u16*)(ws + O_BR));
        }
      }
      gbar(wv, nbar, smem);
    }
    {
      unsigned char* ws = KWS();
      PREP(1) norm_phase(wv, (const float*)KOUT(), 0, MTOK, (const float*)(ws + O_MODF) + (size_t)l * 8 * 6144, 3, (u16*)(ws + O_BR));
    }
    gbar(wv, nbar, smem);
    for (int hh = 0; hh < 2; ++hh) {
      {
        unsigned char* ws = KWS();
        EpiBf16 e; e.C = (u16*)(ws + O_PROJ) + (size_t)hh * MH * 4096; e.ldc = 4096; e.relu2 = 1;
        PREP(6) gemm_phase<1024>(wv, shm, (const u16*)(ws + O_BR) + (size_t)hh * MH * 1024, (const u16*)(ws + O_WT) + (size_t)l * WT_L + WT_UP, MH, 4096, 1024, e);
      }
      gbar(wv, nbar, smem);
      {
        unsigned char* ws = KWS();
        EpiRes e; e.xin = (const float*)KOUT(); e.xout = KOUT(); e.gate = (const float*)(ws + O_MODF) + (size_t)l * 8 * 6144 + 5120; e.row0 = hh * MH;
        gemm_phase<4096>(wv, shm, (const u16*)(ws + O_PROJ) + (size_t)hh * MH * 4096, (const u16*)(ws + O_WT) + (size_t)l * WT_L + WT_DOWN, MH, 1024, 4096, e);
      }
    }
    gbar(wv, nbar, smem);
  }
}

extern "C" void kernel_launch(void* const* d_in, const int* in_sizes, int n_in,
                              void* d_out, int out_size, void* d_ws, size_t ws_size,
                              hipStream_t stream) {
  static int grid_blocks = 0;
  if (!grid_blocks) {
    int dev = 0, cus = 0, per_cu = 0;
    (void)hipGetDevice(&dev);
    (void)hipDeviceGetAttribute(&cus, hipDeviceAttributeMultiprocessorCount, dev);
    (void)hipFuncSetAttribute((const void*)mega, hipFuncAttributeMaxDynamicSharedMemorySize, LDS_BYTES);
    (void)hipOccupancyMaxActiveBlocksPerMultiprocessor(&per_cu, (const void*)mega, 512, LDS_BYTES);
    if (per_cu < 1) per_cu = 1;
    grid_blocks = cus * 1;
    if (ws_size < WS_END) fprintf(stderr, "kernel_launch: workspace too small: %zu < %zu\n", ws_size, (size_t)WS_END);
  }
  (void)hipMemsetAsync((unsigned char*)d_ws + O_BAR, 0, 16384, stream);
  Params p{};
  const float** pp = (const float**)&p;
  for (int i = 0; i < 23; ++i) pp[i] = (const float*)d_in[i];
  p.out = (float*)d_out; p.ws = (unsigned char*)d_ws;
  void* args[] = {&p};
  hipError_t e = hipLaunchCooperativeKernel((void*)mega, dim3(grid_blocks), dim3(512), args, LDS_BYTES, stream);
  if (e != hipSuccess) fprintf(stderr, "cooperative launch failed: %s (grid %d)\n", hipGetErrorString(e), grid_blocks);
}
```

```cpp
#include <hip/hip_runtime.h>
#include <hip/hip_bf16.h>
#include <hip/hip_cooperative_groups.h>
#include <cstdio>
namespace cg = cooperative_groups;

#define DEVI __device__ __forceinline__
typedef unsigned short u16;
using bf16x8 = __attribute__((ext_vector_type(8))) short;
using bf16x4 = __attribute__((ext_vector_type(4))) short;
using f32x4 = __attribute__((ext_vector_type(4))) float;

constexpr int DM = 1024, NB = 8, SEQ = 4096, MTOK = NB * SEQ, NL = 2;
constexpr int MH = MTOK / 2;
constexpr int INW = 9232;
constexpr int NPROJ = 9216;
constexpr int OFF_AQ = 0, OFF_AK = 768, OFF_AV = 1536, OFF_CONV = 2304, OFF_CQ = 2816, OFF_CK = 3072, OFF_CV = 3328,
              OFF_CR = 3840, OFF_DQ = 4352, OFF_DK = 4608, OFF_DV = 4864, OFF_GATE = 5120;
constexpr int BRW = 1280;
constexpr float EPS = 1e-6f;

constexpr size_t WT_IN = 0, WT_BR = (size_t)NPROJ * 1024, WT_OUT = WT_BR + 1024 * 1280, WT_UP = WT_OUT + 1024 * 1024,
                 WT_DOWN = WT_UP + 4096 * 1024, WT_LOW = WT_DOWN + 1024 * 4096, WT_L = WT_LOW + 16 * 1024;
constexpr size_t O_WT = 0;
constexpr size_t O_MODP = O_WT + 2 * WT_L * 2;
constexpr size_t O_MODF = O_MODP + (size_t)2 * 16 * 8 * 6144 * 4;
constexpr size_t O_LSE = O_MODF + (size_t)2 * 8 * 6144 * 4;
constexpr size_t O_GDEC = O_LSE + (size_t)MH * 12 * 4;
constexpr size_t O_H = O_GDEC + (size_t)1024 * 64 * 4;
constexpr size_t O_PROJ = O_H + (size_t)MH * 1024 * 2;
constexpr size_t O_BR = O_PROJ + (size_t)MH * NPROJ * 2;
constexpr size_t O_S = O_BR + (size_t)MH * BRW * 2;
constexpr size_t O_BAR = O_S + (size_t)1024 * 8192 * 4;
constexpr size_t O_C0 = O_BAR + 16384;
constexpr size_t O_GLOW = O_C0 + (size_t)16 * 2 * 16 * 64 * 4;
constexpr size_t WS_END = O_GLOW + (size_t)MH * 256 * 4;

constexpr int LDS_BYTES = 131072 + 16;
#ifndef PROBE
#define PROBE 0
#endif
#define PREP(bit) for (int _rep = 0; _rep < (((PROBE) >> (bit)) & 1) + 1; ++_rep)

struct Params {
  const float *x, *c, *w_ada, *b_ada, *g_mix, *w_in, *q_gain, *k_gain, *conv_w, *conv_b, *conv_ln_g, *conv_ln_b,
      *gla_w_gate, *gla_b_gate, *gla_o_gain, *w_br_a, *w_br_b, *w_br_c, *w_br_d, *w_out, *g_mlp, *w_up, *w_down;
  float* out;
  unsigned char* ws;
};

template <int OFF> DEVI const void* kptr() {
  unsigned long long r;
  auto ka = __builtin_amdgcn_kernarg_segment_ptr();
  asm volatile("s_load_dwordx2 %0, %1, %2\n\ts_waitcnt lgkmcnt(0)" : "=s"(r) : "s"(ka), "i"(OFF) : "memory");
  return (const void*)(__attribute__((address_space(1))) const void*)r;
}
#define KP(field) ((const float*)kptr<(int)offsetof(Params, field)>())
#define KWS() ((unsigned char*)kptr<(int)offsetof(Params, ws)>())
#define KOUT() ((float*)kptr<(int)offsetof(Params, out)>())

DEVI int otid(int wv) { int z = 0; asm volatile("" : "+v"(z)); int lane = __builtin_amdgcn_mbcnt_hi(-1, __builtin_amdgcn_mbcnt_lo(-1, z)); return wv * 64 + lane; }
DEVI int oblk() { int b = blockIdx.x; asm volatile("" : "+s"(b)); return b; }
DEVI int ogrd() { int g = gridDim.x; asm volatile("" : "+s"(g)); return g; }

DEVI float shfl_l(float v, int src) { return __int_as_float(__builtin_amdgcn_ds_bpermute(src << 2, __float_as_int(v))); }
DEVI float shfl_xor_l(float v, int k, int lane) { return shfl_l(v, lane ^ k); }
DEVI float shfl_up_l(float v, int d, int lane) { return shfl_l(v, lane >= d ? lane - d : lane); }

DEVI u16 f2bf(float f) { unsigned r; asm("v_cvt_pk_bf16_f32 %0, %1, %1" : "=v"(r) : "v"(f)); return (u16)(r & 0xffffu); }
DEVI float bf2f(u16 h) { return __uint_as_float(((unsigned)h) << 16); }
DEVI unsigned pk2(float a, float b) { unsigned r; asm("v_cvt_pk_bf16_f32 %0, %1, %2" : "=v"(r) : "v"(a), "v"(b)); return r; }
DEVI unsigned pk2_sw(float a, float b) {
  unsigned ua = __float_as_uint(a), ub = __float_as_uint(b);
  ua += 0x7fffu + ((ua >> 16) & 1u); ub += 0x7fffu + ((ub >> 16) & 1u);
  return (ua >> 16) | (ub & 0xffff0000u);
}
DEVI float bflo(unsigned u) { return __uint_as_float(u << 16); }
DEVI float bfhi(unsigned u) { return __uint_as_float(u & 0xffff0000u); }
DEVI float sigmoidf_(float x) { return 1.f / (1.f + __expf(-x)); }
DEVI float logsigf_(float z) { return fminf(z, 0.f) - __logf(1.f + __expf(-fabsf(z))); }
typedef unsigned u32x4_t __attribute__((ext_vector_type(4)));
DEVI bf16x8 mk8(uint2 lo, uint2 hi) { u32x4_t v = {lo.x, lo.y, hi.x, hi.y}; return __builtin_bit_cast(bf16x8, v); }
DEVI f32x4 mfma16(bf16x8 a, bf16x8 b, f32x4 c) { return __builtin_amdgcn_mfma_f32_16x16x32_bf16(a, b, c, 0, 0, 0); }

constexpr int BM = 256, BK = 64, HALF = 128, HT = HALF * BK;

DEVI int lds_byte(int r, int c) {
  int st = (r >> 4) * 2 + (c >> 5), rr = r & 15, cc = c & 31, ob = rr * 64 + cc * 2;
  return st * 1024 + (ob ^ (((ob >> 9) & 1) << 5));
}
DEVI void stage_rc(int b, int& R, int& C) {
  int st = b / 1024, sb = b % 1024, swz = sb ^ (((sb >> 9) & 1) << 5);
  R = (st >> 1) * 16 + swz / 64; C = (st & 1) * 32 + (swz % 64) / 2;
}

#define G_SA(b, h) (shm + ((b) * 2 + (h)) * HT)
#define G_SB(b, h) (shm + (4 + (b) * 2 + (h)) * HT)
#define G_STAGE(P, BASE, LD, br, kt) do { const u16* _p = (BASE) + (size_t)(br) * (size_t)(LD) + (size_t)(kt) * BK; \
    __builtin_amdgcn_global_load_lds((const unsigned*)(_p + soff0), (unsigned*)((char*)(P) + tid * 16), 16, 0, 0); \
    __builtin_amdgcn_global_load_lds((const unsigned*)(_p + soff1), (unsigned*)((char*)(P) + tid * 16 + 8192), 16, 0, 0); } while (0)
#define G_LDA(dst, b, h) for (int m = 0; m < 4; ++m) for (int k = 0; k < 2; ++k) \
    dst[m][k] = *reinterpret_cast<const bf16x8*>((char*)G_SA(b, h) + lds_byte(wr * 64 + m * 16 + fr, k * 32 + fq * 8))
#define G_LDB(dst, b, h) for (int n = 0; n < 2; ++n) for (int k = 0; k < 2; ++k) \
    dst[n][k] = *reinterpret_cast<const bf16x8*>((char*)G_SB(b, h) + ldsb_base + n * 256 + k * 1024)
#define G_MMA(ai, bj, At, Bf) do { __builtin_amdgcn_s_setprio(1); \
    for (int m = 0; m < 4; ++m) for (int n = 0; n < 2; ++n) for (int k = 0; k < 2; ++k) \
      acc[ai][bj][m][n] = __builtin_amdgcn_mfma_f32_16x16x32_bf16(Bf[n][k], At[m][k], acc[ai][bj][m][n], 0, 0, 0); \
    __builtin_amdgcn_s_setprio(0); } while (0)
#define G_WAIT_V(n) asm volatile("s_waitcnt vmcnt(" #n ")" ::: "memory")
#define G_WAIT_L(n) asm volatile("s_waitcnt lgkmcnt(" #n ")" ::: "memory")
#define G_BAR __builtin_amdgcn_s_barrier()
#define G_SCHED __builtin_amdgcn_sched_barrier(0)

template <int LD, class Epi>
DEVI void gemm_tile(int wv, u16* shm, const u16* A, const u16* Bt, int K, int brow, int bcol, const Epi& epi,
                    bool pre, bool has_next, int nshift, int nbrow, int nbcol) {
  constexpr int lda = LD, ldb = LD;
  const u16* nA = A + nshift; const u16* nB = Bt + nshift;
  const int tid = otid(wv);
  int wid = tid >> 6, lane = tid & 63, wr = wid >> 2, wc = wid & 3, fr = lane & 15, fq = lane >> 4;
  const int ldsb_base = lds_byte(wc * 32 + 8 * (fr >> 2) + (fr & 3), fq * 8);
  f32x4 acc[2][2][4][2] = {};
  bf16x8 At[4][2], B0[2][2], B1[2][2];
  int nt = K / BK;
  unsigned soff0, soff1;
  { int _r, _c; stage_rc(tid * 16, _r, _c); soff0 = (unsigned)(_r * lda + _c); stage_rc(tid * 16 + 8192, _r, _c); soff1 = (unsigned)(_r * lda + _c); }
  if (!pre) {
    G_STAGE(G_SB(0, 0), Bt, ldb, bcol, 0); G_STAGE(G_SA(0, 0), A, lda, brow, 0);
    G_STAGE(G_SB(0, 1), Bt, ldb, bcol + HALF, 0); G_STAGE(G_SA(0, 1), A, lda, brow + HALF, 0);
  }
  if (wr == 1) G_BAR;
  if (pre) { if (Epi::NSTORE == 32) { G_WAIT_V(36); } else { G_WAIT_V(20); } } else { G_WAIT_V(4); } G_BAR;
  G_STAGE(G_SB(1, 0), Bt, ldb, bcol, 1); G_STAGE(G_SA(1, 0), A, lda, brow, 1); G_STAGE(G_SB(1, 1), Bt, ldb, bcol + HALF, 1);
  if (pre) { if (Epi::NSTORE == 32) { G_WAIT_V(38); } else { G_WAIT_V(22); } } else { G_WAIT_V(6); } G_BAR;
  for (int t = 0; t < nt - 2; t += 2) {
    G_LDB(B0, 0, 0); G_SCHED; G_LDA(At, 0, 0); G_STAGE(G_SA(1, 1), A, lda, brow + HALF, t + 1);
    G_WAIT_L(8); G_BAR; G_WAIT_L(0); G_MMA(0, 0, At, B0); G_BAR; G_SCHED;
    G_LDB(B1, 0, 1); G_STAGE(G_SB(0, 0), Bt, ldb, bcol, t + 2);
    G_BAR; G_WAIT_L(0); G_MMA(0, 1, At, B1); G_BAR;
    G_LDA(At, 0, 1); G_STAGE(G_SA(0, 0), A, lda, brow, t + 2);
    G_BAR; G_WAIT_L(0); G_MMA(1, 0, At, B0); G_BAR; G_SCHED;
    G_STAGE(G_SB(0, 1), Bt, ldb, bcol + HALF, t + 2);
    G_WAIT_V(6); G_BAR; G_MMA(1, 1, At, B1); G_BAR;
    G_LDB(B0, 1, 0); G_SCHED; G_LDA(At, 1, 0); G_STAGE(G_SA(0, 1), A, lda, brow + HALF, t + 2);
    G_WAIT_L(8); G_BAR; G_WAIT_L(0); G_MMA(0, 0, At, B0); G_BAR; G_SCHED;
    G_LDB(B1, 1, 1); G_STAGE(G_SB(1, 0), Bt, ldb, bcol, t + 3);
    G_BAR; G_WAIT_L(0); G_MMA(0, 1, At, B1); G_BAR;
    G_LDA(At, 1, 1); G_STAGE(G_SA(1, 0), A, lda, brow, t + 3);
    G_BAR; G_WAIT_L(0); G_MMA(1, 0, At, B0); G_BAR; G_SCHED;
    G_STAGE(G_SB(1, 1), Bt, ldb, bcol + HALF, t + 3);
    G_WAIT_V(6); G_BAR; G_MMA(1, 1, At, B1); G_BAR;
  }
  { G_LDB(B0, 0, 0); G_LDA(At, 0, 0); G_STAGE(G_SA(1, 1), A, lda, brow + HALF, nt - 1);
    G_BAR; G_WAIT_L(0); G_MMA(0, 0, At, B0); G_BAR;
    G_LDB(B1, 0, 1); G_BAR; G_WAIT_L(0); G_MMA(0, 1, At, B1); G_BAR;
    G_LDA(At, 0, 1); G_WAIT_V(4); G_BAR; G_WAIT_L(0); G_MMA(1, 0, At, B0); G_MMA(1, 1, At, B1); G_BAR; }
  { G_LDB(B0, 1, 0); G_LDA(At, 1, 0); G_WAIT_V(2); G_BAR;
    if (has_next) {
      G_STAGE(G_SB(0, 0), nB, ldb, nbcol, 0); G_STAGE(G_SA(0, 0), nA, lda, nbrow, 0);
      G_STAGE(G_SB(0, 1), nB, ldb, nbcol + HALF, 0); G_STAGE(G_SA(0, 1), nA, lda, nbrow + HALF, 0);
    }
    G_WAIT_L(0); G_MMA(0, 0, At, B0); G_BAR;
    G_LDB(B1, 1, 1); if (has_next) { G_WAIT_V(8); } else { G_WAIT_V(0); } G_BAR; G_WAIT_L(0); G_MMA(0, 1, At, B1); G_BAR;
    G_LDA(At, 1, 1); G_BAR; G_WAIT_L(0); G_MMA(1, 0, At, B0); G_MMA(1, 1, At, B1); G_BAR; }
  if (wr == 0) G_BAR;
  epi(acc, brow, bcol, wr, wc, fr, fq);
}

struct EpiBf16 {
  static constexpr int NSTORE = 16;
  u16* C; int ldc; int relu2;
  DEVI void operator()(const f32x4 (&acc)[2][2][4][2], int brow, int bcol, int wr, int wc, int fr, int fq) const {
#pragma unroll
    for (int ai = 0; ai < 2; ++ai)
#pragma unroll
      for (int bj = 0; bj < 2; ++bj)
#pragma unroll
        for (int m = 0; m < 4; ++m) {
          int row = brow + ai * HALF + wr * 64 + m * 16 + fr, col = bcol + bj * HALF + wc * 32 + fq * 8;
          f32x4 v0 = acc[ai][bj][m][0], v1 = acc[ai][bj][m][1];
          if (relu2) {
#pragma unroll
            for (int j = 0; j < 4; ++j) { float t0 = fmaxf(v0[j], 0.f), t1 = fmaxf(v1[j], 0.f); v0[j] = t0 * t0; v1[j] = t1 * t1; }
          }
          uint4 o; o.x = pk2(v0[0], v0[1]); o.y = pk2(v0[2], v0[3]); o.z = pk2(v1[0], v1[1]); o.w = pk2(v1[2], v1[3]);
          *(uint4*)(C + (size_t)row * ldc + col) = o;
        }
  }
};
struct EpiGate {
  const u16* G; int gcol0; u16* Mg; int first;
  DEVI void operator()(const f32x4 (&acc)[2][2][4][2], int brow, int bcol, int wr, int wc, int fr, int fq) const {
#pragma unroll
    for (int ai = 0; ai < 2; ++ai)
#pragma unroll
      for (int bj = 0; bj < 2; ++bj)
#pragma unroll
      for (int mh = 0; mh < 2; ++mh) {
        uint2 g[4][2], o[4][2];
#pragma unroll
        for (int m = 2 * mh; m < 2 * mh + 2; ++m)
#pragma unroll
          for (int n = 0; n < 2; ++n) {
            int row = brow + ai * HALF + wr * 64 + m * 16 + fr, col = bcol + bj * HALF + wc * 32 + n * 16 + fq * 4;
            g[m][n] = *(const uint2*)(G + (size_t)row * NPROJ + gcol0 + col);
            if (!first) o[m][n] = *(const uint2*)(Mg + (size_t)row * 1024 + col);
          }
#pragma unroll
        for (int m = 2 * mh; m < 2 * mh + 2; ++m)
#pragma unroll
          for (int n = 0; n < 2; ++n) {
            int row = brow + ai * HALF + wr * 64 + m * 16 + fr, col = bcol + bj * HALF + wc * 32 + n * 16 + fq * 4;
            f32x4 v = acc[ai][bj][m][n];
            float r0 = v[0] * sigmoidf_(bflo(g[m][n].x)), r1 = v[1] * sigmoidf_(bfhi(g[m][n].x)), r2 = v[2] * sigmoidf_(bflo(g[m][n].y)), r3 = v[3] * sigmoidf_(bfhi(g[m][n].y));
            if (!first) { r0 += bflo(o[m][n].x); r1 += bfhi(o[m][n].x); r2 += bflo(o[m][n].y); r3 += bfhi(o[m][n].y); }
            uint2 o2; o2.x = pk2(r0, r1); o2.y = pk2(r2, r3);
            *(uint2*)(Mg + (size_t)row * 1024 + col) = o2;
          }
      }
  }
};
struct EpiRes {
  const float* xin; float* xout; const float* gate; int row0;
  static constexpr int NSTORE = 32;
  DEVI void load_batch(int q, float4 (&xi)[2][2], int brow, int bcol, int wr, int wc, int fr, int fq) const {
    const int ai = q >> 2, bj = (q >> 1) & 1, mh = q & 1, col = bcol + bj * HALF + wc * 32 + fq * 8;
#pragma unroll
    for (int mm = 0; mm < 2; ++mm) {
      const int row = row0 + brow + ai * HALF + wr * 64 + (2 * mh + mm) * 16 + fr;
      xi[mm][0] = *(const float4*)(xin + (size_t)row * 1024 + col); xi[mm][1] = *(const float4*)(xin + (size_t)row * 1024 + col + 4);
    }
  }
  DEVI void operator()(const f32x4 (&acc)[2][2][4][2], int brow, int bcol, int wr, int wc, int fr, int fq) const {
    const int b = (row0 + brow) >> 12;
    float4 gt[2][2];
#pragma unroll
    for (int bj = 0; bj < 2; ++bj) {
      const int col = bcol + bj * HALF + wc * 32 + fq * 8;
      gt[bj][0] = *(const float4*)(gate + (size_t)b * 6144 + col); gt[bj][1] = *(const float4*)(gate + (size_t)b * 6144 + col + 4);
    }
    float4 xa[2][2], xb[2][2];
    load_batch(0, xa, brow, bcol, wr, wc, fr, fq);
#pragma unroll
    for (int q = 0; q < 8; ++q) {
      const int ai = q >> 2, bj = (q >> 1) & 1, mh = q & 1, col = bcol + bj * HALF + wc * 32 + fq * 8;
      if (q + 1 < 8) { if (q & 1) load_batch(q + 1, xa, brow, bcol, wr, wc, fr, fq); else load_batch(q + 1, xb, brow, bcol, wr, wc, fr, fq); }
#pragma unroll
      for (int mm = 0; mm < 2; ++mm) {
        const int row = row0 + brow + ai * HALF + wr * 64 + (2 * mh + mm) * 16 + fr;
#pragma unroll
        for (int n = 0; n < 2; ++n) {
          const f32x4 v = acc[ai][bj][2 * mh + mm][n];
          const float4 xv = (q & 1) ? xb[mm][n] : xa[mm][n];
          float4 o; o.x = xv.x + gt[bj][n].x * v[0]; o.y = xv.y + gt[bj][n].y * v[1]; o.z = xv.z + gt[bj][n].z * v[2]; o.w = xv.w + gt[bj][n].w * v[3];
          *(float4*)(xout + (size_t)row * 1024 + col + 4 * n) = o;
        }
      }
    }
  }
};

template <int LD, class Epi>
DEVI void gemm_phase(int wv, u16* shm, const u16* A, const u16* Bt, int Mrows, int N, int K, const Epi& epi) {
  int nM = Mrows / BM, nN = N / BM, ntiles = nM * nN;
  int G = ogrd(), b = oblk();
  int vb = (G % 8 == 0) ? (b % 8) * (G / 8) + b / 8 : b;
  const int nig = 8 * nN;
  bool pre = false;
  for (int base = 0; base < ntiles; base += G) {
    int id = base + vb;
    if (id >= ntiles) break;
    int gid = id / nig, rem = id % nig, pm = gid * 8 + rem % 8, pn = rem / 8;
    int nid = id + G; bool has_next = nid < ntiles;
    int ngid = nid / nig, nrem = nid % nig, npm = ngid * 8 + nrem % 8, npn = nrem / 8;
    gemm_tile<LD>(wv, shm, A, Bt, K, pm * BM, pn * BM, epi, pre, has_next, 0, npm * BM, npn * BM);
    pre = has_next;
    if (has_next) { G_BAR; } else { __syncthreads(); }
  }
}

#define BR_LDB(dst, b, h) for (int n = 0; n < 2; ++n) for (int k = 0; k < 2; ++k) \
    dst[n][k] = *reinterpret_cast<const bf16x8*>((char*)G_SB(b, h) + ldsb_base + n * 256 + k * 1024)
DEVI void branch_phase(int wv, u16* shm, const u16* br, const u16* WbrT, const u16* G, u16* Mg) {
  const int tid = otid(wv);
  const int wid = tid >> 6, lane = tid & 63, wr = wid >> 2, wc = wid & 3, fr = lane & 15, fq = lane >> 4;
  constexpr int lda = BRW, ldb = BRW;
  unsigned soff0, soff1;
  { int _r, _c; stage_rc(tid * 16, _r, _c); soff0 = (unsigned)(_r * BRW + _c); stage_rc(tid * 16 + 8192, _r, _c); soff1 = (unsigned)(_r * BRW + _c); }
  const unsigned goff = (unsigned)((wr * 64 + fr) * NPROJ + wc * 32 + fq * 8), moff = (unsigned)((wr * 64 + fr) * 1024 + wc * 32 + fq * 8);
  const int ldsb_base = lds_byte(wc * 32 + 8 * (fr >> 2) + (fr & 3), fq * 8);
  const int Gd = ogrd();
  for (int tile = oblk(); tile < (MH / 128) * 4; tile += Gd) {
    const int pm = tile >> 2, pn = tile & 3, brow = pm * 128, bcol = pn * 256;
    f32x4 mg[2][4][2];
#pragma unroll
    for (int bj = 0; bj < 2; ++bj)
#pragma unroll
      for (int m = 0; m < 4; ++m)
#pragma unroll
        for (int n = 0; n < 2; ++n) mg[bj][m][n] = (f32x4){0.f, 0.f, 0.f, 0.f};
    for (int i = 0; i < 4; ++i) {
      const int koff = (i == 3) ? 1024 : i * 256, nt = (i == 2) ? 8 : 4;
      const u16* A = br + koff; const u16* Bt = WbrT + koff;
      f32x4 acc[2][4][2];
#pragma unroll
      for (int bj = 0; bj < 2; ++bj)
#pragma unroll
        for (int m = 0; m < 4; ++m)
#pragma unroll
          for (int n = 0; n < 2; ++n) acc[bj][m][n] = (f32x4){0.f, 0.f, 0.f, 0.f};
      G_STAGE(G_SA(0, 0), A, lda, brow, 0); G_STAGE(G_SB(0, 0), Bt, ldb, bcol, 0); G_STAGE(G_SB(0, 1), Bt, ldb, bcol + HALF, 0);
      for (int kt = 0; kt < nt; ++kt) {
        const int b = kt & 1;
        if (kt + 1 < nt) {
          if (b) { G_STAGE(G_SA(0, 0), A, lda, brow, kt + 1); G_STAGE(G_SB(0, 0), Bt, ldb, bcol, kt + 1); G_STAGE(G_SB(0, 1), Bt, ldb, bcol + HALF, kt + 1); }
          else   { G_STAGE(G_SA(1, 0), A, lda, brow, kt + 1); G_STAGE(G_SB(1, 0), Bt, ldb, bcol, kt + 1); G_STAGE(G_SB(1, 1), Bt, ldb, bcol + HALF, kt + 1); }
          G_WAIT_V(6);
        } else { G_WAIT_V(0); }
        G_BAR;
        bf16x8 At[4][2], B0[2][2];
        if (b) { G_LDA(At, 1, 0); BR_LDB(B0, 1, 0); } else { G_LDA(At, 0, 0); BR_LDB(B0, 0, 0); }
        G_WAIT_L(0);
        __builtin_amdgcn_s_setprio(1);
#pragma unroll
        for (int m = 0; m < 4; ++m)
#pragma unroll
          for (int n = 0; n < 2; ++n)
#pragma unroll
            for (int k = 0; k < 2; ++k) acc[0][m][n] = __builtin_amdgcn_mfma_f32_16x16x32_bf16(B0[n][k], At[m][k], acc[0][m][n], 0, 0, 0);
        __builtin_amdgcn_s_setprio(0);
        if (b) { BR_LDB(B0, 1, 1); } else { BR_LDB(B0, 0, 1); }
        G_WAIT_L(0);
        __builtin_amdgcn_s_setprio(1);
#pragma unroll
        for (int m = 0; m < 4; ++m)
#pragma unroll
          for (int n = 0; n < 2; ++n)
#pragma unroll
            for (int k = 0; k < 2; ++k) acc[1][m][n] = __builtin_amdgcn_mfma_f32_16x16x32_bf16(B0[n][k], At[m][k], acc[1][m][n], 0, 0, 0);
        __builtin_amdgcn_s_setprio(0);
        G_BAR;
      }
#pragma unroll
      for (int bj = 0; bj < 2; ++bj) {
        uint4 g[4];
#pragma unroll
        for (int m = 0; m < 4; ++m) {
          const u16* gp = G + (size_t)(brow + m * 16) * NPROJ + OFF_GATE + i * 1024 + bcol + bj * HALF;
          g[m] = *(const uint4*)(gp + goff);
        }
#pragma unroll
        for (int m = 0; m < 4; ++m) {
          const uint4 gv = g[m];
          mg[bj][m][0][0] += acc[bj][m][0][0] * sigmoidf_(bflo(gv.x)); mg[bj][m][0][1] += acc[bj][m][0][1] * sigmoidf_(bfhi(gv.x));
          mg[bj][m][0][2] += acc[bj][m][0][2] * sigmoidf_(bflo(gv.y)); mg[bj][m][0][3] += acc[bj][m][0][3] * sigmoidf_(bfhi(gv.y));
          mg[bj][m][1][0] += acc[bj][m][1][0] * sigmoidf_(bflo(gv.z)); mg[bj][m][1][1] += acc[bj][m][1][1] * sigmoidf_(bfhi(gv.z));
          mg[bj][m][1][2] += acc[bj][m][1][2] * sigmoidf_(bflo(gv.w)); mg[bj][m][1][3] += acc[bj][m][1][3] * sigmoidf_(bfhi(gv.w));
        }
      }
    }
#pragma unroll
    for (int bj = 0; bj < 2; ++bj)
#pragma unroll
      for (int m = 0; m < 4; ++m) {
        u16* mp = Mg + (size_t)(brow + m * 16) * 1024 + bcol + bj * HALF;
        uint4 o; o.x = pk2(mg[bj][m][0][0], mg[bj][m][0][1]); o.y = pk2(mg[bj][m][0][2], mg[bj][m][0][3]);
        o.z = pk2(mg[bj][m][1][0], mg[bj][m][1][1]); o.w = pk2(mg[bj][m][1][2], mg[bj][m][1][3]);
        *(uint4*)(mp + moff) = o;
      }
  }
}
#undef BR_LDB

DEVI void transpose_tile(int wv, const float* src, int lds_, int col0, int k0, u16* dst, int ldd, int drow0, int dk0, float* sm) {
  const int t = otid(wv);
  {
    const int k = t >> 4, n4 = (t & 15) * 4;
    float4 a = *(const float4*)(src + (size_t)(k0 + k) * lds_ + col0 + n4);
    float4 b = *(const float4*)(src + (size_t)(k0 + 32 + k) * lds_ + col0 + n4);
    float* p = sm + k * 65 + n4; p[0] = a.x; p[1] = a.y; p[2] = a.z; p[3] = a.w;
    p += 32 * 65; p[0] = b.x; p[1] = b.y; p[2] = b.z; p[3] = b.w;
  }
  __syncthreads();
  {
    const int n = t >> 3, kc = (t & 7) * 8;
    const float* p = sm + kc * 65 + n;
    uint4 o; o.x = pk2(p[0], p[65]); o.y = pk2(p[2 * 65], p[3 * 65]); o.z = pk2(p[4 * 65], p[5 * 65]); o.w = pk2(p[6 * 65], p[7 * 65]);
    *(uint4*)(dst + (size_t)(drow0 + n) * ldd + dk0 + kc) = o;
  }
  __syncthreads();
}

DEVI void prep_phase(int wv, unsigned char* smem) {
  float* sm = (float*)smem;
  u16* WT = (u16*)(KWS() + O_WT);
  constexpr int T1 = 16 * 68, T2 = 16 * 76, T3 = 64, T4 = 64, T5 = 128, T6 = 64, T7 = 256, T8 = 1024, T9 = 1024;
  constexpr int TL = T1 + T2 + T3 + T4 + T5 + T6 + T7 + T8 + T9;
  for (int it = oblk(); it < 2 * TL; it += ogrd()) {
    int l = it / TL, r = it % TL;
    u16* W = WT + (size_t)l * WT_L;
    if (r < T1) { int kt = r / 68, nt = r % 68; transpose_tile(wv, KP(w_in) + (size_t)l * 1024 * INW, INW, nt * 64, kt * 64, W + WT_IN, 1024, nt * 64, kt * 64, sm); continue; } r -= T1;
    if (r < T2) { int kt = r / 76, nt = r % 76; transpose_tile(wv, KP(w_in) + (size_t)l * 1024 * INW, INW, 4368 + nt * 64, kt * 64, W + WT_IN, 1024, 4352 + nt * 64, kt * 64, sm); continue; } r -= T2;
    if (r < T3) { int kt = r / 16, nt = r % 16; transpose_tile(wv, KP(w_br_a) + (size_t)l * 256 * 1024, 1024, nt * 64, kt * 64, W + WT_BR, BRW, nt * 64, 0 + kt * 64, sm); continue; } r -= T3;
    if (r < T4) { int kt = r / 16, nt = r % 16; transpose_tile(wv, KP(w_br_b) + (size_t)l * 256 * 1024, 1024, nt * 64, kt * 64, W + WT_BR, BRW, nt * 64, 256 + kt * 64, sm); continue; } r -= T4;
    if (r < T5) { int kt = r / 16, nt = r % 16; transpose_tile(wv, KP(w_br_c) + (size_t)l * 512 * 1024, 1024, nt * 64, kt * 64, W + WT_BR, BRW, nt * 64, 512 + kt * 64, sm); continue; } r -= T5;
    if (r < T6) { int kt = r / 16, nt = r % 16; transpose_tile(wv, KP(w_br_d) + (size_t)l * 256 * 1024, 1024, nt * 64, kt * 64, W + WT_BR, BRW, nt * 64, 1024 + kt * 64, sm); continue; } r -= T6;
    if (r < T7) { int kt = r / 16, nt = r % 16; transpose_tile(wv, KP(w_out) + (size_t)l * 1024 * 1024, 1024, nt * 64, kt * 64, W + WT_OUT, 1024, nt * 64, kt * 64, sm); continue; } r -= T7;
    if (r < T8) { int kt = r / 64, nt = r % 64; transpose_tile(wv, KP(w_up) + (size_t)l * 1024 * 4096, 4096, nt * 64, kt * 64, W + WT_UP, 1024, nt * 64, kt * 64, sm); continue; } r -= T8;
    { int kt = r / 16, nt = r % 16; transpose_tile(wv, KP(w_down) + (size_t)l * 4096 * 1024, 1024, nt * 64, kt * 64, W + WT_DOWN, 4096, nt * 64, kt * 64, sm); }
  }
  long gtid = (long)oblk() * 512 + otid(wv), gsz = (long)ogrd() * 512;
  for (long idx = gtid; idx < 2L * 16 * 1024; idx += gsz) {
    int l = (int)(idx >> 14), r = (int)((idx >> 10) & 15), k = (int)(idx & 1023);
    WT[(size_t)l * WT_L + WT_LOW + (size_t)r * 1024 + k] = f2bf(KP(w_in)[(size_t)l * 1024 * INW + (size_t)k * INW + 4352 + r]);
  }
  float* modp = (float*)(KWS() + O_MODP);
  const float* cvec = KP(c);
  for (int it = oblk(); it < 2 * 16 * 12; it += ogrd()) {
    int l = it / 192, kp = (it / 12) % 16, cgp = it % 12;
    int j = cgp * 512 + otid(wv);
    float a[8];
#pragma unroll
    for (int b = 0; b < 8; ++b) a[b] = 0.f;
    const float* w = KP(w_ada) + (size_t)l * 1024 * 6144 + (size_t)(kp * 64) * 6144 + j;
    for (int k = 0; k < 64; ++k) {
      float wv = w[(size_t)k * 6144];
#pragma unroll
      for (int b = 0; b < 8; ++b) a[b] += cvec[b * 1024 + kp * 64 + k] * wv;
    }
#pragma unroll
    for (int b = 0; b < 8; ++b) modp[(((size_t)l * 16 + kp) * 8 + b) * 6144 + j] = a[b];
  }
}

DEVI void modfinal_phase(int wv) {
  long gtid = (long)oblk() * 512 + otid(wv), gsz = (long)ogrd() * 512;
  unsigned char* ws_ = KWS();
  const float* modp = (const float*)(ws_ + O_MODP);
  float* modf = (float*)(ws_ + O_MODF);
  for (long idx = gtid; idx < 2L * 8 * 1024; idx += gsz) {
    int l = (int)(idx >> 13), b = (int)((idx >> 10) & 7), col = (int)(idx & 1023);
    float v[6];
#pragma unroll
    for (int s = 0; s < 6; ++s) {
      float a = KP(b_ada)[l * 6144 + s * 1024 + col];
      for (int kp = 0; kp < 16; ++kp) a += modp[(((size_t)l * 16 + kp) * 8 + b) * 6144 + s * 1024 + col];
      v[s] = a;
    }
    float* o = modf + ((size_t)l * 8 + b) * 6144 + col;
    o[0] = KP(g_mix)[l * 1024 + col] * (1.f + v[1]); o[1024] = v[0]; o[2048] = v[2];
    o[3072] = KP(g_mlp)[l * 1024 + col] * (1.f + v[4]); o[4096] = v[3]; o[5120] = v[5];
  }
}

DEVI void norm_phase(int wv, const float* xsrc, int row0, int nrows, const float* modl  , int slot, u16* hout) {
  const int tid = otid(wv); int wave = tid >> 6, lane = tid & 63;
  int gw = oblk() * 8 + wave, NGW = ogrd() * 8;
  for (int r0 = gw * 8; r0 < nrows; r0 += NGW * 8) {
    float4 v[8][4];
#pragma unroll
    for (int q = 0; q < 8; ++q) {
      const float4* xr = (const float4*)(xsrc + (size_t)(row0 + r0 + q) * 1024);
#pragma unroll
      for (int j = 0; j < 4; ++j) v[q][j] = xr[lane + 64 * j];
    }
    const int b = (row0 + r0) >> 12;
    const float4* sc = (const float4*)(modl + (size_t)b * 6144 + slot * 1024);
    const float4* sh = (const float4*)(modl + (size_t)b * 6144 + (slot + 1) * 1024);
    float4 s4[4], h4[4];
#pragma unroll
    for (int j = 0; j < 4; ++j) { s4[j] = sc[lane + 64 * j]; h4[j] = sh[lane + 64 * j]; }
#pragma unroll
    for (int q = 0; q < 8; ++q) {
      float ss = 0.f;
#pragma unroll
      for (int j = 0; j < 4; ++j) ss += v[q][j].x * v[q][j].x + v[q][j].y * v[q][j].y + v[q][j].z * v[q][j].z + v[q][j].w * v[q][j].w;
#pragma unroll
      for (int o = 1; o < 64; o <<= 1) ss += shfl_xor_l(ss, o, lane);
      const float rs = rsqrtf(ss * (1.f / 1024.f) + EPS);
      uint2* o2 = (uint2*)(hout + (size_t)(r0 + q) * 1024);
#pragma unroll
      for (int j = 0; j < 4; ++j) {
        uint2 o; o.x = pk2(v[q][j].x * rs * s4[j].x + h4[j].x, v[q][j].y * rs * s4[j].y + h4[j].y);
        o.y = pk2(v[q][j].z * rs * s4[j].z + h4[j].z, v[q][j].w * rs * s4[j].w + h4[j].w);
        o2[lane + 64 * j] = o;
      }
    }
  }
}

DEVI void glow_phase(int wv, int l, const u16* hbuf, const u16* WlowT, float* xgout) {
  const int tid = otid(wv), w = tid >> 6, lane = tid & 63, fr = lane & 15, fq = lane >> 4;
  const float* wg = KP(gla_w_gate) + (size_t)l * 16 * 256; const float* bg = KP(gla_b_gate) + l * 256;
  for (int u = oblk() * 8 + w; u < MH / 16; u += ogrd() * 8) {
    const u16* ap = WlowT + (size_t)fr * 1024 + fq * 8;
    const u16* bp = hbuf + (size_t)(u * 16 + fr) * 1024 + fq * 8;
    f32x4 acc = {0.f, 0.f, 0.f, 0.f};
#pragma unroll 8
    for (int ks = 0; ks < 32; ++ks) acc = mfma16(*(const bf16x8*)(ap + ks * 32), *(const bf16x8*)(bp + ks * 32), acc);
    u32x4_t pbu = {pk2_sw(acc[0], acc[1]), pk2_sw(acc[2], acc[3]), 0u, 0u};
    const bf16x8 pb = __builtin_bit_cast(bf16x8, pbu);
    float* orow = xgout + (size_t)(u * 16 + fr) * 256 + fq * 4;
#pragma unroll
    for (int nt = 0; nt < 16; ++nt) {
      const float* wp = wg + (size_t)(fq * 4) * 256 + nt * 16 + fr;
      u32x4_t pau = {pk2_sw(wp[0], wp[256]), pk2_sw(wp[512], wp[768]), 0u, 0u};
      f32x4 d = mfma16(__builtin_bit_cast(bf16x8, pau), pb, (f32x4){0.f, 0.f, 0.f, 0.f});
      const float4 bb = *(const float4*)(bg + nt * 16 + fq * 4);
      *(float4*)(orow + nt * 16) = make_float4(d[0] + bb.x, d[1] + bb.y, d[2] + bb.z, d[3] + bb.w);
    }
  }
}

struct MixCtx { int wv; int l; int hf; u16* proj; u16* br; float* lse; float* S; float* gdec; float* glow; };
DEVI MixCtx make_ctx(int wv, int l, int hf) { unsigned char* ws = KWS(); MixCtx c; c.wv = wv; c.l = l; c.hf = hf; c.proj = (u16*)(ws + O_PROJ); c.br = (u16*)(ws + O_BR); c.lse = (float*)(ws + O_LSE); c.S = (float*)(ws + O_S); c.gdec = (float*)(ws + O_GDEC); c.glow = (float*)(ws + O_GLOW); return c; }

DEVI void unpack8(uint4 r, float (&v)[8]) {
  v[0] = bflo(r.x); v[1] = bfhi(r.x); v[2] = bflo(r.y); v[3] = bfhi(r.y); v[4] = bflo(r.z); v[5] = bfhi(r.z); v[6] = bflo(r.w); v[7] = bfhi(r.w);
}

DEVI void dswa_item(const MixCtx& c, int item, unsigned char* smem, bool do_store = true, bool stage_only = false) {
  const int tid = otid(c.wv), w = tid >> 6, lane = tid & 63, fr = lane & 15, fq = lane >> 4;
  int blk = item & 31, h = (item >> 5) & 3, gb = item >> 7, g = gb % 3, bl = gb / 3;
  int d = (g == 0) ? 1 : (g == 1 ? 4 : 16), nbr = 32 / d, r = blk / nbr, nbi = blk % nbr;
  u16* Qs = (u16*)smem; u16* Ks = Qs + 128 * 72; u16* VT = Ks + 256 * 72;
  u16* pj = c.proj + (size_t)bl * 4096 * NPROJ;
  const float* qg = KP(q_gain) + c.l * 64; const float* kg = KP(k_gain) + c.l * 64;
#pragma unroll
  for (int i = 0; i < 2; ++i) {
    int ci = tid + 512 * i, row = ci >> 3, ch = ci & 7, tok = (nbi * 128 + row) * d + r;
    uint4 raw = *(const uint4*)(pj + (size_t)tok * NPROJ + OFF_AQ + g * 256 + h * 64 + ch * 8);
    float v[8]; unpack8(raw, v);
    float ss = 0.f;
#pragma unroll
    for (int j = 0; j < 8; ++j) ss += v[j] * v[j];
    ss += shfl_xor_l(ss, 1, lane); ss += shfl_xor_l(ss, 2, lane); ss += shfl_xor_l(ss, 4, lane);
    float sc = rsqrtf(ss * (1.f / 64.f) + EPS);
    uint4 o; o.x = pk2(v[0] * sc * qg[ch * 8 + 0], v[1] * sc * qg[ch * 8 + 1]); o.y = pk2(v[2] * sc * qg[ch * 8 + 2], v[3] * sc * qg[ch * 8 + 3]);
    o.z = pk2(v[4] * sc * qg[ch * 8 + 4], v[5] * sc * qg[ch * 8 + 5]); o.w = pk2(v[6] * sc * qg[ch * 8 + 6], v[7] * sc * qg[ch * 8 + 7]);
    *(uint4*)(Qs + row * 72 + ch * 8) = o;
  }
#pragma unroll
  for (int i = 0; i < 4; ++i) {
    int ci = tid + 512 * i, row = ci >> 3, ch = ci & 7, sub = (nbi - 1) * 128 + row;
    bool ok = sub >= 0; int tok = ok ? sub * d + r : 0;
    uint4 raw = *(const uint4*)(pj + (size_t)tok * NPROJ + OFF_AK + g * 256 + h * 64 + ch * 8);
    uint4 rv = *(const uint4*)(pj + (size_t)tok * NPROJ + OFF_AV + g * 256 + h * 64 + ch * 8);
    if (!ok) { raw = make_uint4(0, 0, 0, 0); rv = raw; }
    float v[8]; unpack8(raw, v);
    float ss = 0.f;
#pragma unroll
    for (int j = 0; j < 8; ++j) ss += v[j] * v[j];
    ss += shfl_xor_l(ss, 1, lane); ss += shfl_xor_l(ss, 2, lane); ss += shfl_xor_l(ss, 4, lane);
    float sc = rsqrtf(ss * (1.f / 64.f) + EPS);
    uint4 o; o.x = pk2(v[0] * sc * kg[ch * 8 + 0], v[1] * sc * kg[ch * 8 + 1]); o.y = pk2(v[2] * sc * kg[ch * 8 + 2], v[3] * sc * kg[ch * 8 + 3]);
    o.z = pk2(v[4] * sc * kg[ch * 8 + 4], v[5] * sc * kg[ch * 8 + 5]); o.w = pk2(v[6] * sc * kg[ch * 8 + 6], v[7] * sc * kg[ch * 8 + 7]);
    *(uint4*)(Ks + row * 72 + ch * 8) = o;
    u16* vt = VT + (ch * 8) * 264 + row;
    vt[0 * 264] = (u16)(rv.x & 0xffff); vt[1 * 264] = (u16)(rv.x >> 16); vt[2 * 264] = (u16)(rv.y & 0xffff); vt[3 * 264] = (u16)(rv.y >> 16);
    vt[4 * 264] = (u16)(rv.z & 0xffff); vt[5 * 264] = (u16)(rv.z >> 16); vt[6 * 264] = (u16)(rv.w & 0xffff); vt[7 * 264] = (u16)(rv.w >> 16);
  }
  __syncthreads();
  if (stage_only) return;
  bf16x8 qf[2];
#pragma unroll
  for (int ks = 0; ks < 2; ++ks) qf[ks] = *(const bf16x8*)(Qs + (16 * w + fr) * 72 + ks * 32 + fq * 8);
  const int pair0 = w >> 1;
  f32x4 st[5][2];
#pragma unroll
  for (int s5 = 0; s5 < 5; ++s5)
#pragma unroll
    for (int sub = 0; sub < 2; ++sub) {
      f32x4 a = {0.f, 0.f, 0.f, 0.f};
      int kb = 32 * (pair0 + s5) + 16 * sub;
#pragma unroll
      for (int ks = 0; ks < 2; ++ks) a = mfma16(*(const bf16x8*)(Ks + (kb + fr) * 72 + ks * 32 + fq * 8), qf[ks], a);
      st[s5][sub] = a;
    }
  const float slope_d = exp2f(-8.f * (float)(g * 4 + h + 1) / 12.f) * (float)d;
  const int qi = 16 * w + fr;
  float mx = -3.0e38f;
#pragma unroll
  for (int s5 = 0; s5 < 5; ++s5)
#pragma unroll
    for (int sub = 0; sub < 2; ++sub)
#pragma unroll
      for (int j = 0; j < 4; ++j) {
        int kb = 32 * (pair0 + s5) + 16 * sub + 4 * fq + j, rel = 128 + qi - kb;
        bool ok = (rel >= 0) && (rel <= 128) && (nbi > 0 || kb >= 128);
        float s = st[s5][sub][j] * 0.125f - slope_d * (float)rel;
        s = ok ? s : -3.0e38f;
        st[s5][sub][j] = s; mx = fmaxf(mx, s);
      }
  mx = fmaxf(mx, shfl_xor_l(mx, 16, lane)); mx = fmaxf(mx, shfl_xor_l(mx, 32, lane));
  float den = 0.f;
#pragma unroll
  for (int s5 = 0; s5 < 5; ++s5)
#pragma unroll
    for (int sub = 0; sub < 2; ++sub)
#pragma unroll
      for (int j = 0; j < 4; ++j) {
        float s = st[s5][sub][j];
        float pv = (s > -1.0e38f) ? __expf(s - mx) : 0.f;
        st[s5][sub][j] = pv; den += pv;
      }
  den += shfl_xor_l(den, 16, lane); den += shfl_xor_l(den, 32, lane);
  f32x4 ot[4];
#pragma unroll
  for (int et = 0; et < 4; ++et) ot[et] = (f32x4){0.f, 0.f, 0.f, 0.f};
#pragma unroll
  for (int s5 = 0; s5 < 5; ++s5) {
    union { bf16x8 v; unsigned u[4]; } pb;
    pb.u[0] = pk2_sw(st[s5][0][0], st[s5][0][1]); pb.u[1] = pk2_sw(st[s5][0][2], st[s5][0][3]);
    pb.u[2] = pk2_sw(st[s5][1][0], st[s5][1][1]); pb.u[3] = pk2_sw(st[s5][1][2], st[s5][1][3]);
    int kb0 = 32 * (pair0 + s5);
#pragma unroll
    for (int et = 0; et < 4; ++et) {
      union { bf16x8 v; uint2 h[2]; } av;
      av.h[0] = *(const uint2*)(VT + (et * 16 + fr) * 264 + kb0 + fq * 4);
      av.h[1] = *(const uint2*)(VT + (et * 16 + fr) * 264 + kb0 + 16 + fq * 4);
      ot[et] = mfma16(av.v, pb.v, ot[et]);
    }
  }
  float inv = 1.f / den;
  int tokq = (nbi * 128 + qi) * d + r;
  if (!do_store) { if (inv == 123.456f) c.lse[0] = ot[0][0] + ot[1][1] + ot[2][2] + ot[3][3]; return; }
#pragma unroll
  for (int et = 0; et < 4; ++et) {
    uint2 o; o.x = pk2(ot[et][0] * inv, ot[et][1] * inv); o.y = pk2(ot[et][2] * inv, ot[et][3] * inv);
    *(uint2*)(pj + (size_t)tokq * NPROJ + OFF_AQ + g * 256 + h * 64 + et * 16 + fq * 4) = o;
  }
  if (fq == 0) c.lse[((size_t)bl * 4096 + tokq) * 12 + g * 4 + h] = mx + __logf(den);
}

typedef short v4i16_t __attribute__((ext_vector_type(4)));
DEVI uint2 lds_tr16(const u16* p) {
  return __builtin_bit_cast(uint2, __builtin_amdgcn_ds_read_tr16_b64_v4i16((__attribute__((address_space(3))) v4i16_t*)p));
}


DEVI void sb_wave_phase(const MixCtx& c, unsigned char* smem) {
  const int tid = otid(c.wv), w = tid >> 6, lane = tid & 63, fr = lane & 15, fq = lane >> 4;
  u16* Vs = (u16*)smem + w * (32 * 72);
  for (int wi = oblk() * 8 + w; wi < 4096; wi += ogrd() * 8) {
    const int qg = 255 - (wi & 255), h = (wi >> 8) & 3, bl = wi >> 10;
    const u16* pj = c.proj + (size_t)bl * 4096 * NPROJ;
    const int t0 = qg * 16, t = t0 + fr;
    bf16x8 qf[2];
#pragma unroll
    for (int ks = 0; ks < 2; ++ks) qf[ks] = *(const bf16x8*)(pj + (size_t)t * NPROJ + OFF_DQ + h * 64 + ks * 32 + fq * 8);
    float carry = 0.f;
    f32x4 ot[4];
#pragma unroll
    for (int et = 0; et < 4; ++et) ot[et] = (f32x4){0.f, 0.f, 0.f, 0.f};
    const int s0 = (t0 + 14) >> 5;
    bf16x8 kn00, kn01, kn10, kn11; uint4 vn0, vn1, vn2, vn3;
    {
      const u16* kp = pj + (size_t)(s0 * 32 + fr) * NPROJ + OFF_DK + h * 64 + fq * 8;
      kn00 = *(const bf16x8*)(kp); kn01 = *(const bf16x8*)(kp + 32);
      kn10 = *(const bf16x8*)(kp + (size_t)16 * NPROJ); kn11 = *(const bf16x8*)(kp + (size_t)16 * NPROJ + 32);
      const u16* vp = pj + (size_t)(s0 * 32 + (lane >> 1)) * NPROJ + OFF_DV + h * 64 + (lane & 1) * 32;
      vn0 = *(const uint4*)(vp); vn1 = *(const uint4*)(vp + 8); vn2 = *(const uint4*)(vp + 16); vn3 = *(const uint4*)(vp + 24);
    }
    for (int step = s0; step >= 0; --step) {
      const bf16x8 kf00 = kn00, kf01 = kn01, kf10 = kn10, kf11 = kn11;
      {
        u16* vd = Vs + (lane >> 1) * 72 + (lane & 1) * 32;
        *(uint4*)(vd) = vn0; *(uint4*)(vd + 8) = vn1; *(uint4*)(vd + 16) = vn2; *(uint4*)(vd + 24) = vn3;
      }
      if (step > 0) {
        const u16* kp = pj + (size_t)((step - 1) * 32 + fr) * NPROJ + OFF_DK + h * 64 + fq * 8;
        kn00 = *(const bf16x8*)(kp); kn01 = *(const bf16x8*)(kp + 32);
        kn10 = *(const bf16x8*)(kp + (size_t)16 * NPROJ); kn11 = *(const bf16x8*)(kp + (size_t)16 * NPROJ + 32);
        const u16* vp = pj + (size_t)((step - 1) * 32 + (lane >> 1)) * NPROJ + OFF_DV + h * 64 + (lane & 1) * 32;
        vn0 = *(const uint4*)(vp); vn1 = *(const uint4*)(vp + 8); vn2 = *(const uint4*)(vp + 16); vn3 = *(const uint4*)(vp + 24);
      }
      f32x4 z[2];
      z[0] = mfma16(kf01, qf[1], mfma16(kf00, qf[0], (f32x4){0.f, 0.f, 0.f, 0.f}));
      z[1] = mfma16(kf11, qf[1], mfma16(kf10, qf[0], (f32x4){0.f, 0.f, 0.f, 0.f}));
      float ls[2][4], lk[2][4], L[2];
#pragma unroll
      for (int sub = 0; sub < 2; ++sub) {
        L[sub] = 0.f;
#pragma unroll
        for (int j = 0; j < 4; ++j) {
          int key = step * 32 + 16 * sub + 4 * fq + j;
          float zz = z[sub][j] * 0.125f;
          float l_ = logsigf_(zz);
          bool m = key < t;
          ls[sub][j] = m ? l_ : -3.0e38f;
          lk[sub][j] = m ? (l_ - zz) : 0.f;
          L[sub] += lk[sub][j];
        }
      }
      float a0[4], a1[4];
#pragma unroll
      for (int gq = 0; gq < 4; ++gq) { a0[gq] = shfl_l(L[0], fr + 16 * gq); a1[gq] = shfl_l(L[1], fr + 16 * gq); }
      float tot0 = a0[0] + a0[1] + a0[2] + a0[3], tot1 = a1[0] + a1[1] + a1[2] + a1[3];
      float suf0 = 0.f, suf1 = 0.f;
#pragma unroll
      for (int gq = 1; gq < 4; ++gq) { if (gq > fq) { suf0 += a0[gq]; suf1 += a1[gq]; } }
      float base[2]; base[1] = carry + suf1; base[0] = carry + tot1 + suf0;
      float wv[2][4];
#pragma unroll
      for (int sub = 0; sub < 2; ++sub) {
        float run = base[sub];
#pragma unroll
        for (int j = 3; j >= 0; --j) {
          float e = ls[sub][j] + run;
          wv[sub][j] = (ls[sub][j] > -1.0e38f) ? __expf(e) : 0.f;
          run += lk[sub][j];
        }
      }
      carry += tot0 + tot1;
      union { bf16x8 v; unsigned u[4]; } pb;
      pb.u[0] = pk2_sw(wv[0][0], wv[0][1]); pb.u[1] = pk2_sw(wv[0][2], wv[0][3]); pb.u[2] = pk2_sw(wv[1][0], wv[1][1]); pb.u[3] = pk2_sw(wv[1][2], wv[1][3]);
      const u16* vb = Vs + (fq * 4 + (fr >> 2)) * 72 + 4 * (fr & 3);
#pragma unroll
      for (int et = 0; et < 4; ++et) {
        union { bf16x8 v; uint2 h[2]; } av;
        av.h[0] = lds_tr16(vb + et * 16);
        av.h[1] = lds_tr16(vb + 16 * 72 + et * 16);
        ot[et] = mfma16(av.v, pb.v, ot[et]);
      }
      if (__all(carry < -104.f)) break;
    }
    u16* brp = c.br + ((size_t)bl * 4096 + t) * BRW + 1024 + h * 64;
    float one = 1.f; asm volatile("" : "+v"(one));
#pragma unroll
    for (int et = 0; et < 4; ++et) {
      uint2 o; o.x = pk2(ot[et][0] * one, ot[et][1] * one); o.y = pk2(ot[et][2] * one, ot[et][3] * one);
      *(uint2*)(brp + et * 16 + fq * 4) = o;
    }
  }
}

struct DswaIt { int bl, g, h, d, r, nbi; };
DEVI DswaIt dswa_decode(int item) {
  DswaIt q; int blk = item & 31; q.h = (item >> 5) & 3; int gb = item >> 7; q.g = gb % 3; q.bl = gb / 3;
  q.d = (q.g == 0) ? 1 : (q.g == 1 ? 4 : 16); int nbr = 32 / q.d; q.r = blk / nbr; q.nbi = blk % nbr; return q;
}
#define DSWA_RAW_LOAD(ITEM)                                                                                          \
  {                                                                                                                    \
    const DswaIt q_ = dswa_decode(ITEM);                                                                               \
    const u16* pj_ = c.proj + (size_t)q_.bl * 4096 * NPROJ + q_.g * 256 + q_.h * 64 + (tid & 7) * 8;                    \
    _Pragma("unroll") for (int i_ = 0; i_ < 2; ++i_) {                                                                 \
      int row_ = (tid + 512 * i_) >> 3, tok_ = (q_.nbi * 128 + row_) * q_.d + q_.r;                                    \
      rq[i_] = *(const uint4*)(pj_ + (size_t)tok_ * NPROJ + OFF_AQ); }                                                 \
    _Pragma("unroll") for (int i_ = 0; i_ < 4; ++i_) {                                                                 \
      int row_ = (tid + 512 * i_) >> 3, sub_ = (q_.nbi - 1) * 128 + row_; bool ok_ = sub_ >= 0;                        \
      int tok_ = ok_ ? sub_ * q_.d + q_.r : 0;                                                                         \
      rk[i_] = *(const uint4*)(pj_ + (size_t)tok_ * NPROJ + OFF_AK); rv[i_] = *(const uint4*)(pj_ + (size_t)tok_ * NPROJ + OFF_AV); \
      if (!ok_) { rk[i_] = make_uint4(0, 0, 0, 0); rv[i_] = rk[i_]; } }                                                \
  }

DEVI void dswa_block_phase(const MixCtx& c, unsigned char* smem) {
  const int tid = otid(c.wv), w = tid >> 6, lane = tid & 63, fr = lane & 15, fq = lane >> 4, ch = tid & 7;
  u16* Qs = (u16*)smem; u16* Ks = Qs + 128 * 72; u16* Vs = Ks + 256 * 72;
  const float* qgp = KP(q_gain) + c.l * 64 + ch * 8; const float* kgp = KP(k_gain) + c.l * 64 + ch * 8;
  float qg[8], kg[8];
#pragma unroll
  for (int j = 0; j < 8; ++j) { qg[j] = qgp[j]; kg[j] = kgp[j]; }
  const int G = ogrd();
  int it = oblk();
  uint4 rq[2], rk[4], rv[4];
  if (it < 1536) DSWA_RAW_LOAD(it)
  for (; it < 1536; it += G) {
    const DswaIt q = dswa_decode(it);
#pragma unroll
    for (int i = 0; i < 2; ++i) {
      int row = (tid + 512 * i) >> 3;
      float v[8]; unpack8(rq[i], v);
      float ss = 0.f;
#pragma unroll
      for (int j = 0; j < 8; ++j) ss += v[j] * v[j];
      ss += shfl_xor_l(ss, 1, lane); ss += shfl_xor_l(ss, 2, lane); ss += shfl_xor_l(ss, 4, lane);
      float sc = rsqrtf(ss * (1.f / 64.f) + EPS);
      uint4 o; o.x = pk2(v[0] * sc * qg[0], v[1] * sc * qg[1]); o.y = pk2(v[2] * sc * qg[2], v[3] * sc * qg[3]);
      o.z = pk2(v[4] * sc * qg[4], v[5] * sc * qg[5]); o.w = pk2(v[6] * sc * qg[6], v[7] * sc * qg[7]);
      *(uint4*)(Qs + row * 72 + ch * 8) = o;
    }
#pragma unroll
    for (int i = 0; i < 4; ++i) {
      int row = (tid + 512 * i) >> 3;
      float v[8]; unpack8(rk[i], v);
      float ss = 0.f;
#pragma unroll
      for (int j = 0; j < 8; ++j) ss += v[j] * v[j];
      ss += shfl_xor_l(ss, 1, lane); ss += shfl_xor_l(ss, 2, lane); ss += shfl_xor_l(ss, 4, lane);
      float sc = rsqrtf(ss * (1.f / 64.f) + EPS);
      uint4 o; o.x = pk2(v[0] * sc * kg[0], v[1] * sc * kg[1]); o.y = pk2(v[2] * sc * kg[2], v[3] * sc * kg[3]);
      o.z = pk2(v[4] * sc * kg[4], v[5] * sc * kg[5]); o.w = pk2(v[6] * sc * kg[6], v[7] * sc * kg[7]);
      *(uint4*)(Ks + row * 72 + ch * 8) = o;
      *(uint4*)(Vs + row * 72 + ch * 8) = rv[i];
    }
    __syncthreads();
    if (it + G < 1536) DSWA_RAW_LOAD(it + G)
    bf16x8 qf[2];
#pragma unroll
    for (int ks = 0; ks < 2; ++ks) qf[ks] = *(const bf16x8*)(Qs + (16 * w + fr) * 72 + ks * 32 + fq * 8);
    const int pair0 = w >> 1;
    f32x4 st[5][2];
#pragma unroll
    for (int s5 = 0; s5 < 5; ++s5)
#pragma unroll
      for (int sub = 0; sub < 2; ++sub) {
        f32x4 a = {0.f, 0.f, 0.f, 0.f};
        int kb = 32 * (pair0 + s5) + 16 * sub;
#pragma unroll
        for (int ks = 0; ks < 2; ++ks) a = mfma16(*(const bf16x8*)(Ks + (kb + fr) * 72 + ks * 32 + fq * 8), qf[ks], a);
        st[s5][sub] = a;
      }
    const float slope_d = exp2f(-8.f * (float)(q.g * 4 + q.h + 1) / 12.f) * (float)q.d * 1.44269504f;
    int qi = 16 * w + fr;
    asm volatile("" : "+v"(qi));
    float mx = -3.0e38f;
#pragma unroll
    for (int s5 = 0; s5 < 5; ++s5)
#pragma unroll
      for (int sub = 0; sub < 2; ++sub)
#pragma unroll
        for (int j = 0; j < 4; ++j) {
          int kb = 32 * (pair0 + s5) + 16 * sub + 4 * fq + j, rel = 128 + qi - kb;
          bool ok = (rel >= 0) && (rel <= 128) && (q.nbi > 0 || kb >= 128);
          float sv = st[s5][sub][j] * (0.125f * 1.44269504f) - slope_d * (float)rel;
          sv = ok ? sv : -3.0e38f;
          st[s5][sub][j] = sv; mx = fmaxf(mx, sv);
        }
    mx = fmaxf(mx, shfl_xor_l(mx, 16, lane)); mx = fmaxf(mx, shfl_xor_l(mx, 32, lane));
    float den = 0.f;
#pragma unroll
    for (int s5 = 0; s5 < 5; ++s5)
#pragma unroll
      for (int sub = 0; sub < 2; ++sub)
#pragma unroll
        for (int j = 0; j < 4; ++j) {
          float sv = st[s5][sub][j];
          float pv = (sv > -1.0e38f) ? __builtin_amdgcn_exp2f(sv - mx) : 0.f;
          st[s5][sub][j] = pv; den += pv;
        }
    den += shfl_xor_l(den, 16, lane); den += shfl_xor_l(den, 32, lane);
    f32x4 ot[4];
#pragma unroll
    for (int et = 0; et < 4; ++et) ot[et] = (f32x4){0.f, 0.f, 0.f, 0.f};
#pragma unroll
    for (int s5 = 0; s5 < 5; ++s5) {
      u32x4_t pbu = {pk2_sw(st[s5][0][0], st[s5][0][1]), pk2_sw(st[s5][0][2], st[s5][0][3]), pk2_sw(st[s5][1][0], st[s5][1][1]), pk2_sw(st[s5][1][2], st[s5][1][3])};
      const bf16x8 pb = __builtin_bit_cast(bf16x8, pbu);
      const u16* vb = Vs + (32 * (pair0 + s5) + fq * 4 + (fr >> 2)) * 72 + 4 * (fr & 3);
#pragma unroll
      for (int et = 0; et < 4; ++et) ot[et] = mfma16(mk8(lds_tr16(vb + et * 16), lds_tr16(vb + 16 * 72 + et * 16)), pb, ot[et]);
    }
    const float inv = 1.f / den;
    const int tokq = (q.nbi * 128 + qi) * q.d + q.r;
    u16* pj = c.proj + (size_t)q.bl * 4096 * NPROJ;
#pragma unroll
    for (int et = 0; et < 4; ++et) {
      uint2 o; o.x = pk2(ot[et][0] * inv, ot[et][1] * inv); o.y = pk2(ot[et][2] * inv, ot[et][3] * inv);
      *(uint2*)(pj + (size_t)tokq * NPROJ + OFF_AQ + q.g * 256 + q.h * 64 + et * 16 + fq * 4) = o;
    }
    if (fq == 0) c.lse[((size_t)q.bl * 4096 + tokq) * 12 + q.g * 4 + q.h] = (mx + __log2f(den)) * 0.69314718f;
    __syncthreads();
  }
}
#undef DSWA_RAW_LOAD

DEVI void dswa_wave_phase(const MixCtx& c, unsigned char* smem) {
  const int tid = otid(c.wv), w = tid >> 6, lane = tid & 63, fr = lane & 15, fq = lane >> 4;
  u16* Vs = (u16*)smem + w * (32 * 72);
  const float* qgp = KP(q_gain) + c.l * 64; const float* kgp = KP(k_gain) + c.l * 64;
  float qg[16], kg[16];
#pragma unroll
  for (int ks = 0; ks < 2; ++ks)
#pragma unroll
    for (int j = 0; j < 8; ++j) { qg[ks * 8 + j] = qgp[ks * 32 + fq * 8 + j]; kg[ks * 8 + j] = kgp[ks * 32 + fq * 8 + j]; }
  for (int wi = oblk() * 8 + w; wi < 12288; wi += ogrd() * 8) {
    const int wq = wi & 7, blk = (wi >> 3) & 31, h = (wi >> 8) & 3, gb = wi >> 10, g = gb % 3, bl = gb / 3;
    const int d = (g == 0) ? 1 : (g == 1 ? 4 : 16), nbr = 32 / d, r = blk / nbr, nbi = blk % nbr;
    u16* pj = c.proj + (size_t)bl * 4096 * NPROJ;
    const int qi = 16 * wq + fr, tokq = (nbi * 128 + qi) * d + r;
    const int colq = OFF_AQ + g * 256 + h * 64, colk = OFF_AK + g * 256 + h * 64, colv = OFF_AV + g * 256 + h * 64;
    bf16x8 qf0, qf1;
    {
      uint4 r0 = *(const uint4*)(pj + (size_t)tokq * NPROJ + colq + fq * 8), r1 = *(const uint4*)(pj + (size_t)tokq * NPROJ + colq + 32 + fq * 8);
      float a[8], b[8]; unpack8(r0, a); unpack8(r1, b);
      float ss = 0.f;
#pragma unroll
      for (int j = 0; j < 8; ++j) ss += a[j] * a[j] + b[j] * b[j];
      ss += shfl_xor_l(ss, 16, lane); ss += shfl_xor_l(ss, 32, lane);
      float sc = rsqrtf(ss * (1.f / 64.f) + EPS);
      u32x4_t p0 = {pk2(a[0] * sc * qg[0], a[1] * sc * qg[1]), pk2(a[2] * sc * qg[2], a[3] * sc * qg[3]), pk2(a[4] * sc * qg[4], a[5] * sc * qg[5]), pk2(a[6] * sc * qg[6], a[7] * sc * qg[7])};
      u32x4_t p1 = {pk2(b[0] * sc * qg[8], b[1] * sc * qg[9]), pk2(b[2] * sc * qg[10], b[3] * sc * qg[11]), pk2(b[4] * sc * qg[12], b[5] * sc * qg[13]), pk2(b[6] * sc * qg[14], b[7] * sc * qg[15])};
      qf0 = __builtin_bit_cast(bf16x8, p0); qf1 = __builtin_bit_cast(bf16x8, p1);
    }
    const int pair0 = wq >> 1, sub0 = (nbi - 1) * 128;
    const float slope_d = exp2f(-8.f * (float)(g * 4 + h + 1) / 12.f) * (float)d;
    uint4 kn00, kn01, kn10, kn11, vn0, vn1, vn2, vn3;
#define DSWA_LOAD(P)                                                                                              \
    {                                                                                                               \
      const int kbA = 32 * (pair0 + (P)) + fr, sA = sub0 + kbA, sB = sA + 16;                                        \
      const u16* pa = pj + (size_t)((sA >= 0 ? sA : 0) * d + r) * NPROJ + colk + fq * 8;                             \
      const u16* pb_ = pj + (size_t)((sB >= 0 ? sB : 0) * d + r) * NPROJ + colk + fq * 8;                            \
      kn00 = *(const uint4*)(pa); kn01 = *(const uint4*)(pa + 32); kn10 = *(const uint4*)(pb_); kn11 = *(const uint4*)(pb_ + 32); \
      if (sA < 0) { kn00 = make_uint4(0, 0, 0, 0); kn01 = kn00; }                                                    \
      if (sB < 0) { kn10 = make_uint4(0, 0, 0, 0); kn11 = kn10; }                                                    \
      const int sV = sub0 + 32 * (pair0 + (P)) + (lane >> 1);                                                        \
      const u16* pv = pj + (size_t)((sV >= 0 ? sV : 0) * d + r) * NPROJ + colv + (lane & 1) * 32;                    \
      vn0 = *(const uint4*)(pv); vn1 = *(const uint4*)(pv + 8); vn2 = *(const uint4*)(pv + 16); vn3 = *(const uint4*)(pv + 24); \
      if (sV < 0) { vn0 = make_uint4(0, 0, 0, 0); vn1 = vn0; vn2 = vn0; vn3 = vn0; }                                 \
    }
    DSWA_LOAD(0)
    float mrun = -3.0e38f, den = 0.f;
    f32x4 ot[4];
#pragma unroll
    for (int et = 0; et < 4; ++et) ot[et] = (f32x4){0.f, 0.f, 0.f, 0.f};
    for (int p = 0; p < 5; ++p) {
      const uint4 k00 = kn00, k01 = kn01, k10 = kn10, k11 = kn11;
      {
        u16* vd = Vs + (lane >> 1) * 72 + (lane & 1) * 32;
        *(uint4*)(vd) = vn0; *(uint4*)(vd + 8) = vn1; *(uint4*)(vd + 16) = vn2; *(uint4*)(vd + 24) = vn3;
      }
      if (p < 4) DSWA_LOAD(p + 1)
      bf16x8 kf[2][2];
#pragma unroll
      for (int sub = 0; sub < 2; ++sub) {
        float a[8], b[8]; unpack8(sub ? k10 : k00, a); unpack8(sub ? k11 : k01, b);
        float ss = 0.f;
#pragma unroll
        for (int j = 0; j < 8; ++j) ss += a[j] * a[j] + b[j] * b[j];
        ss += shfl_xor_l(ss, 16, lane); ss += shfl_xor_l(ss, 32, lane);
        float sc = rsqrtf(ss * (1.f / 64.f) + EPS);
        u32x4_t p0 = {pk2(a[0] * sc * kg[0], a[1] * sc * kg[1]), pk2(a[2] * sc * kg[2], a[3] * sc * kg[3]), pk2(a[4] * sc * kg[4], a[5] * sc * kg[5]), pk2(a[6] * sc * kg[6], a[7] * sc * kg[7])};
        u32x4_t p1 = {pk2(b[0] * sc * kg[8], b[1] * sc * kg[9]), pk2(b[2] * sc * kg[10], b[3] * sc * kg[11]), pk2(b[4] * sc * kg[12], b[5] * sc * kg[13]), pk2(b[6] * sc * kg[14], b[7] * sc * kg[15])};
        kf[sub][0] = __builtin_bit_cast(bf16x8, p0); kf[sub][1] = __builtin_bit_cast(bf16x8, p1);
      }
      f32x4 z[2];
      z[0] = mfma16(kf[0][1], qf1, mfma16(kf[0][0], qf0, (f32x4){0.f, 0.f, 0.f, 0.f}));
      z[1] = mfma16(kf[1][1], qf1, mfma16(kf[1][0], qf0, (f32x4){0.f, 0.f, 0.f, 0.f}));
      float sv[2][4], mx = mrun;
#pragma unroll
      for (int sub = 0; sub < 2; ++sub)
#pragma unroll
        for (int j = 0; j < 4; ++j) {
          const int kb = 32 * (pair0 + p) + 16 * sub + 4 * fq + j, rel = 128 + qi - kb;
          const bool ok = (rel >= 0) && (rel <= 128) && (nbi > 0 || kb >= 128);
          float sc_ = z[sub][j] * 0.125f - slope_d * (float)rel;
          sc_ = ok ? sc_ : -3.0e38f;
          sv[sub][j] = sc_; mx = fmaxf(mx, sc_);
        }
      mx = fmaxf(mx, shfl_xor_l(mx, 16, lane)); mx = fmaxf(mx, shfl_xor_l(mx, 32, lane));
      const float alpha = __expf(mrun - mx);
      mrun = mx;
      float ps = 0.f;
#pragma unroll
      for (int sub = 0; sub < 2; ++sub)
#pragma unroll
        for (int j = 0; j < 4; ++j) { float pv = (sv[sub][j] > -1.0e38f) ? __expf(sv[sub][j] - mx) : 0.f; sv[sub][j] = pv; ps += pv; }
      ps += shfl_xor_l(ps, 16, lane); ps += shfl_xor_l(ps, 32, lane);
      den = den * alpha + ps;
#pragma unroll
      for (int et = 0; et < 4; ++et) { ot[et][0] *= alpha; ot[et][1] *= alpha; ot[et][2] *= alpha; ot[et][3] *= alpha; }
      u32x4_t pbu = {pk2_sw(sv[0][0], sv[0][1]), pk2_sw(sv[0][2], sv[0][3]), pk2_sw(sv[1][0], sv[1][1]), pk2_sw(sv[1][2], sv[1][3])};
      const bf16x8 pb = __builtin_bit_cast(bf16x8, pbu);
      const u16* vb = Vs + (fq * 4 + (fr >> 2)) * 72 + 4 * (fr & 3);
#pragma unroll
      for (int et = 0; et < 4; ++et) ot[et] = mfma16(mk8(lds_tr16(vb + et * 16), lds_tr16(vb + 16 * 72 + et * 16)), pb, ot[et]);
    }
#undef DSWA_LOAD
    const float inv = 1.f / den;
#pragma unroll
    for (int et = 0; et < 4; ++et) {
      uint2 o; o.x = pk2(ot[et][0] * inv, ot[et][1] * inv); o.y = pk2(ot[et][2] * inv, ot[et][3] * inv);
      *(uint2*)(pj + (size_t)tokq * NPROJ + colq + et * 16 + fq * 4) = o;
    }
    if (fq == 0) c.lse[((size_t)bl * 4096 + tokq) * 12 + g * 4 + h] = mrun + __logf(den);
  }
}

DEVI void conv_item(const MixCtx& c, int item, unsigned char* smem) {
  const int tid = otid(c.wv), w = tid >> 6, lane = tid & 63;
  int bl = item >> 7, t0 = (item & 127) * 32;
  float* ys = (float*)smem; float* cs = ys + 62 * 256;
  const u16* pj = c.proj + (size_t)bl * 4096 * NPROJ;
#pragma unroll
  for (int q = 0; q < 4; ++q) {
    int ci = tid + 512 * q;
    if (ci < 62 * 32) {
      int i = ci >> 5, c8 = (ci & 31) * 8, t = t0 - 30 + i;
      float y[8];
      if (t >= 0) {
        float a[8], g[8];
        unpack8(*(const uint4*)(pj + (size_t)t * NPROJ + OFF_CONV + c8), a);
        unpack8(*(const uint4*)(pj + (size_t)t * NPROJ + OFF_CONV + 256 + c8), g);
#pragma unroll
        for (int e = 0; e < 8; ++e) y[e] = a[e] * sigmoidf_(g[e]);
      } else {
#pragma unroll
        for (int e = 0; e < 8; ++e) y[e] = 0.f;
      }
      *(float4*)(ys + i * 256 + c8) = make_float4(y[0], y[1], y[2], y[3]);
      *(float4*)(ys + i * 256 + c8 + 4) = make_float4(y[4], y[5], y[6], y[7]);
    }
  }
  __syncthreads();
  {
    int ch = tid & 255, tg = tid >> 8;
    float wj[31];
    const float* cw = KP(conv_w) + (size_t)c.l * 31 * 256 + ch;
#pragma unroll
    for (int j = 0; j < 31; ++j) wj[j] = cw[j * 256];
    float bias = KP(conv_b)[c.l * 256 + ch];
    float acc[16];
#pragma unroll
    for (int tl = 0; tl < 16; ++tl) acc[tl] = bias;
#pragma unroll
    for (int i = 0; i < 46; ++i) {
      float v = ys[(tg * 16 + i) * 256 + ch];
#pragma unroll
      for (int tl = 0; tl < 16; ++tl) { const int d = i - tl, dc = d < 0 ? 0 : (d > 30 ? 30 : d); if (d >= 0 && d <= 30) acc[tl] += wj[dc] * v; }
    }
#pragma unroll
    for (int tl = 0; tl < 16; ++tl) cs[(tg * 16 + tl) * 256 + ch] = acc[tl];
  }
  __syncthreads();
  const float* lng = KP(conv_ln_g) + c.l * 256; const float* lnb = KP(conv_ln_b) + c.l * 256;
#pragma unroll
  for (int q = 0; q < 4; ++q) {
    int tok = w * 4 + q;
    float v[4], s = 0.f;
#pragma unroll
    for (int i = 0; i < 4; ++i) { v[i] = cs[tok * 256 + lane + 64 * i]; s += v[i]; }
#pragma unroll
    for (int o = 1; o < 64; o <<= 1) s += shfl_xor_l(s, o, lane);
    float mu = s * (1.f / 256.f), s2 = 0.f;
#pragma unroll
    for (int i = 0; i < 4; ++i) { v[i] -= mu; s2 += v[i] * v[i]; }
#pragma unroll
    for (int o = 1; o < 64; o <<= 1) s2 += shfl_xor_l(s2, o, lane);
    float rs = rsqrtf(s2 * (1.f / 256.f) + EPS);
    u16* o = c.br + ((size_t)bl * 4096 + t0 + tok) * BRW + 256;
#pragma unroll
    for (int i = 0; i < 4; ++i) {
      int ch = lane + 64 * i;
      float y = v[i] * rs * lng[ch] + lnb[ch];
      o[ch] = f2bf(y * sigmoidf_(y));
    }
  }
}

DEVI void gla_cum8(const float (&xg)[8], float* segtot, float (&cum)[8], int tid) {
  const int lane = tid & 63, w = tid >> 6, kc = tid & 7;
#pragma unroll
  for (int j = 0; j < 8; ++j) cum[j] = logsigf_(xg[j]) * (1.f / 16.f);
#pragma unroll
  for (int j = 0; j < 8; ++j) {
    float o = shfl_up_l(cum[j], 8, lane); if (lane >= 8) cum[j] += o;
    o = shfl_up_l(cum[j], 16, lane); if (lane >= 16) cum[j] += o;
    o = shfl_up_l(cum[j], 32, lane); if (lane >= 32) cum[j] += o;
  }
  if (lane >= 56) {
    *(float4*)(segtot + w * 64 + kc * 8) = make_float4(cum[0], cum[1], cum[2], cum[3]);
    *(float4*)(segtot + w * 64 + kc * 8 + 4) = make_float4(cum[4], cum[5], cum[6], cum[7]);
  }
  __syncthreads();
#pragma unroll
  for (int ww = 0; ww < 7; ++ww) {
    float4 a = *(const float4*)(segtot + ww * 64 + kc * 8), b = *(const float4*)(segtot + ww * 64 + kc * 8 + 4);
    if (ww < w) { cum[0] += a.x; cum[1] += a.y; cum[2] += a.z; cum[3] += a.w; cum[4] += b.x; cum[5] += b.y; cum[6] += b.z; cum[7] += b.w; }
  }
}

DEVI void gla_gate8(const float4 (&gl)[4], const float* wgS, const float* bgp, int kc, float (&xg)[8]) {
  const float g[16] = {gl[0].x, gl[0].y, gl[0].z, gl[0].w, gl[1].x, gl[1].y, gl[1].z, gl[1].w, gl[2].x, gl[2].y, gl[2].z, gl[2].w, gl[3].x, gl[3].y, gl[3].z, gl[3].w};
#pragma unroll
  for (int j = 0; j < 8; ++j) xg[j] = bgp[kc * 8 + j];
#pragma unroll
  for (int r = 0; r < 16; ++r) {
    float4 a = *(const float4*)(wgS + r * 64 + kc * 8), b = *(const float4*)(wgS + r * 64 + kc * 8 + 4);
    xg[0] += g[r] * a.x; xg[1] += g[r] * a.y; xg[2] += g[r] * a.z; xg[3] += g[r] * a.w;
    xg[4] += g[r] * b.x; xg[5] += g[r] * b.y; xg[6] += g[r] * b.z; xg[7] += g[r] * b.w;
  }
}

DEVI void gla_local_item(const MixCtx& c, int unit, unsigned char* smem) {
  const int tid = otid(c.wv), w = tid >> 6, lane = tid & 63, fr = lane & 15, fq = lane >> 4;
  int ch = unit & 63, h = (unit >> 6) & 3, bl = unit >> 8, tok0 = ch * 64;
  float* segtot = (float*)smem;
  u16* keS = (u16*)(smem + 2048);
  u16* vS = (u16*)(smem + 20480);
  const u16* pj = c.proj + (size_t)bl * 4096 * NPROJ;
  const float* bgp = KP(gla_b_gate) + c.l * 256 + h * 64;
  const int t = tid >> 3, kc = tid & 7;
  const float4* glp = (const float4*)(c.glow + ((size_t)bl * 4096 + tok0 + t) * 256 + h * 64 + kc * 8);
  const float4 xg0 = glp[0], xg1 = glp[1];
  uint4 kraw = *(const uint4*)(pj + (size_t)(tok0 + t) * NPROJ + OFF_CK + h * 64 + kc * 8);
  const uint4 vraw0 = *(const uint4*)(pj + (size_t)(tok0 + (tid >> 4)) * NPROJ + OFF_CV + h * 128 + (tid & 15) * 8);
  const uint4 vraw1 = *(const uint4*)(pj + (size_t)(tok0 + 32 + (tid >> 4)) * NPROJ + OFF_CV + h * 128 + (tid & 15) * 8);
  const float xg[8] = {xg0.x, xg0.y, xg0.z, xg0.w, xg1.x, xg1.y, xg1.z, xg1.w};
  float cum[8];
  gla_cum8(xg, segtot, cum, tid);
  {
    float last[8];
#pragma unroll
    for (int j = 0; j < 8; ++j) last[j] = 0.f;
#pragma unroll
    for (int ww = 0; ww < 8; ++ww) {
      float4 a = *(const float4*)(segtot + ww * 64 + kc * 8), b = *(const float4*)(segtot + ww * 64 + kc * 8 + 4);
      last[0] += a.x; last[1] += a.y; last[2] += a.z; last[3] += a.w; last[4] += b.x; last[5] += b.y; last[6] += b.z; last[7] += b.w;
    }
    float kv[8]; unpack8(kraw, kv);
    uint4 o;
    o.x = pk2(kv[0] * __expf(last[0] - cum[0]), kv[1] * __expf(last[1] - cum[1])); o.y = pk2(kv[2] * __expf(last[2] - cum[2]), kv[3] * __expf(last[3] - cum[3]));
    o.z = pk2(kv[4] * __expf(last[4] - cum[4]), kv[5] * __expf(last[5] - cum[5])); o.w = pk2(kv[6] * __expf(last[6] - cum[6]), kv[7] * __expf(last[7] - cum[7]));
    *(uint4*)(keS + t * 72 + kc * 8) = o;
    if (tid < 8) {
      float4 e0 = make_float4(__expf(last[0]), __expf(last[1]), __expf(last[2]), __expf(last[3])), e1 = make_float4(__expf(last[4]), __expf(last[5]), __expf(last[6]), __expf(last[7]));
      *(float4*)(c.gdec + (size_t)unit * 64 + kc * 8) = e0; *(float4*)(c.gdec + (size_t)unit * 64 + kc * 8 + 4) = e1;
    }
    *(uint4*)(vS + (tid >> 4) * 136 + (tid & 15) * 8) = vraw0;
    *(uint4*)(vS + (32 + (tid >> 4)) * 136 + (tid & 15) * 8) = vraw1;
  }
  __syncthreads();
  bf16x8 af[2];
#pragma unroll
  for (int ks = 0; ks < 2; ++ks) {
    const u16* vb = vS + (ks * 32 + fq * 8 + (fr >> 2)) * 136 + 16 * w + 4 * (fr & 3);
    af[ks] = mk8(lds_tr16(vb), lds_tr16(vb + 4 * 136));
  }
  float* S = c.S + (size_t)unit * 8192;
#pragma unroll
  for (int jt = 0; jt < 4; ++jt) {
    f32x4 a = {0.f, 0.f, 0.f, 0.f};
#pragma unroll
    for (int ks = 0; ks < 2; ++ks) {
      const u16* kb = keS + (ks * 32 + fq * 8 + (fr >> 2)) * 72 + 16 * jt + 4 * (fr & 3);
      a = mfma16(af[ks], mk8(lds_tr16(kb), lds_tr16(kb + 4 * 72)), a);
    }
#pragma unroll
    for (int j = 0; j < 4; ++j) S[(16 * w + fq * 4 + j) * 64 + 16 * jt + fr] = a[j];
  }
}

DEVI void gla_scan_phase(const MixCtx& c) {
  long gtid = (long)oblk() * 512 + otid(c.wv), gsz = (long)ogrd() * 512;
  for (long idx = gtid; idx < 16L * 8192; idx += gsz) {
    int bh = (int)(idx >> 13), e = (int)(idx & 8191), k = e & 63;
    float* __restrict__ S = c.S + (size_t)bh * 64 * 8192 + e;
    const float* __restrict__ gd = c.gdec + (size_t)bh * 64 * 64 + k;
    float run = 0.f;
    for (int c0 = 0; c0 < 64; c0 += 32) {
      float loc[32], g[32];
#pragma unroll
      for (int i = 0; i < 32; ++i) { loc[i] = S[(size_t)(c0 + i) * 8192]; g[i] = gd[(c0 + i) * 64]; }
#pragma unroll
      for (int i = 0; i < 32; ++i) { S[(size_t)(c0 + i) * 8192] = run; run = g[i] * run + loc[i]; }
    }
  }
}

DEVI void gla_tok0_partials(const MixCtx& c) {
  const int tid = otid(c.wv), w = tid >> 6, lane = tid & 63;
  float* c0p = (float*)(KWS() + O_C0);
  for (int wi = oblk() * 8 + w; wi < 512; wi += ogrd() * 8) {
    int ks = wi & 15, qk = (wi >> 4) & 1, h = (wi >> 5) & 3, bl = wi >> 7, b = c.hf * 4 + bl;
    const float* xr = ((c.l == 0) ? KP(x) : (const float*)KOUT()) + (size_t)b * 4096 * 1024;
    const float* mf = (const float*)(KWS() + O_MODF) + ((size_t)c.l * 8 + b) * 6144;
    float ss = 0.f;
#pragma unroll
    for (int j = 0; j < 4; ++j) { float4 v = ((const float4*)xr)[lane + 64 * j]; ss += v.x * v.x + v.y * v.y + v.z * v.z + v.w * v.w; }
#pragma unroll
    for (int o = 1; o < 64; o <<= 1) ss += shfl_xor_l(ss, o, lane);
    float rs = rsqrtf(ss * (1.f / 1024.f) + EPS);
    int i0 = ks * 64 + lane;
    float h0 = xr[i0] * rs * mf[i0] + mf[1024 + i0];
    const float* wp = KP(w_in) + (size_t)c.l * 1024 * INW + (size_t)(ks * 64) * INW + (qk ? 3072 : 2816) + h * 64 + lane;
    float a = 0.f;
    float wrow[64];
#pragma unroll
    for (int i = 0; i < 64; ++i) wrow[i] = wp[(size_t)i * INW];
#pragma unroll
    for (int i = 0; i < 64; ++i) a += shfl_l(h0, i) * wrow[i];
    c0p[(size_t)wi * 64 + lane] = a;
  }
}

#define GLA_OUT_LOAD(U)                                                                                                  \
  {                                                                                                                        \
    const int ch_ = (U) & 63, h_ = ((U) >> 6) & 3, bl_ = (U) >> 8, tok0_ = ch_ * 64;                                        \
    const u16* pj_ = c.proj + (size_t)bl_ * 4096 * NPROJ;                                                                  \
    const u16* rowp_ = pj_ + (size_t)(tok0_ + t) * NPROJ + h_ * 64 + kc * 8;                                                \
    qraw = *(const uint4*)(rowp_ + OFF_CQ); kraw = *(const uint4*)(rowp_ + OFF_CK);                                         \
    const float4* glp_ = (const float4*)(c.glow + ((size_t)bl_ * 4096 + tok0_ + t) * 256 + h_ * 64 + kc * 8);               \
    xg0 = glp_[0]; xg1 = glp_[1];                                                                                          \
    vraw0 = *(const uint4*)(pj_ + (size_t)(tok0_ + (tid >> 4)) * NPROJ + OFF_CV + h_ * 128 + (tid & 15) * 8);               \
    vraw1 = *(const uint4*)(pj_ + (size_t)(tok0_ + 32 + (tid >> 4)) * NPROJ + OFF_CV + h_ * 128 + (tid & 15) * 8);          \
    rraw0 = *(const uint4*)(pj_ + (size_t)(tok0_ + t) * NPROJ + OFF_CR + h_ * 128 + kc * 16);                               \
    rraw1 = *(const uint4*)(pj_ + (size_t)(tok0_ + t) * NPROJ + OFF_CR + h_ * 128 + kc * 16 + 8);                           \
    const float4* Sg_ = (const float4*)(c.S + (size_t)(U) * 8192);                                                          \
    sraw0 = Sg_[tid]; sraw1 = Sg_[tid + 512]; sraw2 = Sg_[tid + 1024]; sraw3 = Sg_[tid + 1536];                             \
  }

DEVI void gla_out_phase(const MixCtx& c, unsigned char* smem) {
  const int tid = otid(c.wv), w = tid >> 6, lane = tid & 63, fr = lane & 15, fq = lane >> 4;
  float* segtot = (float*)smem;
  u16* qt = (u16*)(smem + 2048); u16* kt = (u16*)(smem + 11264); u16* vS = (u16*)(smem + 20480);
  u16* stT = (u16*)(smem + 37888); u16* att = (u16*)(smem + 56320); float* oS = (float*)(smem + 65536);
  const float* og = KP(gla_o_gain) + c.l * 128;
  const float* c0p = (const float*)(KWS() + O_C0);
  const int t = tid >> 3, kc = tid & 7;
  const int Gd = ogrd();
  uint4 qraw, kraw, vraw0, vraw1, rraw0, rraw1; float4 xg0, xg1, sraw0, sraw1, sraw2, sraw3;
  int unit = oblk();
  if (unit < 1024) GLA_OUT_LOAD(unit)
  for (; unit < 1024; unit += Gd) {
  const int ch = unit & 63, h = (unit >> 6) & 3, bl = unit >> 8, tok0 = ch * 64;
  const float xg[8] = {xg0.x, xg0.y, xg0.z, xg0.w, xg1.x, xg1.y, xg1.z, xg1.w};
  float cum[8];
  gla_cum8(xg, segtot, cum, tid);
  {
    float qv[8], kv[8]; unpack8(qraw, qv); unpack8(kraw, kv);
    float eq[8], ek[8];
#pragma unroll
    for (int j = 0; j < 8; ++j) { float e = __expf(cum[j]); eq[j] = qv[j] * 0.125f * e; ek[j] = kv[j] * __expf(-cum[j]); }
    uint4 o;
    o.x = pk2(eq[0], eq[1]); o.y = pk2(eq[2], eq[3]); o.z = pk2(eq[4], eq[5]); o.w = pk2(eq[6], eq[7]);
    *(uint4*)(qt + t * 72 + kc * 8) = o;
    o.x = pk2(ek[0], ek[1]); o.y = pk2(ek[2], ek[3]); o.z = pk2(ek[4], ek[5]); o.w = pk2(ek[6], ek[7]);
    *(uint4*)(kt + t * 72 + kc * 8) = o;
    *(uint4*)(vS + (tid >> 4) * 136 + (tid & 15) * 8) = vraw0;
    *(uint4*)(vS + (32 + (tid >> 4)) * 136 + (tid & 15) * 8) = vraw1;
    *(uint2*)(stT + (tid >> 4) * 72 + (tid & 15) * 4) = make_uint2(pk2(sraw0.x, sraw0.y), pk2(sraw0.z, sraw0.w));
    *(uint2*)(stT + (32 + (tid >> 4)) * 72 + (tid & 15) * 4) = make_uint2(pk2(sraw1.x, sraw1.y), pk2(sraw1.z, sraw1.w));
    *(uint2*)(stT + (64 + (tid >> 4)) * 72 + (tid & 15) * 4) = make_uint2(pk2(sraw2.x, sraw2.y), pk2(sraw2.z, sraw2.w));
    *(uint2*)(stT + (96 + (tid >> 4)) * 72 + (tid & 15) * 4) = make_uint2(pk2(sraw3.x, sraw3.y), pk2(sraw3.z, sraw3.w));
  }
  __syncthreads();
  const uint4 rc0 = rraw0, rc1 = rraw1;
  if (unit + Gd < 1024) GLA_OUT_LOAD(unit + Gd)
  {
    int it = w >> 1;
    bf16x8 af[2];
#pragma unroll
    for (int ks = 0; ks < 2; ++ks) af[ks] = *(const bf16x8*)(qt + (16 * it + fr) * 72 + ks * 32 + fq * 8);
#pragma unroll
    for (int jj = 0; jj < 2; ++jj) {
      int jt = 2 * (w & 1) + jj;
      f32x4 a = {0.f, 0.f, 0.f, 0.f};
#pragma unroll
      for (int ks = 0; ks < 2; ++ks) a = mfma16(af[ks], *(const bf16x8*)(kt + (16 * jt + fr) * 72 + ks * 32 + fq * 8), a);
#pragma unroll
      for (int j = 0; j < 4; ++j) { int tt = 16 * it + fq * 4 + j, ss = 16 * jt + fr; att[tt * 72 + ss] = f2bf(ss <= tt ? a[j] : 0.f); }
    }
  }
  __syncthreads();
  {
    int it = w >> 1;
    bf16x8 a1[2], a2[2];
#pragma unroll
    for (int ks = 0; ks < 2; ++ks) { a1[ks] = *(const bf16x8*)(att + (16 * it + fr) * 72 + ks * 32 + fq * 8); a2[ks] = *(const bf16x8*)(qt + (16 * it + fr) * 72 + ks * 32 + fq * 8); }
#pragma unroll
    for (int jj = 0; jj < 4; ++jj) {
      int jt = 4 * (w & 1) + jj;
      f32x4 a = {0.f, 0.f, 0.f, 0.f};
#pragma unroll
      for (int ks = 0; ks < 2; ++ks) {
        const u16* vb = vS + (ks * 32 + fq * 8 + (fr >> 2)) * 136 + 16 * jt + 4 * (fr & 3);
        a = mfma16(a1[ks], mk8(lds_tr16(vb), lds_tr16(vb + 4 * 136)), a);
        a = mfma16(a2[ks], *(const bf16x8*)(stT + (16 * jt + fr) * 72 + ks * 32 + fq * 8), a);
      }
#pragma unroll
      for (int j = 0; j < 4; ++j) oS[(16 * it + fq * 4 + j) * 132 + 16 * jt + fr] = a[j];
    }
  }
  __syncthreads();
  if (ch == 0) {
    const float* cp = c0p + (size_t)((bl * 4 + h) * 2) * 16 * 64;
    float qv = 0.f, kv = 0.f;
#pragma unroll
    for (int ks = 0; ks < 16; ++ks) { qv += cp[ks * 64 + lane]; kv += cp[1024 + ks * 64 + lane]; }
    float pr = qv * kv;
#pragma unroll
    for (int o = 1; o < 64; o <<= 1) pr += shfl_xor_l(pr, o, lane);
    if (tid < 128) oS[tid] = pr * 0.125f * bf2f(vS[tid]);
    __syncthreads();
  }
  {
    const float* ogp = og + kc * 16;
    float ov[16];
#pragma unroll
    for (int i = 0; i < 4; ++i) { float4 a = *(const float4*)(oS + t * 132 + kc * 16 + 4 * i); ov[4 * i] = a.x; ov[4 * i + 1] = a.y; ov[4 * i + 2] = a.z; ov[4 * i + 3] = a.w; }
    float ss = 0.f;
#pragma unroll
    for (int i = 0; i < 16; ++i) ss += ov[i] * ov[i];
    ss += shfl_xor_l(ss, 1, lane); ss += shfl_xor_l(ss, 2, lane); ss += shfl_xor_l(ss, 4, lane);
    float rs = rsqrtf(ss * (1.f / 128.f) + EPS);
    u16* op = c.br + ((size_t)bl * 4096 + tok0 + t) * BRW + 512 + h * 128 + kc * 16;
#pragma unroll
    for (int i = 0; i < 2; ++i) {
      float r[8]; unpack8(i ? rc1 : rc0, r);
      float y[8];
#pragma unroll
      for (int e = 0; e < 8; ++e) y[e] = ov[8 * i + e] * rs * ogp[8 * i + e] * r[e] * sigmoidf_(r[e]);
      uint4 o; o.x = pk2(y[0], y[1]); o.y = pk2(y[2], y[3]); o.z = pk2(y[4], y[5]); o.w = pk2(y[6], y[7]);
      *(uint4*)(op + 8 * i) = o;
    }
  }
  __syncthreads();
  }
}
#undef GLA_OUT_LOAD

DEVI void dswa_merge_phase(const MixCtx& c) {
  long gtid = (long)oblk() * 512 + otid(c.wv), gsz = (long)ogrd() * 512;
  for (long idx0 = gtid; idx0 < (long)MH * 32; idx0 += 2 * gsz) {
    float l0[2], l1[2], l2[2]; uint4 ra[2], rb[2], rd[2]; bool ok[2];
#pragma unroll
    for (int q = 0; q < 2; ++q) {
      const long idx = idx0 + q * gsz; ok[q] = idx < (long)MH * 32;
      const long ii = ok[q] ? idx : idx0;
      const long tok = ii >> 5; const int chunk = (int)(ii & 31), h = chunk >> 3, e0 = (chunk & 7) * 8;
      const float* ls = c.lse + tok * 12 + h;
      l0[q] = ls[0]; l1[q] = ls[4]; l2[q] = ls[8];
      const u16* pr = c.proj + tok * NPROJ + h * 64 + e0;
      ra[q] = *(const uint4*)(pr); rb[q] = *(const uint4*)(pr + 256); rd[q] = *(const uint4*)(pr + 512);
    }
#pragma unroll
    for (int q = 0; q < 2; ++q) {
      if (!ok[q]) continue;
      const long idx = idx0 + q * gsz;
      const long tok = idx >> 5; const int chunk = (int)(idx & 31), h = chunk >> 3, e0 = (chunk & 7) * 8;
      float m = fmaxf(l0[q], fmaxf(l1[q], l2[q]));
      float w0 = __expf(l0[q] - m), w1 = __expf(l1[q] - m), w2 = __expf(l2[q] - m), inv = 1.f / (w0 + w1 + w2);
      w0 *= inv; w1 *= inv; w2 *= inv;
      float a[8], b[8], d[8];
      unpack8(ra[q], a); unpack8(rb[q], b); unpack8(rd[q], d);
      uint4 o;
      o.x = pk2(w0 * a[0] + w1 * b[0] + w2 * d[0], w0 * a[1] + w1 * b[1] + w2 * d[1]);
      o.y = pk2(w0 * a[2] + w1 * b[2] + w2 * d[2], w0 * a[3] + w1 * b[3] + w2 * d[3]);
      o.z = pk2(w0 * a[4] + w1 * b[4] + w2 * d[4], w0 * a[5] + w1 * b[5] + w2 * d[5]);
      o.w = pk2(w0 * a[6] + w1 * b[6] + w2 * d[6], w0 * a[7] + w1 * b[7] + w2 * d[7]);
      *(uint4*)(c.br + tok * BRW + h * 64 + e0) = o;
    }
  }
}

#define XB_TMO      128
#define XB_XCNT(j)  (256  + 64 * (j))
#define XB_XSUB(j)  (1280 + 64 * (j))
#define XB_XGEN(j)  (2304 + 64 * (j))
#define XB_TOP      3328
#define XB_TOPGEN   3392
#define XCD_BAR_WORDS 3456
#define XB_SPIN_CAP (1u << 22)
#define LAS __attribute__((address_space(3)))
DEVI unsigned xb_ld(unsigned* p) { return __hip_atomic_load(p, __ATOMIC_RELAXED, __HIP_MEMORY_SCOPE_AGENT); }
DEVI unsigned xb_add(unsigned* p, unsigned v) { return __hip_atomic_fetch_add(p, v, __ATOMIC_RELAXED, __HIP_MEMORY_SCOPE_AGENT); }
DEVI unsigned xb_xcc_id() { return (unsigned)__builtin_amdgcn_s_getreg((3 << 11) | 20) & 0xFu; }
#define XB_SPIN(cond, bar) do { unsigned _sp = 0; while (cond) { __builtin_amdgcn_s_sleep(1); \
    if ((++_sp & 255u) == 0u) { if (xb_ld(&(bar)[XB_TMO])) break; if (_sp > XB_SPIN_CAP) { atomicAdd(&(bar)[XB_TMO], 1u); break; } } } } while (0)

DEVI void xb_complete(unsigned* bar, unsigned x, unsigned G, unsigned& nloc, unsigned& nx) {
  unsigned sum, cnt, mine, sp = 0u;
  for (;;) {
    sum = 0u; cnt = 0u; mine = 0u;
#pragma unroll
    for (unsigned j = 0; j < 16; ++j) { const unsigned cc = xb_ld(&bar[XB_XCNT(j)]); sum += cc; cnt += (cc > 0u) ? 1u : 0u; mine = (j == x) ? cc : mine; }
    if (sum == G) break;
    __builtin_amdgcn_s_sleep(1);
    if ((++sp & 255u) == 0u) { if (xb_ld(&bar[XB_TMO])) break; if (sp > XB_SPIN_CAP) { atomicAdd(&bar[XB_TMO], 1u); break; } }
  }
  nloc = mine > 0u ? mine : 1u; nx = cnt > 0u ? cnt : 1u;
}

DEVI void gbar1(int wv, unsigned& nbar, unsigned char* smem) {
  asm volatile("s_waitcnt vmcnt(0)" ::: "memory");
  __syncthreads();
  unsigned* bar = (unsigned*)(KWS() + O_BAR);
  const unsigned x = xb_xcc_id();
  if (otid(wv) == 0) {
    volatile LAS unsigned* st = (volatile LAS unsigned*)(smem + 131072);
    __builtin_amdgcn_s_waitcnt(0);
    unsigned nloc = st[0], nx = st[1];
    if (nloc == 0u) { xb_complete(bar, x, (unsigned)ogrd(), nloc, nx); st[0] = nloc; st[1] = nx; }
    const unsigned old = xb_add(&bar[XB_XSUB(x)], 1u);
    const unsigned gen = old / nloc;
    if (old + 1u == (gen + 1u) * nloc) {
      __builtin_amdgcn_fence(__ATOMIC_RELEASE, "agent");
      asm volatile("s_waitcnt vmcnt(0)" ::: "memory");
      const unsigned og = xb_add(&bar[XB_TOP], 1u);
      const unsigned tg = og / nx;
      if (og + 1u == (tg + 1u) * nx) xb_add(&bar[XB_TOPGEN], 1u);
      else XB_SPIN(xb_ld(&bar[XB_TOPGEN]) == tg, bar);
      __builtin_amdgcn_fence(__ATOMIC_ACQUIRE, "agent");
      xb_add(&bar[XB_XGEN(x)], 1u);
      asm volatile("s_waitcnt vmcnt(0)" ::: "memory");
    } else {
      XB_SPIN(xb_ld(&bar[XB_XGEN(x)]) == gen, bar);
      __builtin_amdgcn_fence(__ATOMIC_ACQUIRE, "agent");
      asm volatile("s_waitcnt vmcnt(0)" ::: "memory");
    }
  }
  __syncthreads();
}
DEVI void gbar(int wv, unsigned& nbar, unsigned char* smem) { PREP(7) gbar1(wv, nbar, smem); }

__global__ void __launch_bounds__(512) mega(Params p_unused) {
  extern __shared__ __attribute__((aligned(16))) unsigned char smem[];
  cg::grid_group grid = cg::this_grid();
  u16* shm = (u16*)smem;
  unsigned nbar = 0;
  const int wv = __builtin_amdgcn_readfirstlane((int)(threadIdx.x >> 6));
  {
    unsigned* bar0 = (unsigned*)(KWS() + O_BAR);
    const unsigned xcc0 = xb_xcc_id();
    if (otid(wv) == 0) {
      volatile LAS unsigned* st = (volatile LAS unsigned*)(smem + 131072);
      st[0] = 0u; st[1] = 0u;
      (void)xb_add(bar0 + XB_XCNT(xcc0), 1u);
    }
  }
  __syncthreads();

  PREP(0) prep_phase(wv, smem);
  grid.sync();
  PREP(0) modfinal_phase(wv);
  gbar(wv, nbar, smem);

  for (int l = 0; l < NL; ++l) {
    for (int hf = 0; hf < 2; ++hf) {
      const int row0 = hf * MH;
      const size_t o_h = (hf == 0) ? O_H : O_BR;
      if (hf == 0) {
        unsigned char* ws = KWS();
        const float* xin = (l == 0) ? KP(x) : (const float*)KOUT();
        PREP(1) norm_phase(wv, xin, row0, MH, (const float*)(ws + O_MODF) + (size_t)l * 8 * 6144, 0, (u16*)(ws + O_H));
        gbar(wv, nbar, smem);
      }
      {
        unsigned char* ws = KWS();
        EpiBf16 e; e.C = (u16*)(ws + O_PROJ); e.ldc = NPROJ; e.relu2 = 0;
        PREP(2) gemm_phase<1024>(wv, shm, (const u16*)(ws + o_h), (const u16*)(ws + O_WT) + (size_t)l * WT_L + WT_IN, MH, NPROJ, 1024, e);
        glow_phase(wv, l, (const u16*)(ws + o_h), (const u16*)(ws + O_WT) + (size_t)l * WT_L + WT_LOW, (float*)(ws + O_GLOW));
      }
      gbar(wv, nbar, smem);
      {
        MixCtx c = make_ctx(wv, l, hf);
        dswa_block_phase(c, smem);
        for (int it = oblk(); it < 1024 + 512; it += ogrd()) {
          if (it < 1024) gla_local_item(c, it, smem);
          else conv_item(c, it - 1024, smem);
          __syncthreads();
        }
        PREP(10) sb_wave_phase(c, smem);
        gla_tok0_partials(c);
      }
      gbar(wv, nbar, smem);
      { MixCtx c = make_ctx(wv, l, hf); gla_scan_phase(c); }
      gbar(wv, nbar, smem);
      {
        MixCtx c = make_ctx(wv, l, hf);
        PREP(4) { gla_out_phase(c, smem);
        dswa_merge_phase(c); }
      }
      gbar(wv, nbar, smem);
      {
        unsigned char* ws = KWS();
        PREP(5) branch_phase(wv, shm, (const u16*)(ws + O_BR), (const u16*)(ws + O_WT) + (size_t)l * WT_L + WT_BR, (const u16*)(ws + O_PROJ), (u16*)(ws + O_S));
      }
      gbar(wv, nbar, smem);
      {
        unsigned char* ws = KWS();
        EpiRes e; e.xin = (l == 0) ? KP(x) : (const float*)KOUT(); e.xout = KOUT(); e.gate = (const float*)(ws + O_MODF) + (size_t)l * 8 * 6144 + 2048; e.row0 = row0;
        gemm_phase<1024>(wv, shm, (const u16*)(ws + O_S), (const u16*)(ws + O_WT) + (size_t)l * WT_L + WT_OUT, MH, 1024, 1024, e);
        if (hf == 0) {
          const float* xin2 = (l == 0) ? KP(x) : (const float*)KOUT();
          norm_phase(wv, xin2, MH, MH, (const float*)(ws + O_MODF) + (size_t)l * 8 * 6144, 0, (u16*)(ws + O_BR));
        }
      }
      gbar(wv, nbar, smem);
    }
    {
      unsigned char* ws = KWS();
      PREP(1) norm_phase(wv, (const float*)KOUT(), 0, MTOK, (const float*)(ws + O_MODF) + (size_t)l * 8 * 6144, 3, (u16*)(ws + O_BR));
    }
    gbar(wv, nbar, smem);
    for (int hh = 0; hh < 2; ++hh) {
      {
        unsigned char* ws = KWS();
        EpiBf16 e; e.C = (u16*)(ws + O_PROJ) + (size_t)hh * MH * 4096; e.ldc = 4096; e.relu2 = 1;
        PREP(6) gemm_phase<1024>(wv, shm, (const u16*)(ws + O_BR) + (size_t)hh * MH * 1024, (const u16*)(ws + O_WT) + (size_t)l * WT_L + WT_UP, MH, 4096, 1024, e);
      }
      gbar(wv, nbar, smem);
      {
        unsigned char* ws = KWS();
        EpiRes e; e.xin = (const float*)KOUT(); e.xout = KOUT(); e.gate = (const float*)(ws + O_MODF) + (size_t)l * 8 * 6144 + 5120; e.row0 = hh * MH;
        gemm_phase<4096>(wv, shm, (const u16*)(ws + O_PROJ) + (size_t)hh * MH * 4096, (const u16*)(ws + O_WT) + (size_t)l * WT_L + WT_DOWN, MH, 1024, 4096, e);
      }
    }
    gbar(wv, nbar, smem);
  }
}

extern "C" void kernel_launch(void* const* d_in, const int* in_sizes, int n_in,
                              void* d_out, int out_size, void* d_ws, size_t ws_size,
                              hipStream_t stream) {
  static int grid_blocks = 0;
  if (!grid_blocks) {
    int dev = 0, cus = 0, per_cu = 0;
    (void)hipGetDevice(&dev);
    (void)hipDeviceGetAttribute(&cus, hipDeviceAttributeMultiprocessorCount, dev);
    (void)hipFuncSetAttribute((const void*)mega, hipFuncAttributeMaxDynamicSharedMemorySize, LDS_BYTES);
    (void)hipOccupancyMaxActiveBlocksPerMultiprocessor(&per_cu, (const void*)mega, 512, LDS_BYTES);
    if (per_cu < 1) per_cu = 1;
    grid_blocks = cus * 1;
    if (ws_size < WS_END) fprintf(stderr, "kernel_launch: workspace too small: %zu < %zu\n", ws_size, (size_t)WS_END);
  }
  (void)hipMemsetAsync((unsigned char*)d_ws + O_BAR, 0, 16384, stream);
  Params p{};
  const float** pp = (const float**)&p;
  for (int i = 0; i < 23; ++i) pp[i] = (const float*)d_in[i];
  p.out = (float*)d_out; p.ws = (unsigned char*)d_ws;
  void* args[] = {&p};
  hipError_t e = hipLaunchCooperativeKernel((void*)mega, dim3(grid_blocks), dim3(512), args, LDS_BYTES, stream);
  if (e != hipSuccess) fprintf(stderr, "cooperative launch failed: %s (grid %d)\n", hipGetErrorString(e), grid_blocks);
}
```

```cpp
#include <hip/hip_runtime.h>
#include <hip/hip_bf16.h>
#include <hip/hip_cooperative_groups.h>
#include <cstdio>
namespace cg = cooperative_groups;

#define DEVI __device__ __forceinline__
typedef unsigned short u16;
using bf16x8 = __attribute__((ext_vector_type(8))) short;
using bf16x4 = __attribute__((ext_vector_type(4))) short;
using f32x4 = __attribute__((ext_vector_type(4))) float;

constexpr int DM = 1024, NB = 8, SEQ = 4096, MTOK = NB * SEQ, NL = 2;
constexpr int MH = MTOK / 2;
constexpr int INW = 9232;
constexpr int NPROJ = 9216;
constexpr int OFF_AQ = 0, OFF_AK = 768, OFF_AV = 1536, OFF_CONV = 2304, OFF_CQ = 2816, OFF_CK = 3072, OFF_CV = 3328,
              OFF_CR = 3840, OFF_DQ = 4352, OFF_DK = 4608, OFF_DV = 4864, OFF_GATE = 5120;
constexpr int BRW = 1280;
constexpr float EPS = 1e-6f;

constexpr size_t WT_IN = 0, WT_BR = (size_t)NPROJ * 1024, WT_OUT = WT_BR + 1024 * 1280, WT_UP = WT_OUT + 1024 * 1024,
                 WT_DOWN = WT_UP + 4096 * 1024, WT_LOW = WT_DOWN + 1024 * 4096, WT_L = WT_LOW + 16 * 1024;
constexpr size_t O_WT = 0;
constexpr size_t O_MODP = O_WT + 2 * WT_L * 2;
constexpr size_t O_MODF = O_MODP + (size_t)2 * 16 * 8 * 6144 * 4;
constexpr size_t O_LSE = O_MODF + (size_t)2 * 8 * 6144 * 4;
constexpr size_t O_GDEC = O_LSE + (size_t)MH * 12 * 4;
constexpr size_t O_H = O_GDEC + (size_t)1024 * 64 * 4;
constexpr size_t O_PROJ = O_H + (size_t)MH * 1024 * 2;
constexpr size_t O_BR = O_PROJ + (size_t)MH * NPROJ * 2;
constexpr size_t O_S = O_BR + (size_t)MH * BRW * 2;
constexpr size_t O_BAR = O_S + (size_t)1024 * 8192 * 4;
constexpr size_t O_C0 = O_BAR + 16384;
constexpr size_t O_GLOW = O_C0 + (size_t)16 * 2 * 16 * 64 * 4;
constexpr size_t WS_END = O_GLOW + (size_t)MH * 256 * 4;

constexpr int LDS_BYTES = 131072 + 16;
#ifndef PROBE
#define PROBE 0
#endif
#define PREP(bit) for (int _rep = 0; _rep < (((PROBE) >> (bit)) & 1) + 1; ++_rep)

struct Params {
  const float *x, *c, *w_ada, *b_ada, *g_mix, *w_in, *q_gain, *k_gain, *conv_w, *conv_b, *conv_ln_g, *conv_ln_b,
      *gla_w_gate, *gla_b_gate, *gla_o_gain, *w_br_a, *w_br_b, *w_br_c, *w_br_d, *w_out, *g_mlp, *w_up, *w_down;
  float* out;
  unsigned char* ws;
};

template <int OFF> DEVI const void* kptr() {
  unsigned long long r;
  auto ka = __builtin_amdgcn_kernarg_segment_ptr();
  asm volatile("s_load_dwordx2 %0, %1, %2\n\ts_waitcnt lgkmcnt(0)" : "=s"(r) : "s"(ka), "i"(OFF) : "memory");
  return (const void*)(__attribute__((address_space(1))) const void*)r;
}
#define KP(field) ((const float*)kptr<(int)offsetof(Params, field)>())
#define KWS() ((unsigned char*)kptr<(int)offsetof(Params, ws)>())
#define KOUT() ((float*)kptr<(int)offsetof(Params, out)>())

DEVI int otid(int wv) { int z = 0; asm volatile("" : "+v"(z)); int lane = __builtin_amdgcn_mbcnt_hi(-1, __builtin_amdgcn_mbcnt_lo(-1, z)); return wv * 64 + lane; }
DEVI int oblk() { int b = blockIdx.x; asm volatile("" : "+s"(b)); return b; }
DEVI int ogrd() { int g = gridDim.x; asm volatile("" : "+s"(g)); return g; }

DEVI float shfl_l(float v, int src) { return __int_as_float(__builtin_amdgcn_ds_bpermute(src << 2, __float_as_int(v))); }
DEVI float shfl_xor_l(float v, int k, int lane) { return shfl_l(v, lane ^ k); }
DEVI float shfl_up_l(float v, int d, int lane) { return shfl_l(v, lane >= d ? lane - d : lane); }

DEVI u16 f2bf(float f) { unsigned r; asm("v_cvt_pk_bf16_f32 %0, %1, %1" : "=v"(r) : "v"(f)); return (u16)(r & 0xffffu); }
DEVI float bf2f(u16 h) { return __uint_as_float(((unsigned)h) << 16); }
DEVI unsigned pk2(float a, float b) { unsigned r; asm("v_cvt_pk_bf16_f32 %0, %1, %2" : "=v"(r) : "v"(a), "v"(b)); return r; }
DEVI unsigned pk2_sw(float a, float b) {
  unsigned ua = __float_as_uint(a), ub = __float_as_uint(b);
  ua += 0x7fffu + ((ua >> 16) & 1u); ub += 0x7fffu + ((ub >> 16) & 1u);
  return (ua >> 16) | (ub & 0xffff0000u);
}
DEVI float bflo(unsigned u) { return __uint_as_float(u << 16); }
DEVI float bfhi(unsigned u) { return __uint_as_float(u & 0xffff0000u); }
DEVI float sigmoidf_(float x) { return 1.f / (1.f + __expf(-x)); }
DEVI float logsigf_(float z) { return fminf(z, 0.f) - __logf(1.f + __expf(-fabsf(z))); }
typedef unsigned u32x4_t __attribute__((ext_vector_type(4)));
DEVI bf16x8 mk8(uint2 lo, uint2 hi) { u32x4_t v = {lo.x, lo.y, hi.x, hi.y}; return __builtin_bit_cast(bf16x8, v); }
DEVI f32x4 mfma16(bf16x8 a, bf16x8 b, f32x4 c) { return __builtin_amdgcn_mfma_f32_16x16x32_bf16(a, b, c, 0, 0, 0); }

constexpr int BM = 256, BK = 64, HALF = 128, HT = HALF * BK;

DEVI int lds_byte(int r, int c) {
  int st = (r >> 4) * 2 + (c >> 5), rr = r & 15, cc = c & 31, ob = rr * 64 + cc * 2;
  return st * 1024 + (ob ^ (((ob >> 9) & 1) << 5));
}
DEVI void stage_rc(int b, int& R, int& C) {
  int st = b / 1024, sb = b % 1024, swz = sb ^ (((sb >> 9) & 1) << 5);
  R = (st >> 1) * 16 + swz / 64; C = (st & 1) * 32 + (swz % 64) / 2;
}

#define G_SA(b, h) (shm + ((b) * 2 + (h)) * HT)
#define G_SB(b, h) (shm + (4 + (b) * 2 + (h)) * HT)
#define G_STAGE(P, BASE, LD, br, kt) do { const u16* _p = (BASE) + (size_t)(br) * (size_t)(LD) + (size_t)(kt) * BK; \
    __builtin_amdgcn_global_load_lds((const unsigned*)(_p + soff0), (unsigned*)((char*)(P) + tid * 16), 16, 0, 0); \
    __builtin_amdgcn_global_load_lds((const unsigned*)(_p + soff1), (unsigned*)((char*)(P) + tid * 16 + 8192), 16, 0, 0); } while (0)
#define G_LDA(dst, b, h) for (int m = 0; m < 4; ++m) for (int k = 0; k < 2; ++k) \
    dst[m][k] = *reinterpret_cast<const bf16x8*>((char*)G_SA(b, h) + lds_byte(wr * 64 + m * 16 + fr, k * 32 + fq * 8))
#define G_LDB(dst, b, h) for (int n = 0; n < 2; ++n) for (int k = 0; k < 2; ++k) \
    dst[n][k] = *reinterpret_cast<const bf16x8*>((char*)G_SB(b, h) + ldsb_base + n * 256 + k * 1024)
#define G_MMA(ai, bj, At, Bf) do { __builtin_amdgcn_s_setprio(1); \
    for (int m = 0; m < 4; ++m) for (int n = 0; n < 2; ++n) for (int k = 0; k < 2; ++k) \
      acc[ai][bj][m][n] = __builtin_amdgcn_mfma_f32_16x16x32_bf16(Bf[n][k], At[m][k], acc[ai][bj][m][n], 0, 0, 0); \
    __builtin_amdgcn_s_setprio(0); } while (0)
#define G_WAIT_V(n) asm volatile("s_waitcnt vmcnt(" #n ")" ::: "memory")
#define G_WAIT_L(n) asm volatile("s_waitcnt lgkmcnt(" #n ")" ::: "memory")
#define G_BAR __builtin_amdgcn_s_barrier()
#define G_SCHED __builtin_amdgcn_sched_barrier(0)

template <int LD, class Epi>
DEVI void gemm_tile(int wv, u16* shm, const u16* A, const u16* Bt, int K, int brow, int bcol, const Epi& epi,
                    bool pre, bool has_next, int nshift, int nbrow, int nbcol) {
  constexpr int lda = LD, ldb = LD;
  const u16* nA = A + nshift; const u16* nB = Bt + nshift;
  const int tid = otid(wv);
  int wid = tid >> 6, lane = tid & 63, wr = wid >> 2, wc = wid & 3, fr = lane & 15, fq = lane >> 4;
  const int ldsb_base = lds_byte(wc * 32 + 8 * (fr >> 2) + (fr & 3), fq * 8);
  f32x4 acc[2][2][4][2] = {};
  bf16x8 At[4][2], B0[2][2], B1[2][2];
  int nt = K / BK;
  unsigned soff0, soff1;
  { int _r, _c; stage_rc(tid * 16, _r, _c); soff0 = (unsigned)(_r * lda + _c); stage_rc(tid * 16 + 8192, _r, _c); soff1 = (unsigned)(_r * lda + _c); }
  if (!pre) {
    G_STAGE(G_SB(0, 0), Bt, ldb, bcol, 0); G_STAGE(G_SA(0, 0), A, lda, brow, 0);
    G_STAGE(G_SB(0, 1), Bt, ldb, bcol + HALF, 0); G_STAGE(G_SA(0, 1), A, lda, brow + HALF, 0);
  }
  if (wr == 1) G_BAR;
  if (pre) { if (Epi::NSTORE == 32) { G_WAIT_V(36); } else { G_WAIT_V(20); } } else { G_WAIT_V(4); } G_BAR;
  G_STAGE(G_SB(1, 0), Bt, ldb, bcol, 1); G_STAGE(G_SA(1, 0), A, lda, brow, 1); G_STAGE(G_SB(1, 1), Bt, ldb, bcol + HALF, 1);
  if (pre) { if (Epi::NSTORE == 32) { G_WAIT_V(38); } else { G_WAIT_V(22); } } else { G_WAIT_V(6); } G_BAR;
  for (int t = 0; t < nt - 2; t += 2) {
    G_LDB(B0, 0, 0); G_SCHED; G_LDA(At, 0, 0); G_STAGE(G_SA(1, 1), A, lda, brow + HALF, t + 1);
    G_WAIT_L(8); G_BAR; G_WAIT_L(0); G_MMA(0, 0, At, B0); G_BAR; G_SCHED;
    G_LDB(B1, 0, 1); G_STAGE(G_SB(0, 0), Bt, ldb, bcol, t + 2);
    G_BAR; G_WAIT_L(0); G_MMA(0, 1, At, B1); G_BAR;
    G_LDA(At, 0, 1); G_STAGE(G_SA(0, 0), A, lda, brow, t + 2);
    G_BAR; G_WAIT_L(0); G_MMA(1, 0, At, B0); G_BAR; G_SCHED;
    G_STAGE(G_SB(0, 1), Bt, ldb, bcol + HALF, t + 2);
    G_WAIT_V(6); G_BAR; G_MMA(1, 1, At, B1); G_BAR;
    G_LDB(B0, 1, 0); G_SCHED; G_LDA(At, 1, 0); G_STAGE(G_SA(0, 1), A, lda, brow + HALF, t + 2);
    G_WAIT_L(8); G_BAR; G_WAIT_L(0); G_MMA(0, 0, At, B0); G_BAR; G_SCHED;
    G_LDB(B1, 1, 1); G_STAGE(G_SB(1, 0), Bt, ldb, bcol, t + 3);
    G_BAR; G_WAIT_L(0); G_MMA(0, 1, At, B1); G_BAR;
    G_LDA(At, 1, 1); G_STAGE(G_SA(1, 0), A, lda, brow, t + 3);
    G_BAR; G_WAIT_L(0); G_MMA(1, 0, At, B0); G_BAR; G_SCHED;
    G_STAGE(G_SB(1, 1), Bt, ldb, bcol + HALF, t + 3);
    G_WAIT_V(6); G_BAR; G_MMA(1, 1, At, B1); G_BAR;
  }
  { G_LDB(B0, 0, 0); G_LDA(At, 0, 0); G_STAGE(G_SA(1, 1), A, lda, brow + HALF, nt - 1);
    G_BAR; G_WAIT_L(0); G_MMA(0, 0, At, B0); G_BAR;
    G_LDB(B1, 0, 1); G_BAR; G_WAIT_L(0); G_MMA(0, 1, At, B1); G_BAR;
    G_LDA(At, 0, 1); G_WAIT_V(4); G_BAR; G_WAIT_L(0); G_MMA(1, 0, At, B0); G_MMA(1, 1, At, B1); G_BAR; }
  { G_LDB(B0, 1, 0); G_LDA(At, 1, 0); G_WAIT_V(2); G_BAR;
    if (has_next) {
      G_STAGE(G_SB(0, 0), nB, ldb, nbcol, 0); G_STAGE(G_SA(0, 0), nA, lda, nbrow, 0);
      G_STAGE(G_SB(0, 1), nB, ldb, nbcol + HALF, 0); G_STAGE(G_SA(0, 1), nA, lda, nbrow + HALF, 0);
    }
    G_WAIT_L(0); G_MMA(0, 0, At, B0); G_BAR;
    G_LDB(B1, 1, 1); if (has_next) { G_WAIT_V(8); } else { G_WAIT_V(0); } G_BAR; G_WAIT_L(0); G_MMA(0, 1, At, B1); G_BAR;
    G_LDA(At, 1, 1); G_BAR; G_WAIT_L(0); G_MMA(1, 0, At, B0); G_MMA(1, 1, At, B1); G_BAR; }
  if (wr == 0) G_BAR;
  epi(acc, brow, bcol, wr, wc, fr, fq);
}

struct EpiBf16 {
  static constexpr int NSTORE = 16;
  u16* C; int ldc; int relu2;
  DEVI void operator()(const f32x4 (&acc)[2][2][4][2], int brow, int bcol, int wr, int wc, int fr, int fq) const {
#pragma unroll
    for (int ai = 0; ai < 2; ++ai)
#pragma unroll
      for (int bj = 0; bj < 2; ++bj)
#pragma unroll
        for (int m = 0; m < 4; ++m) {
          int row = brow + ai * HALF + wr * 64 + m * 16 + fr, col = bcol + bj * HALF + wc * 32 + fq * 8;
          f32x4 v0 = acc[ai][bj][m][0], v1 = acc[ai][bj][m][1];
          if (relu2) {
#pragma unroll
            for (int j = 0; j < 4; ++j) { float t0 = fmaxf(v0[j], 0.f), t1 = fmaxf(v1[j], 0.f); v0[j] = t0 * t0; v1[j] = t1 * t1; }
          }
          uint4 o; o.x = pk2(v0[0], v0[1]); o.y = pk2(v0[2], v0[3]); o.z = pk2(v1[0], v1[1]); o.w = pk2(v1[2], v1[3]);
          *(uint4*)(C + (size_t)row * ldc + col) = o;
        }
  }
};
struct EpiGate {
  const u16* G; int gcol0; u16* Mg; int first;
  DEVI void operator()(const f32x4 (&acc)[2][2][4][2], int brow, int bcol, int wr, int wc, int fr, int fq) const {
#pragma unroll
    for (int ai = 0; ai < 2; ++ai)
#pragma unroll
      for (int bj = 0; bj < 2; ++bj)
#pragma unroll
      for (int mh = 0; mh < 2; ++mh) {
        uint2 g[4][2], o[4][2];
#pragma unroll
        for (int m = 2 * mh; m < 2 * mh + 2; ++m)
#pragma unroll
          for (int n = 0; n < 2; ++n) {
            int row = brow + ai * HALF + wr * 64 + m * 16 + fr, col = bcol + bj * HALF + wc * 32 + n * 16 + fq * 4;
            g[m][n] = *(const uint2*)(G + (size_t)row * NPROJ + gcol0 + col);
            if (!first) o[m][n] = *(const uint2*)(Mg + (size_t)row * 1024 + col);
          }
#pragma unroll
        for (int m = 2 * mh; m < 2 * mh + 2; ++m)
#pragma unroll
          for (int n = 0; n < 2; ++n) {
            int row = brow + ai * HALF + wr * 64 + m * 16 + fr, col = bcol + bj * HALF + wc * 32 + n * 16 + fq * 4;
            f32x4 v = acc[ai][bj][m][n];
            float r0 = v[0] * sigmoidf_(bflo(g[m][n].x)), r1 = v[1] * sigmoidf_(bfhi(g[m][n].x)), r2 = v[2] * sigmoidf_(bflo(g[m][n].y)), r3 = v[3] * sigmoidf_(bfhi(g[m][n].y));
            if (!first) { r0 += bflo(o[m][n].x); r1 += bfhi(o[m][n].x); r2 += bflo(o[m][n].y); r3 += bfhi(o[m][n].y); }
            uint2 o2; o2.x = pk2(r0, r1); o2.y = pk2(r2, r3);
            *(uint2*)(Mg + (size_t)row * 1024 + col) = o2;
          }
      }
  }
};
struct EpiRes {
  const float* xin; float* xout; const float* gate; int row0;
  static constexpr int NSTORE = 32;
  DEVI void load_batch(int q, float4 (&xi)[2][2], int brow, int bcol, int wr, int wc, int fr, int fq) const {
    const int ai = q >> 2, bj = (q >> 1) & 1, mh = q & 1, col = bcol + bj * HALF + wc * 32 + fq * 8;
#pragma unroll
    for (int mm = 0; mm < 2; ++mm) {
      const int row = row0 + brow + ai * HALF + wr * 64 + (2 * mh + mm) * 16 + fr;
      xi[mm][0] = *(const float4*)(xin + (size_t)row * 1024 + col); xi[mm][1] = *(const float4*)(xin + (size_t)row * 1024 + col + 4);
    }
  }
  DEVI void operator()(const f32x4 (&acc)[2][2][4][2], int brow, int bcol, int wr, int wc, int fr, int fq) const {
    const int b = (row0 + brow) >> 12;
    float4 gt[2][2];
#pragma unroll
    for (int bj = 0; bj < 2; ++bj) {
      const int col = bcol + bj * HALF + wc * 32 + fq * 8;
      gt[bj][0] = *(const float4*)(gate + (size_t)b * 6144 + col); gt[bj][1] = *(const float4*)(gate + (size_t)b * 6144 + col + 4);
    }
    float4 xa[2][2], xb[2][2];
    load_batch(0, xa, brow, bcol, wr, wc, fr, fq);
#pragma unroll
    for (int q = 0; q < 8; ++q) {
      const int ai = q >> 2, bj = (q >> 1) & 1, mh = q & 1, col = bcol + bj * HALF + wc * 32 + fq * 8;
      if (q + 1 < 8) { if (q & 1) load_batch(q + 1, xa, brow, bcol, wr, wc, fr, fq); else load_batch(q + 1, xb, brow, bcol, wr, wc, fr, fq); }
#pragma unroll
      for (int mm = 0; mm < 2; ++mm) {
        const int row = row0 + brow + ai * HALF + wr * 64 + (2 * mh + mm) * 16 + fr;
#pragma unroll
        for (int n = 0; n < 2; ++n) {
          const f32x4 v = acc[ai][bj][2 * mh + mm][n];
          const float4 xv = (q & 1) ? xb[mm][n] : xa[mm][n];
          float4 o; o.x = xv.x + gt[bj][n].x * v[0]; o.y = xv.y + gt[bj][n].y * v[1]; o.z = xv.z + gt[bj][n].z * v[2]; o.w = xv.w + gt[bj][n].w * v[3];
          *(float4*)(xout + (size_t)row * 1024 + col + 4 * n) = o;
        }
      }
    }
  }
};

template <int LD, class Epi>
DEVI void gemm_phase(int wv, u16* shm, const u16* A, const u16* Bt, int Mrows, int N, int K, const Epi& epi) {
  int nM = Mrows / BM, nN = N / BM, ntiles = nM * nN;
  int G = ogrd(), b = oblk();
  int vb = (G % 8 == 0) ? (b % 8) * (G / 8) + b / 8 : b;
  const int nig = 8 * nN;
  bool pre = false;
  for (int base = 0; base < ntiles; base += G) {
    int id = base + vb;
    if (id >= ntiles) break;
    int gid = id / nig, rem = id % nig, pm = gid * 8 + rem % 8, pn = rem / 8;
    int nid = id + G; bool has_next = nid < ntiles;
    int ngid = nid / nig, nrem = nid % nig, npm = ngid * 8 + nrem % 8, npn = nrem / 8;
    gemm_tile<LD>(wv, shm, A, Bt, K, pm * BM, pn * BM, epi, pre, has_next, 0, npm * BM, npn * BM);
    pre = has_next;
    if (has_next) { G_BAR; } else { __syncthreads(); }
  }
}

#define BR_LDB(dst, b, h) for (int n = 0; n < 2; ++n) for (int k = 0; k < 2; ++k) \
    dst[n][k] = *reinterpret_cast<const bf16x8*>((char*)G_SB(b, h) + ldsb_base + n * 256 + k * 1024)
DEVI void branch_phase(int wv, u16* shm, const u16* br, const u16* WbrT, const u16* G, u16* Mg) {
  const int tid = otid(wv);
  const int wid = tid >> 6, lane = tid & 63, wr = wid >> 2, wc = wid & 3, fr = lane & 15, fq = lane >> 4;
  constexpr int lda = BRW, ldb = BRW;
  unsigned soff0, soff1;
  { int _r, _c; stage_rc(tid * 16, _r, _c); soff0 = (unsigned)(_r * BRW + _c); stage_rc(tid * 16 + 8192, _r, _c); soff1 = (unsigned)(_r * BRW + _c); }
  const unsigned goff = (unsigned)((wr * 64 + fr) * NPROJ + wc * 32 + fq * 8), moff = (unsigned)((wr * 64 + fr) * 1024 + wc * 32 + fq * 8);
  const int ldsb_base = lds_byte(wc * 32 + 8 * (fr >> 2) + (fr & 3), fq * 8);
  const int Gd = ogrd();
  for (int tile = oblk(); tile < (MH / 128) * 4; tile += Gd) {
    const int pm = tile >> 2, pn = tile & 3, brow = pm * 128, bcol = pn * 256;
    f32x4 mg[2][4][2];
#pragma unroll
    for (int bj = 0; bj < 2; ++bj)
#pragma unroll
      for (int m = 0; m < 4; ++m)
#pragma unroll
        for (int n = 0; n < 2; ++n) mg[bj][m][n] = (f32x4){0.f, 0.f, 0.f, 0.f};
    for (int i = 0; i < 4; ++i) {
      const int koff = (i == 3) ? 1024 : i * 256, nt = (i == 2) ? 8 : 4;
      const u16* A = br + koff; const u16* Bt = WbrT + koff;
      f32x4 acc[2][4][2];
#pragma unroll
      for (int bj = 0; bj < 2; ++bj)
#pragma unroll
        for (int m = 0; m < 4; ++m)
#pragma unroll
          for (int n = 0; n < 2; ++n) acc[bj][m][n] = (f32x4){0.f, 0.f, 0.f, 0.f};
      G_STAGE(G_SA(0, 0), A, lda, brow, 0); G_STAGE(G_SB(0, 0), Bt, ldb, bcol, 0); G_STAGE(G_SB(0, 1), Bt, ldb, bcol + HALF, 0);
      for (int kt = 0; kt < nt; ++kt) {
        const int b = kt & 1;
        if (kt + 1 < nt) {
          if (b) { G_STAGE(G_SA(0, 0), A, lda, brow, kt + 1); G_STAGE(G_SB(0, 0), Bt, ldb, bcol, kt + 1); G_STAGE(G_SB(0, 1), Bt, ldb, bcol + HALF, kt + 1); }
          else   { G_STAGE(G_SA(1, 0), A, lda, brow, kt + 1); G_STAGE(G_SB(1, 0), Bt, ldb, bcol, kt + 1); G_STAGE(G_SB(1, 1), Bt, ldb, bcol + HALF, kt + 1); }
          G_WAIT_V(6);
        } else { G_WAIT_V(0); }
        G_BAR;
        bf16x8 At[4][2], B0[2][2];
        if (b) { G_LDA(At, 1, 0); BR_LDB(B0, 1, 0); } else { G_LDA(At, 0, 0); BR_LDB(B0, 0, 0); }
        G_WAIT_L(0);
        __builtin_amdgcn_s_setprio(1);
#pragma unroll
        for (int m = 0; m < 4; ++m)
#pragma unroll
          for (int n = 0; n < 2; ++n)
#pragma unroll
            for (int k = 0; k < 2; ++k) acc[0][m][n] = __builtin_amdgcn_mfma_f32_16x16x32_bf16(B0[n][k], At[m][k], acc[0][m][n], 0, 0, 0);
        __builtin_amdgcn_s_setprio(0);
        if (b) { BR_LDB(B0, 1, 1); } else { BR_LDB(B0, 0, 1); }
        G_WAIT_L(0);
        __builtin_amdgcn_s_setprio(1);
#pragma unroll
        for (int m = 0; m < 4; ++m)
#pragma unroll
          for (int n = 0; n < 2; ++n)
#pragma unroll
            for (int k = 0; k < 2; ++k) acc[1][m][n] = __builtin_amdgcn_mfma_f32_16x16x32_bf16(B0[n][k], At[m][k], acc[1][m][n], 0, 0, 0);
        __builtin_amdgcn_s_setprio(0);
        G_BAR;
      }
#pragma unroll
      for (int bj = 0; bj < 2; ++bj) {
        uint4 g[4];
#pragma unroll
        for (int m = 0; m < 4; ++m) {
          const u16* gp = G + (size_t)(brow + m * 16) * NPROJ + OFF_GATE + i * 1024 + bcol + bj * HALF;
          g[m] = *(const uint4*)(gp + goff);
        }
#pragma unroll
        for (int m = 0; m < 4; ++m) {
          const uint4 gv = g[m];
          mg[bj][m][0][0] += acc[bj][m][0][0] * sigmoidf_(bflo(gv.x)); mg[bj][m][0][1] += acc[bj][m][0][1] * sigmoidf_(bfhi(gv.x));
          mg[bj][m][0][2] += acc[bj][m][0][2] * sigmoidf_(bflo(gv.y)); mg[bj][m][0][3] += acc[bj][m][0][3] * sigmoidf_(bfhi(gv.y));
          mg[bj][m][1][0] += acc[bj][m][1][0] * sigmoidf_(bflo(gv.z)); mg[bj][m][1][1] += acc[bj][m][1][1] * sigmoidf_(bfhi(gv.z));
          mg[bj][m][1][2] += acc[bj][m][1][2] * sigmoidf_(bflo(gv.w)); mg[bj][m][1][3] += acc[bj][m][1][3] * sigmoidf_(bfhi(gv.w));
        }
      }
    }
#pragma unroll
    for (int bj = 0; bj < 2; ++bj)
#pragma unroll
      for (int m = 0; m < 4; ++m) {
        u16* mp = Mg + (size_t)(brow + m * 16) * 1024 + bcol + bj * HALF;
        uint4 o; o.x = pk2(mg[bj][m][0][0], mg[bj][m][0][1]); o.y = pk2(mg[bj][m][0][2], mg[bj][m][0][3]);
        o.z = pk2(mg[bj][m][1][0], mg[bj][m][1][1]); o.w = pk2(mg[bj][m][1][2], mg[bj][m][1][3]);
        *(uint4*)(mp + moff) = o;
      }
  }
}
#undef BR_LDB

DEVI void transpose_tile(int wv, const float* src, int lds_, int col0, int k0, u16* dst, int ldd, int drow0, int dk0, float* sm) {
  const int t = otid(wv);
  {
    const int k = t >> 4, n4 = (t & 15) * 4;
    float4 a = *(const float4*)(src + (size_t)(k0 + k) * lds_ + col0 + n4);
    float4 b = *(const float4*)(src + (size_t)(k0 + 32 + k) * lds_ + col0 + n4);
    float* p = sm + k * 65 + n4; p[0] = a.x; p[1] = a.y; p[2] = a.z; p[3] = a.w;
    p += 32 * 65; p[0] = b.x; p[1] = b.y; p[2] = b.z; p[3] = b.w;
  }
  __syncthreads();
  {
    const int n = t >> 3, kc = (t & 7) * 8;
    const float* p = sm + kc * 65 + n;
    uint4 o; o.x = pk2(p[0], p[65]); o.y = pk2(p[2 * 65], p[3 * 65]); o.z = pk2(p[4 * 65], p[5 * 65]); o.w = pk2(p[6 * 65], p[7 * 65]);
    *(uint4*)(dst + (size_t)(drow0 + n) * ldd + dk0 + kc) = o;
  }
  __syncthreads();
}

DEVI void prep_phase(int wv, unsigned char* smem) {
  float* sm = (float*)smem;
  u16* WT = (u16*)(KWS() + O_WT);
  constexpr int T1 = 16 * 68, T2 = 16 * 76, T3 = 64, T4 = 64, T5 = 128, T6 = 64, T7 = 256, T8 = 1024, T9 = 1024;
  constexpr int TL = T1 + T2 + T3 + T4 + T5 + T6 + T7 + T8 + T9;
  for (int it = oblk(); it < 2 * TL; it += ogrd()) {
    int l = it / TL, r = it % TL;
    u16* W = WT + (size_t)l * WT_L;
    if (r < T1) { int kt = r / 68, nt = r % 68; transpose_tile(wv, KP(w_in) + (size_t)l * 1024 * INW, INW, nt * 64, kt * 64, W + WT_IN, 1024, nt * 64, kt * 64, sm); continue; } r -= T1;
    if (r < T2) { int kt = r / 76, nt = r % 76; transpose_tile(wv, KP(w_in) + (size_t)l * 1024 * INW, INW, 4368 + nt * 64, kt * 64, W + WT_IN, 1024, 4352 + nt * 64, kt * 64, sm); continue; } r -= T2;
    if (r < T3) { int kt = r / 16, nt = r % 16; transpose_tile(wv, KP(w_br_a) + (size_t)l * 256 * 1024, 1024, nt * 64, kt * 64, W + WT_BR, BRW, nt * 64, 0 + kt * 64, sm); continue; } r -= T3;
    if (r < T4) { int kt = r / 16, nt = r % 16; transpose_tile(wv, KP(w_br_b) + (size_t)l * 256 * 1024, 1024, nt * 64, kt * 64, W + WT_BR, BRW, nt * 64, 256 + kt * 64, sm); continue; } r -= T4;
    if (r < T5) { int kt = r / 16, nt = r % 16; transpose_tile(wv, KP(w_br_c) + (size_t)l * 512 * 1024, 1024, nt * 64, kt * 64, W + WT_BR, BRW, nt * 64, 512 + kt * 64, sm); continue; } r -= T5;
    if (r < T6) { int kt = r / 16, nt = r % 16; transpose_tile(wv, KP(w_br_d) + (size_t)l * 256 * 1024, 1024, nt * 64, kt * 64, W + WT_BR, BRW, nt * 64, 1024 + kt * 64, sm); continue; } r -= T6;
    if (r < T7) { int kt = r / 16, nt = r % 16; transpose_tile(wv, KP(w_out) + (size_t)l * 1024 * 1024, 1024, nt * 64, kt * 64, W + WT_OUT, 1024, nt * 64, kt * 64, sm); continue; } r -= T7;
    if (r < T8) { int kt = r / 64, nt = r % 64; transpose_tile(wv, KP(w_up) + (size_t)l * 1024 * 4096, 4096, nt * 64, kt * 64, W + WT_UP, 1024, nt * 64, kt * 64, sm); continue; } r -= T8;
    { int kt = r / 16, nt = r % 16; transpose_tile(wv, KP(w_down) + (size_t)l * 4096 * 1024, 1024, nt * 64, kt * 64, W + WT_DOWN, 4096, nt * 64, kt * 64, sm); }
  }
  long gtid = (long)oblk() * 512 + otid(wv), gsz = (long)ogrd() * 512;
  for (long idx = gtid; idx < 2L * 16 * 1024; idx += gsz) {
    int l = (int)(idx >> 14), r = (int)((idx >> 10) & 15), k = (int)(idx & 1023);
    WT[(size_t)l * WT_L + WT_LOW + (size_t)r * 1024 + k] = f2bf(KP(w_in)[(size_t)l * 1024 * INW + (size_t)k * INW + 4352 + r]);
  }
  float* modp = (float*)(KWS() + O_MODP);
  const float* cvec = KP(c);
  for (int it = oblk(); it < 2 * 16 * 12; it += ogrd()) {
    int l = it / 192, kp = (it / 12) % 16, cgp = it % 12;
    int j = cgp * 512 + otid(wv);
    float a[8];
#pragma unroll
    for (int b = 0; b < 8; ++b) a[b] = 0.f;
    const float* w = KP(w_ada) + (size_t)l * 1024 * 6144 + (size_t)(kp * 64) * 6144 + j;
    for (int k = 0; k < 64; ++k) {
      float wv = w[(size_t)k * 6144];
#pragma unroll
      for (int b = 0; b < 8; ++b) a[b] += cvec[b * 1024 + kp * 64 + k] * wv;
    }
#pragma unroll
    for (int b = 0; b < 8; ++b) modp[(((size_t)l * 16 + kp) * 8 + b) * 6144 + j] = a[b];
  }
}

DEVI void modfinal_phase(int wv) {
  long gtid = (long)oblk() * 512 + otid(wv), gsz = (long)ogrd() * 512;
  unsigned char* ws_ = KWS();
  const float* modp = (const float*)(ws_ + O_MODP);
  float* modf = (float*)(ws_ + O_MODF);
  for (long idx = gtid; idx < 2L * 8 * 1024; idx += gsz) {
    int l = (int)(idx >> 13), b = (int)((idx >> 10) & 7), col = (int)(idx & 1023);
    float v[6];
#pragma unroll
    for (int s = 0; s < 6; ++s) {
      float a = KP(b_ada)[l * 6144 + s * 1024 + col];
      for (int kp = 0; kp < 16; ++kp) a += modp[(((size_t)l * 16 + kp) * 8 + b) * 6144 + s * 1024 + col];
      v[s] = a;
    }
    float* o = modf + ((size_t)l * 8 + b) * 6144 + col;
    o[0] = KP(g_mix)[l * 1024 + col] * (1.f + v[1]); o[1024] = v[0]; o[2048] = v[2];
    o[3072] = KP(g_mlp)[l * 1024 + col] * (1.f + v[4]); o[4096] = v[3]; o[5120] = v[5];
  }
}

DEVI void norm_phase(int wv, const float* xsrc, int row0, int nrows, const float* modl  , int slot, u16* hout) {
  const int tid = otid(wv); int wave = tid >> 6, lane = tid & 63;
  int gw = oblk() * 8 + wave, NGW = ogrd() * 8;
  for (int r0 = gw * 8; r0 < nrows; r0 += NGW * 8) {
    float4 v[8][4];
#pragma unroll
    for (int q = 0; q < 8; ++q) {
      const float4* xr = (const float4*)(xsrc + (size_t)(row0 + r0 + q) * 1024);
#pragma unroll
      for (int j = 0; j < 4; ++j) v[q][j] = xr[lane + 64 * j];
    }
    const int b = (row0 + r0) >> 12;
    const float4* sc = (const float4*)(modl + (size_t)b * 6144 + slot * 1024);
    const float4* sh = (const float4*)(modl + (size_t)b * 6144 + (slot + 1) * 1024);
    float4 s4[4], h4[4];
#pragma unroll
    for (int j = 0; j < 4; ++j) { s4[j] = sc[lane + 64 * j]; h4[j] = sh[lane + 64 * j]; }
#pragma unroll
    for (int q = 0; q < 8; ++q) {
      float ss = 0.f;
#pragma unroll
      for (int j = 0; j < 4; ++j) ss += v[q][j].x * v[q][j].x + v[q][j].y * v[q][j].y + v[q][j].z * v[q][j].z + v[q][j].w * v[q][j].w;
#pragma unroll
      for (int o = 1; o < 64; o <<= 1) ss += shfl_xor_l(ss, o, lane);
      const float rs = rsqrtf(ss * (1.f / 1024.f) + EPS);
      uint2* o2 = (uint2*)(hout + (size_t)(r0 + q) * 1024);
#pragma unroll
      for (int j = 0; j < 4; ++j) {
        uint2 o; o.x = pk2(v[q][j].x * rs * s4[j].x + h4[j].x, v[q][j].y * rs * s4[j].y + h4[j].y);
        o.y = pk2(v[q][j].z * rs * s4[j].z + h4[j].z, v[q][j].w * rs * s4[j].w + h4[j].w);
        o2[lane + 64 * j] = o;
      }
    }
  }
}

DEVI void glow_phase(int wv, int l, const u16* hbuf, const u16* WlowT, float* xgout) {
  const int tid = otid(wv), w = tid >> 6, lane = tid & 63, fr = lane & 15, fq = lane >> 4;
  const float* wg = KP(gla_w_gate) + (size_t)l * 16 * 256; const float* bg = KP(gla_b_gate) + l * 256;
  for (int u = oblk() * 8 + w; u < MH / 16; u += ogrd() * 8) {
    const u16* ap = WlowT + (size_t)fr * 1024 + fq * 8;
    const u16* bp = hbuf + (size_t)(u * 16 + fr) * 1024 + fq * 8;
    f32x4 acc = {0.f, 0.f, 0.f, 0.f};
#pragma unroll 8
    for (int ks = 0; ks < 32; ++ks) acc = mfma16(*(const bf16x8*)(ap + ks * 32), *(const bf16x8*)(bp + ks * 32), acc);
    u32x4_t pbu = {pk2_sw(acc[0], acc[1]), pk2_sw(acc[2], acc[3]), 0u, 0u};
    const bf16x8 pb = __builtin_bit_cast(bf16x8, pbu);
    float* orow = xgout + (size_t)(u * 16 + fr) * 256 + fq * 4;
#pragma unroll
    for (int nt = 0; nt < 16; ++nt) {
      const float* wp = wg + (size_t)(fq * 4) * 256 + nt * 16 + fr;
      u32x4_t pau = {pk2_sw(wp[0], wp[256]), pk2_sw(wp[512], wp[768]), 0u, 0u};
      f32x4 d = mfma16(__builtin_bit_cast(bf16x8, pau), pb, (f32x4){0.f, 0.f, 0.f, 0.f});
      const float4 bb = *(const float4*)(bg + nt * 16 + fq * 4);
      *(float4*)(orow + nt * 16) = make_float4(d[0] + bb.x, d[1] + bb.y, d[2] + bb.z, d[3] + bb.w);
    }
  }
}

struct MixCtx { int wv; int l; int hf; u16* proj; u16* br; float* lse; float* S; float* gdec; float* glow; };
DEVI MixCtx make_ctx(int wv, int l, int hf) { unsigned char* ws = KWS(); MixCtx c; c.wv = wv; c.l = l; c.hf = hf; c.proj = (u16*)(ws + O_PROJ); c.br = (u16*)(ws + O_BR); c.lse = (float*)(ws + O_LSE); c.S = (float*)(ws + O_S); c.gdec = (float*)(ws + O_GDEC); c.glow = (float*)(ws + O_GLOW); return c; }

DEVI void unpack8(uint4 r, float (&v)[8]) {
  v[0] = bflo(r.x); v[1] = bfhi(r.x); v[2] = bflo(r.y); v[3] = bfhi(r.y); v[4] = bflo(r.z); v[5] = bfhi(r.z); v[6] = bflo(r.w); v[7] = bfhi(r.w);
}

DEVI void dswa_item(const MixCtx& c, int item, unsigned char* smem, bool do_store = true, bool stage_only = false) {
  const int tid = otid(c.wv), w = tid >> 6, lane = tid & 63, fr = lane & 15, fq = lane >> 4;
  int blk = item & 31, h = (item >> 5) & 3, gb = item >> 7, g = gb % 3, bl = gb / 3;
  int d = (g == 0) ? 1 : (g == 1 ? 4 : 16), nbr = 32 / d, r = blk / nbr, nbi = blk % nbr;
  u16* Qs = (u16*)smem; u16* Ks = Qs + 128 * 72; u16* VT = Ks + 256 * 72;
  u16* pj = c.proj + (size_t)bl * 4096 * NPROJ;
  const float* qg = KP(q_gain) + c.l * 64; const float* kg = KP(k_gain) + c.l * 64;
#pragma unroll
  for (int i = 0; i < 2; ++i) {
    int ci = tid + 512 * i, row = ci >> 3, ch = ci & 7, tok = (nbi * 128 + row) * d + r;
    uint4 raw = *(const uint4*)(pj + (size_t)tok * NPROJ + OFF_AQ + g * 256 + h * 64 + ch * 8);
    float v[8]; unpack8(raw, v);
    float ss = 0.f;
#pragma unroll
    for (int j = 0; j < 8; ++j) ss += v[j] * v[j];
    ss += shfl_xor_l(ss, 1, lane); ss += shfl_xor_l(ss, 2, lane); ss += shfl_xor_l(ss, 4, lane);
    float sc = rsqrtf(ss * (1.f / 64.f) + EPS);
    uint4 o; o.x = pk2(v[0] * sc * qg[ch * 8 + 0], v[1] * sc * qg[ch * 8 + 1]); o.y = pk2(v[2] * sc * qg[ch * 8 + 2], v[3] * sc * qg[ch * 8 + 3]);
    o.z = pk2(v[4] * sc * qg[ch * 8 + 4], v[5] * sc * qg[ch * 8 + 5]); o.w = pk2(v[6] * sc * qg[ch * 8 + 6], v[7] * sc * qg[ch * 8 + 7]);
    *(uint4*)(Qs + row * 72 + ch * 8) = o;
  }
#pragma unroll
  for (int i = 0; i < 4; ++i) {
    int ci = tid + 512 * i, row = ci >> 3, ch = ci & 7, sub = (nbi - 1) * 128 + row;
    bool ok = sub >= 0; int tok = ok ? sub * d + r : 0;
    uint4 raw = *(const uint4*)(pj + (size_t)tok * NPROJ + OFF_AK + g * 256 + h * 64 + ch * 8);
    uint4 rv = *(const uint4*)(pj + (size_t)tok * NPROJ + OFF_AV + g * 256 + h * 64 + ch * 8);
    if (!ok) { raw = make_uint4(0, 0, 0, 0); rv = raw; }
    float v[8]; unpack8(raw, v);
    float ss = 0.f;
#pragma unroll
    for (int j = 0; j < 8; ++j) ss += v[j] * v[j];
    ss += shfl_xor_l(ss, 1, lane); ss += shfl_xor_l(ss, 2, lane); ss += shfl_xor_l(ss, 4, lane);
    float sc = rsqrtf(ss * (1.f / 64.f) + EPS);
    uint4 o; o.x = pk2(v[0] * sc * kg[ch * 8 + 0], v[1] * sc * kg[ch * 8 + 1]); o.y = pk2(v[2] * sc * kg[ch * 8 + 2], v[3] * sc * kg[ch * 8 + 3]);
    o.z = pk2(v[4] * sc * kg[ch * 8 + 4], v[5] * sc * kg[ch * 8 + 5]); o.w = pk2(v[6] * sc * kg[ch * 8 + 6], v[7] * sc * kg[ch * 8 + 7]);
    *(uint4*)(Ks + row * 72 + ch * 8) = o;
    u16* vt = VT + (ch * 8) * 264 + row;
    vt[0 * 264] = (u16)(rv.x & 0xffff); vt[1 * 264] = (u16)(rv.x >> 16); vt[2 * 264] = (u16)(rv.y & 0xffff); vt[3 * 264] = (u16)(rv.y >> 16);
    vt[4 * 264] = (u16)(rv.z & 0xffff); vt[5 * 264] = (u16)(rv.z >> 16); vt[6 * 264] = (u16)(rv.w & 0xffff); vt[7 * 264] = (u16)(rv.w >> 16);
  }
  __syncthreads();
  if (stage_only) return;
  bf16x8 qf[2];
#pragma unroll
  for (int ks = 0; ks < 2; ++ks) qf[ks] = *(const bf16x8*)(Qs + (16 * w + fr) * 72 + ks * 32 + fq * 8);
  const int pair0 = w >> 1;
  f32x4 st[5][2];
#pragma unroll
  for (int s5 = 0; s5 < 5; ++s5)
#pragma unroll
    for (int sub = 0; sub < 2; ++sub) {
      f32x4 a = {0.f, 0.f, 0.f, 0.f};
      int kb = 32 * (pair0 + s5) + 16 * sub;
#pragma unroll
      for (int ks = 0; ks < 2; ++ks) a = mfma16(*(const bf16x8*)(Ks + (kb + fr) * 72 + ks * 32 + fq * 8), qf[ks], a);
      st[s5][sub] = a;
    }
  const float slope_d = exp2f(-8.f * (float)(g * 4 + h + 1) / 12.f) * (float)d;
  const int qi = 16 * w + fr;
  float mx = -3.0e38f;
#pragma unroll
  for (int s5 = 0; s5 < 5; ++s5)
#pragma unroll
    for (int sub = 0; sub < 2; ++sub)
#pragma unroll
      for (int j = 0; j < 4; ++j) {
        int kb = 32 * (pair0 + s5) + 16 * sub + 4 * fq + j, rel = 128 + qi - kb;
        bool ok = (rel >= 0) && (rel <= 128) && (nbi > 0 || kb >= 128);
        float s = st[s5][sub][j] * 0.125f - slope_d * (float)rel;
        s = ok ? s : -3.0e38f;
        st[s5][sub][j] = s; mx = fmaxf(mx, s);
      }
  mx = fmaxf(mx, shfl_xor_l(mx, 16, lane)); mx = fmaxf(mx, shfl_xor_l(mx, 32, lane));
  float den = 0.f;
#pragma unroll
  for (int s5 = 0; s5 < 5; ++s5)
#pragma unroll
    for (int sub = 0; sub < 2; ++sub)
#pragma unroll
      for (int j = 0; j < 4; ++j) {
        float s = st[s5][sub][j];
        float pv = (s > -1.0e38f) ? __expf(s - mx) : 0.f;
        st[s5][sub][j] = pv; den += pv;
      }
  den += shfl_xor_l(den, 16, lane); den += shfl_xor_l(den, 32, lane);
  f32x4 ot[4];
#pragma unroll
  for (int et = 0; et < 4; ++et) ot[et] = (f32x4){0.f, 0.f, 0.f, 0.f};
#pragma unroll
  for (int s5 = 0; s5 < 5; ++s5) {
    union { bf16x8 v; unsigned u[4]; } pb;
    pb.u[0] = pk2_sw(st[s5][0][0], st[s5][0][1]); pb.u[1] = pk2_sw(st[s5][0][2], st[s5][0][3]);
    pb.u[2] = pk2_sw(st[s5][1][0], st[s5][1][1]); pb.u[3] = pk2_sw(st[s5][1][2], st[s5][1][3]);
    int kb0 = 32 * (pair0 + s5);
#pragma unroll
    for (int et = 0; et < 4; ++et) {
      union { bf16x8 v; uint2 h[2]; } av;
      av.h[0] = *(const uint2*)(VT + (et * 16 + fr) * 264 + kb0 + fq * 4);
      av.h[1] = *(const uint2*)(VT + (et * 16 + fr) * 264 + kb0 + 16 + fq * 4);
      ot[et] = mfma16(av.v, pb.v, ot[et]);
    }
  }
  float inv = 1.f / den;
  int tokq = (nbi * 128 + qi) * d + r;
  if (!do_store) { if (inv == 123.456f) c.lse[0] = ot[0][0] + ot[1][1] + ot[2][2] + ot[3][3]; return; }
#pragma unroll
  for (int et = 0; et < 4; ++et) {
    uint2 o; o.x = pk2(ot[et][0] * inv, ot[et][1] * inv); o.y = pk2(ot[et][2] * inv, ot[et][3] * inv);
    *(uint2*)(pj + (size_t)tokq * NPROJ + OFF_AQ + g * 256 + h * 64 + et * 16 + fq * 4) = o;
  }
  if (fq == 0) c.lse[((size_t)bl * 4096 + tokq) * 12 + g * 4 + h] = mx + __logf(den);
}

typedef short v4i16_t __attribute__((ext_vector_type(4)));
DEVI uint2 lds_tr16(const u16* p) {
  return __builtin_bit_cast(uint2, __builtin_amdgcn_ds_read_tr16_b64_v4i16((__attribute__((address_space(3))) v4i16_t*)p));
}


DEVI void sb_wave_phase(const MixCtx& c, unsigned char* smem) {
  const int tid = otid(c.wv), w = tid >> 6, lane = tid & 63, fr = lane & 15, fq = lane >> 4;
  u16* Vs = (u16*)smem + w * (32 * 72);
  for (int wi = oblk() * 8 + w; wi < 4096; wi += ogrd() * 8) {
    const int qg = 255 - (wi & 255), h = (wi >> 8) & 3, bl = wi >> 10;
    const u16* pj = c.proj + (size_t)bl * 4096 * NPROJ;
    const int t0 = qg * 16, t = t0 + fr;
    bf16x8 qf[2];
#pragma unroll
    for (int ks = 0; ks < 2; ++ks) qf[ks] = *(const bf16x8*)(pj + (size_t)t * NPROJ + OFF_DQ + h * 64 + ks * 32 + fq * 8);
    float carry = 0.f;
    f32x4 ot[4];
#pragma unroll
    for (int et = 0; et < 4; ++et) ot[et] = (f32x4){0.f, 0.f, 0.f, 0.f};
    const int s0 = (t0 + 14) >> 5;
    bf16x8 kn00, kn01, kn10, kn11; uint4 vn0, vn1, vn2, vn3;
    {
      const u16* kp = pj + (size_t)(s0 * 32 + fr) * NPROJ + OFF_DK + h * 64 + fq * 8;
      kn00 = *(const bf16x8*)(kp); kn01 = *(const bf16x8*)(kp + 32);
      kn10 = *(const bf16x8*)(kp + (size_t)16 * NPROJ); kn11 = *(const bf16x8*)(kp + (size_t)16 * NPROJ + 32);
      const u16* vp = pj + (size_t)(s0 * 32 + (lane >> 1)) * NPROJ + OFF_DV + h * 64 + (lane & 1) * 32;
      vn0 = *(const uint4*)(vp); vn1 = *(const uint4*)(vp + 8); vn2 = *(const uint4*)(vp + 16); vn3 = *(const uint4*)(vp + 24);
    }
    for (int step = s0; step >= 0; --step) {
      const bf16x8 kf00 = kn00, kf01 = kn01, kf10 = kn10, kf11 = kn11;
      {
        u16* vd = Vs + (lane >> 1) * 72 + (lane & 1) * 32;
        *(uint4*)(vd) = vn0; *(uint4*)(vd + 8) = vn1; *(uint4*)(vd + 16) = vn2; *(uint4*)(vd + 24) = vn3;
      }
      if (step > 0) {
        const u16* kp = pj + (size_t)((step - 1) * 32 + fr) * NPROJ + OFF_DK + h * 64 + fq * 8;
        kn00 = *(const bf16x8*)(kp); kn01 = *(const bf16x8*)(kp + 32);
        kn10 = *(const bf16x8*)(kp + (size_t)16 * NPROJ); kn11 = *(const bf16x8*)(kp + (size_t)16 * NPROJ + 32);
        const u16* vp = pj + (size_t)((step - 1) * 32 + (lane >> 1)) * NPROJ + OFF_DV + h * 64 + (lane & 1) * 32;
        vn0 = *(const uint4*)(vp); vn1 = *(const uint4*)(vp + 8); vn2 = *(const uint4*)(vp + 16); vn3 = *(const uint4*)(vp + 24);
      }
      f32x4 z[2];
      z[0] = mfma16(kf01, qf[1], mfma16(kf00, qf[0], (f32x4){0.f, 0.f, 0.f, 0.f}));
      z[1] = mfma16(kf11, qf[1], mfma16(kf10, qf[0], (f32x4){0.f, 0.f, 0.f, 0.f}));
      float ls[2][4], lk[2][4], L[2];
#pragma unroll
      for (int sub = 0; sub < 2; ++sub) {
        L[sub] = 0.f;
#pragma unroll
        for (int j = 0; j < 4; ++j) {
          int key = step * 32 + 16 * sub + 4 * fq + j;
          float zz = z[sub][j] * (0.125f * 1.44269504f);
          float l_ = fminf(zz, 0.f) - __log2f(1.f + __builtin_amdgcn_exp2f(-fabsf(zz)));
          bool m = key < t;
          ls[sub][j] = m ? l_ : -3.0e38f;
          lk[sub][j] = m ? (l_ - zz) : 0.f;
          L[sub] += lk[sub][j];
        }
      }
      float a0[4], a1[4];
#pragma unroll
      for (int gq = 0; gq < 4; ++gq) { a0[gq] = shfl_l(L[0], fr + 16 * gq); a1[gq] = shfl_l(L[1], fr + 16 * gq); }
      float tot0 = a0[0] + a0[1] + a0[2] + a0[3], tot1 = a1[0] + a1[1] + a1[2] + a1[3];
      float suf0 = 0.f, suf1 = 0.f;
#pragma unroll
      for (int gq = 1; gq < 4; ++gq) { if (gq > fq) { suf0 += a0[gq]; suf1 += a1[gq]; } }
      float base[2]; base[1] = carry + suf1; base[0] = carry + tot1 + suf0;
      float wv[2][4];
#pragma unroll
      for (int sub = 0; sub < 2; ++sub) {
        float run = base[sub];
#pragma unroll
        for (int j = 3; j >= 0; --j) {
          float e = ls[sub][j] + run;
          wv[sub][j] = (ls[sub][j] > -1.0e38f) ? __builtin_amdgcn_exp2f(e) : 0.f;
          run += lk[sub][j];
        }
      }
      carry += tot0 + tot1;
      union { bf16x8 v; unsigned u[4]; } pb;
      pb.u[0] = pk2_sw(wv[0][0], wv[0][1]); pb.u[1] = pk2_sw(wv[0][2], wv[0][3]); pb.u[2] = pk2_sw(wv[1][0], wv[1][1]); pb.u[3] = pk2_sw(wv[1][2], wv[1][3]);
      const u16* vb = Vs + (fq * 4 + (fr >> 2)) * 72 + 4 * (fr & 3);
#pragma unroll
      for (int et = 0; et < 4; ++et) {
        union { bf16x8 v; uint2 h[2]; } av;
        av.h[0] = lds_tr16(vb + et * 16);
        av.h[1] = lds_tr16(vb + 16 * 72 + et * 16);
        ot[et] = mfma16(av.v, pb.v, ot[et]);
      }
      if (__all(carry < -150.04f)) break;
    }
    u16* brp = c.br + ((size_t)bl * 4096 + t) * BRW + 1024 + h * 64;
    float one = 1.f; asm volatile("" : "+v"(one));
#pragma unroll
    for (int et = 0; et < 4; ++et) {
      uint2 o; o.x = pk2(ot[et][0] * one, ot[et][1] * one); o.y = pk2(ot[et][2] * one, ot[et][3] * one);
      *(uint2*)(brp + et * 16 + fq * 4) = o;
    }
  }
}

struct DswaIt { int bl, g, h, d, r, nbi; };
DEVI DswaIt dswa_decode(int item) {
  DswaIt q; int blk = item & 31; q.h = (item >> 5) & 3; int gb = item >> 7; q.g = gb % 3; q.bl = gb / 3;
  q.d = (q.g == 0) ? 1 : (q.g == 1 ? 4 : 16); int nbr = 32 / q.d; q.r = blk / nbr; q.nbi = blk % nbr; return q;
}
#define DSWA_RAW_LOAD(ITEM)                                                                                          \
  {                                                                                                                    \
    const DswaIt q_ = dswa_decode(ITEM);                                                                               \
    const u16* pj_ = c.proj + (size_t)q_.bl * 4096 * NPROJ + q_.g * 256 + q_.h * 64 + (tid & 7) * 8;                    \
    _Pragma("unroll") for (int i_ = 0; i_ < 2; ++i_) {                                                                 \
      int row_ = (tid + 512 * i_) >> 3, tok_ = (q_.nbi * 128 + row_) * q_.d + q_.r;                                    \
      rq[i_] = *(const uint4*)(pj_ + (size_t)tok_ * NPROJ + OFF_AQ); }                                                 \
    _Pragma("unroll") for (int i_ = 0; i_ < 4; ++i_) {                                                                 \
      int row_ = (tid + 512 * i_) >> 3, sub_ = (q_.nbi - 1) * 128 + row_; bool ok_ = sub_ >= 0;                        \
      int tok_ = ok_ ? sub_ * q_.d + q_.r : 0;                                                                         \
      rk[i_] = *(const uint4*)(pj_ + (size_t)tok_ * NPROJ + OFF_AK); rv[i_] = *(const uint4*)(pj_ + (size_t)tok_ * NPROJ + OFF_AV); \
      if (!ok_) { rk[i_] = make_uint4(0, 0, 0, 0); rv[i_] = rk[i_]; } }                                                \
  }

DEVI void dswa_block_phase(const MixCtx& c, unsigned char* smem) {
  const int tid = otid(c.wv), w = tid >> 6, lane = tid & 63, fr = lane & 15, fq = lane >> 4, ch = tid & 7;
  u16* Qs = (u16*)smem; u16* Ks = Qs + 128 * 72; u16* Vs = Ks + 256 * 72;
  const float* qgp = KP(q_gain) + c.l * 64 + ch * 8; const float* kgp = KP(k_gain) + c.l * 64 + ch * 8;
  float qg[8], kg[8];
#pragma unroll
  for (int j = 0; j < 8; ++j) { qg[j] = qgp[j]; kg[j] = kgp[j]; }
  const int G = ogrd();
  int it = oblk();
  uint4 rq[2], rk[4], rv[4];
  if (it < 1536) DSWA_RAW_LOAD(it)
  for (; it < 1536; it += G) {
    const DswaIt q = dswa_decode(it);
#pragma unroll
    for (int i = 0; i < 2; ++i) {
      int row = (tid + 512 * i) >> 3;
      float v[8]; unpack8(rq[i], v);
      float ss = 0.f;
#pragma unroll
      for (int j = 0; j < 8; ++j) ss += v[j] * v[j];
      ss += shfl_xor_l(ss, 1, lane); ss += shfl_xor_l(ss, 2, lane); ss += shfl_xor_l(ss, 4, lane);
      float sc = rsqrtf(ss * (1.f / 64.f) + EPS);
      uint4 o; o.x = pk2(v[0] * sc * qg[0], v[1] * sc * qg[1]); o.y = pk2(v[2] * sc * qg[2], v[3] * sc * qg[3]);
      o.z = pk2(v[4] * sc * qg[4], v[5] * sc * qg[5]); o.w = pk2(v[6] * sc * qg[6], v[7] * sc * qg[7]);
      *(uint4*)(Qs + row * 72 + ch * 8) = o;
    }
#pragma unroll
    for (int i = 0; i < 4; ++i) {
      int row = (tid + 512 * i) >> 3;
      float v[8]; unpack8(rk[i], v);
      float ss = 0.f;
#pragma unroll
      for (int j = 0; j < 8; ++j) ss += v[j] * v[j];
      ss += shfl_xor_l(ss, 1, lane); ss += shfl_xor_l(ss, 2, lane); ss += shfl_xor_l(ss, 4, lane);
      float sc = rsqrtf(ss * (1.f / 64.f) + EPS);
      uint4 o; o.x = pk2(v[0] * sc * kg[0], v[1] * sc * kg[1]); o.y = pk2(v[2] * sc * kg[2], v[3] * sc * kg[3]);
      o.z = pk2(v[4] * sc * kg[4], v[5] * sc * kg[5]); o.w = pk2(v[6] * sc * kg[6], v[7] * sc * kg[7]);
      *(uint4*)(Ks + row * 72 + ch * 8) = o;
      *(uint4*)(Vs + row * 72 + ch * 8) = rv[i];
    }
    __syncthreads();
    if (it + G < 1536) DSWA_RAW_LOAD(it + G)
    bf16x8 qf[2];
#pragma unroll
    for (int ks = 0; ks < 2; ++ks) qf[ks] = *(const bf16x8*)(Qs + (16 * w + fr) * 72 + ks * 32 + fq * 8);
    const int pair0 = w >> 1;
    f32x4 st[5][2];
#pragma unroll
    for (int s5 = 0; s5 < 5; ++s5)
#pragma unroll
      for (int sub = 0; sub < 2; ++sub) {
        f32x4 a = {0.f, 0.f, 0.f, 0.f};
        int kb = 32 * (pair0 + s5) + 16 * sub;
#pragma unroll
        for (int ks = 0; ks < 2; ++ks) a = mfma16(*(const bf16x8*)(Ks + (kb + fr) * 72 + ks * 32 + fq * 8), qf[ks], a);
        st[s5][sub] = a;
      }
    const float slope_d = exp2f(-8.f * (float)(q.g * 4 + q.h + 1) / 12.f) * (float)q.d * 1.44269504f;
    int qi = 16 * w + fr;
    asm volatile("" : "+v"(qi));
    float mx = -3.0e38f;
#pragma unroll
    for (int s5 = 0; s5 < 5; ++s5)
#pragma unroll
      for (int sub = 0; sub < 2; ++sub)
#pragma unroll
        for (int j = 0; j < 4; ++j) {
          int kb = 32 * (pair0 + s5) + 16 * sub + 4 * fq + j, rel = 128 + qi - kb;
          bool ok = (rel >= 0) && (rel <= 128) && (q.nbi > 0 || kb >= 128);
          float sv = st[s5][sub][j] * (0.125f * 1.44269504f) - slope_d * (float)rel;
          sv = ok ? sv : -3.0e38f;
          st[s5][sub][j] = sv; mx = fmaxf(mx, sv);
        }
    mx = fmaxf(mx, shfl_xor_l(mx, 16, lane)); mx = fmaxf(mx, shfl_xor_l(mx, 32, lane));
    float den = 0.f;
#pragma unroll
    for (int s5 = 0; s5 < 5; ++s5)
#pragma unroll
      for (int sub = 0; sub < 2; ++sub)
#pragma unroll
        for (int j = 0; j < 4; ++j) {
          float sv = st[s5][sub][j];
          float pv = (sv > -1.0e38f) ? __builtin_amdgcn_exp2f(sv - mx) : 0.f;
          st[s5][sub][j] = pv; den += pv;
        }
    den += shfl_xor_l(den, 16, lane); den += shfl_xor_l(den, 32, lane);
    f32x4 ot[4];
#pragma unroll
    for (int et = 0; et < 4; ++et) ot[et] = (f32x4){0.f, 0.f, 0.f, 0.f};
#pragma unroll
    for (int s5 = 0; s5 < 5; ++s5) {
      u32x4_t pbu = {pk2_sw(st[s5][0][0], st[s5][0][1]), pk2_sw(st[s5][0][2], st[s5][0][3]), pk2_sw(st[s5][1][0], st[s5][1][1]), pk2_sw(st[s5][1][2], st[s5][1][3])};
      const bf16x8 pb = __builtin_bit_cast(bf16x8, pbu);
      const u16* vb = Vs + (32 * (pair0 + s5) + fq * 4 + (fr >> 2)) * 72 + 4 * (fr & 3);
#pragma unroll
      for (int et = 0; et < 4; ++et) ot[et] = mfma16(mk8(lds_tr16(vb + et * 16), lds_tr16(vb + 16 * 72 + et * 16)), pb, ot[et]);
    }
    const float inv = 1.f / den;
    const int tokq = (q.nbi * 128 + qi) * q.d + q.r;
    u16* pj = c.proj + (size_t)q.bl * 4096 * NPROJ;
#pragma unroll
    for (int et = 0; et < 4; ++et) {
      uint2 o; o.x = pk2(ot[et][0] * inv, ot[et][1] * inv); o.y = pk2(ot[et][2] * inv, ot[et][3] * inv);
      *(uint2*)(pj + (size_t)tokq * NPROJ + OFF_AQ + q.g * 256 + q.h * 64 + et * 16 + fq * 4) = o;
    }
    if (fq == 0) c.lse[((size_t)q.bl * 4096 + tokq) * 12 + q.g * 4 + q.h] = (mx + __log2f(den)) * 0.69314718f;
    __syncthreads();
  }
}
#undef DSWA_RAW_LOAD

DEVI void dswa_wave_phase(const MixCtx& c, unsigned char* smem) {
  const int tid = otid(c.wv), w = tid >> 6, lane = tid & 63, fr = lane & 15, fq = lane >> 4;
  u16* Vs = (u16*)smem + w * (32 * 72);
  const float* qgp = KP(q_gain) + c.l * 64; const float* kgp = KP(k_gain) + c.l * 64;
  float qg[16], kg[16];
#pragma unroll
  for (int ks = 0; ks < 2; ++ks)
#pragma unroll
    for (int j = 0; j < 8; ++j) { qg[ks * 8 + j] = qgp[ks * 32 + fq * 8 + j]; kg[ks * 8 + j] = kgp[ks * 32 + fq * 8 + j]; }
  for (int wi = oblk() * 8 + w; wi < 12288; wi += ogrd() * 8) {
    const int wq = wi & 7, blk = (wi >> 3) & 31, h = (wi >> 8) & 3, gb = wi >> 10, g = gb % 3, bl = gb / 3;
    const int d = (g == 0) ? 1 : (g == 1 ? 4 : 16), nbr = 32 / d, r = blk / nbr, nbi = blk % nbr;
    u16* pj = c.proj + (size_t)bl * 4096 * NPROJ;
    const int qi = 16 * wq + fr, tokq = (nbi * 128 + qi) * d + r;
    const int colq = OFF_AQ + g * 256 + h * 64, colk = OFF_AK + g * 256 + h * 64, colv = OFF_AV + g * 256 + h * 64;
    bf16x8 qf0, qf1;
    {
      uint4 r0 = *(const uint4*)(pj + (size_t)tokq * NPROJ + colq + fq * 8), r1 = *(const uint4*)(pj + (size_t)tokq * NPROJ + colq + 32 + fq * 8);
      float a[8], b[8]; unpack8(r0, a); unpack8(r1, b);
      float ss = 0.f;
#pragma unroll
      for (int j = 0; j < 8; ++j) ss += a[j] * a[j] + b[j] * b[j];
      ss += shfl_xor_l(ss, 16, lane); ss += shfl_xor_l(ss, 32, lane);
      float sc = rsqrtf(ss * (1.f / 64.f) + EPS);
      u32x4_t p0 = {pk2(a[0] * sc * qg[0], a[1] * sc * qg[1]), pk2(a[2] * sc * qg[2], a[3] * sc * qg[3]), pk2(a[4] * sc * qg[4], a[5] * sc * qg[5]), pk2(a[6] * sc * qg[6], a[7] * sc * qg[7])};
      u32x4_t p1 = {pk2(b[0] * sc * qg[8], b[1] * sc * qg[9]), pk2(b[2] * sc * qg[10], b[3] * sc * qg[11]), pk2(b[4] * sc * qg[12], b[5] * sc * qg[13]), pk2(b[6] * sc * qg[14], b[7] * sc * qg[15])};
      qf0 = __builtin_bit_cast(bf16x8, p0); qf1 = __builtin_bit_cast(bf16x8, p1);
    }
    const int pair0 = wq >> 1, sub0 = (nbi - 1) * 128;
    const float slope_d = exp2f(-8.f * (float)(g * 4 + h + 1) / 12.f) * (float)d;
    uint4 kn00, kn01, kn10, kn11, vn0, vn1, vn2, vn3;
#define DSWA_LOAD(P)                                                                                              \
    {                                                                                                               \
      const int kbA = 32 * (pair0 + (P)) + fr, sA = sub0 + kbA, sB = sA + 16;                                        \
      const u16* pa = pj + (size_t)((sA >= 0 ? sA : 0) * d + r) * NPROJ + colk + fq * 8;                             \
      const u16* pb_ = pj + (size_t)((sB >= 0 ? sB : 0) * d + r) * NPROJ + colk + fq * 8;                            \
      kn00 = *(const uint4*)(pa); kn01 = *(const uint4*)(pa + 32); kn10 = *(const uint4*)(pb_); kn11 = *(const uint4*)(pb_ + 32); \
      if (sA < 0) { kn00 = make_uint4(0, 0, 0, 0); kn01 = kn00; }                                                    \
      if (sB < 0) { kn10 = make_uint4(0, 0, 0, 0); kn11 = kn10; }                                                    \
      const int sV = sub0 + 32 * (pair0 + (P)) + (lane >> 1);                                                        \
      const u16* pv = pj + (size_t)((sV >= 0 ? sV : 0) * d + r) * NPROJ + colv + (lane & 1) * 32;                    \
      vn0 = *(const uint4*)(pv); vn1 = *(const uint4*)(pv + 8); vn2 = *(const uint4*)(pv + 16); vn3 = *(const uint4*)(pv + 24); \
      if (sV < 0) { vn0 = make_uint4(0, 0, 0, 0); vn1 = vn0; vn2 = vn0; vn3 = vn0; }                                 \
    }
    DSWA_LOAD(0)
    float mrun = -3.0e38f, den = 0.f;
    f32x4 ot[4];
#pragma unroll
    for (int et = 0; et < 4; ++et) ot[et] = (f32x4){0.f, 0.f, 0.f, 0.f};
    for (int p = 0; p < 5; ++p) {
      const uint4 k00 = kn00, k01 = kn01, k10 = kn10, k11 = kn11;
      {
        u16* vd = Vs + (lane >> 1) * 72 + (lane & 1) * 32;
        *(uint4*)(vd) = vn0; *(uint4*)(vd + 8) = vn1; *(uint4*)(vd + 16) = vn2; *(uint4*)(vd + 24) = vn3;
      }
      if (p < 4) DSWA_LOAD(p + 1)
      bf16x8 kf[2][2];
#pragma unroll
      for (int sub = 0; sub < 2; ++sub) {
        float a[8], b[8]; unpack8(sub ? k10 : k00, a); unpack8(sub ? k11 : k01, b);
        float ss = 0.f;
#pragma unroll
        for (int j = 0; j < 8; ++j) ss += a[j] * a[j] + b[j] * b[j];
        ss += shfl_xor_l(ss, 16, lane); ss += shfl_xor_l(ss, 32, lane);
        float sc = rsqrtf(ss * (1.f / 64.f) + EPS);
        u32x4_t p0 = {pk2(a[0] * sc * kg[0], a[1] * sc * kg[1]), pk2(a[2] * sc * kg[2], a[3] * sc * kg[3]), pk2(a[4] * sc * kg[4], a[5] * sc * kg[5]), pk2(a[6] * sc * kg[6], a[7] * sc * kg[7])};
        u32x4_t p1 = {pk2(b[0] * sc * kg[8], b[1] * sc * kg[9]), pk2(b[2] * sc * kg[10], b[3] * sc * kg[11]), pk2(b[4] * sc * kg[12], b[5] * sc * kg[13]), pk2(b[6] * sc * kg[14], b[7] * sc * kg[15])};
        kf[sub][0] = __builtin_bit_cast(bf16x8, p0); kf[sub][1] = __builtin_bit_cast(bf16x8, p1);
      }
      f32x4 z[2];
      z[0] = mfma16(kf[0][1], qf1, mfma16(kf[0][0], qf0, (f32x4){0.f, 0.f, 0.f, 0.f}));
      z[1] = mfma16(kf[1][1], qf1, mfma16(kf[1][0], qf0, (f32x4){0.f, 0.f, 0.f, 0.f}));
      float sv[2][4], mx = mrun;
#pragma unroll
      for (int sub = 0; sub < 2; ++sub)
#pragma unroll
        for (int j = 0; j < 4; ++j) {
          const int kb = 32 * (pair0 + p) + 16 * sub + 4 * fq + j, rel = 128 + qi - kb;
          const bool ok = (rel >= 0) && (rel <= 128) && (nbi > 0 || kb >= 128);
          float sc_ = z[sub][j] * 0.125f - slope_d * (float)rel;
          sc_ = ok ? sc_ : -3.0e38f;
          sv[sub][j] = sc_; mx = fmaxf(mx, sc_);
        }
      mx = fmaxf(mx, shfl_xor_l(mx, 16, lane)); mx = fmaxf(mx, shfl_xor_l(mx, 32, lane));
      const float alpha = __expf(mrun - mx);
      mrun = mx;
      float ps = 0.f;
#pragma unroll
      for (int sub = 0; sub < 2; ++sub)
#pragma unroll
        for (int j = 0; j < 4; ++j) { float pv = (sv[sub][j] > -1.0e38f) ? __expf(sv[sub][j] - mx) : 0.f; sv[sub][j] = pv; ps += pv; }
      ps += shfl_xor_l(ps, 16, lane); ps += shfl_xor_l(ps, 32, lane);
      den = den * alpha + ps;
#pragma unroll
      for (int et = 0; et < 4; ++et) { ot[et][0] *= alpha; ot[et][1] *= alpha; ot[et][2] *= alpha; ot[et][3] *= alpha; }
      u32x4_t pbu = {pk2_sw(sv[0][0], sv[0][1]), pk2_sw(sv[0][2], sv[0][3]), pk2_sw(sv[1][0], sv[1][1]), pk2_sw(sv[1][2], sv[1][3])};
      const bf16x8 pb = __builtin_bit_cast(bf16x8, pbu);
      const u16* vb = Vs + (fq * 4 + (fr >> 2)) * 72 + 4 * (fr & 3);
#pragma unroll
      for (int et = 0; et < 4; ++et) ot[et] = mfma16(mk8(lds_tr16(vb + et * 16), lds_tr16(vb + 16 * 72 + et * 16)), pb, ot[et]);
    }
#undef DSWA_LOAD
    const float inv = 1.f / den;
#pragma unroll
    for (int et = 0; et < 4; ++et) {
      uint2 o; o.x = pk2(ot[et][0] * inv, ot[et][1] * inv); o.y = pk2(ot[et][2] * inv, ot[et][3] * inv);
      *(uint2*)(pj + (size_t)tokq * NPROJ + colq + et * 16 + fq * 4) = o;
    }
    if (fq == 0) c.lse[((size_t)bl * 4096 + tokq) * 12 + g * 4 + h] = mrun + __logf(den);
  }
}

DEVI void conv_item(const MixCtx& c, int item, unsigned char* smem) {
  const int tid = otid(c.wv), w = tid >> 6, lane = tid & 63;
  int bl = item >> 7, t0 = (item & 127) * 32;
  float* ys = (float*)smem; float* cs = ys + 62 * 256;
  const u16* pj = c.proj + (size_t)bl * 4096 * NPROJ;
#pragma unroll
  for (int q = 0; q < 4; ++q) {
    int ci = tid + 512 * q;
    if (ci < 62 * 32) {
      int i = ci >> 5, c8 = (ci & 31) * 8, t = t0 - 30 + i;
      float y[8];
      if (t >= 0) {
        float a[8], g[8];
        unpack8(*(const uint4*)(pj + (size_t)t * NPROJ + OFF_CONV + c8), a);
        unpack8(*(const uint4*)(pj + (size_t)t * NPROJ + OFF_CONV + 256 + c8), g);
#pragma unroll
        for (int e = 0; e < 8; ++e) y[e] = a[e] * sigmoidf_(g[e]);
      } else {
#pragma unroll
        for (int e = 0; e < 8; ++e) y[e] = 0.f;
      }
      *(float4*)(ys + i * 256 + c8) = make_float4(y[0], y[1], y[2], y[3]);
      *(float4*)(ys + i * 256 + c8 + 4) = make_float4(y[4], y[5], y[6], y[7]);
    }
  }
  __syncthreads();
  {
    int ch = tid & 255, tg = tid >> 8;
    float wj[31];
    const float* cw = KP(conv_w) + (size_t)c.l * 31 * 256 + ch;
#pragma unroll
    for (int j = 0; j < 31; ++j) wj[j] = cw[j * 256];
    float bias = KP(conv_b)[c.l * 256 + ch];
    float acc[16];
#pragma unroll
    for (int tl = 0; tl < 16; ++tl) acc[tl] = bias;
#pragma unroll
    for (int i = 0; i < 46; ++i) {
      float v = ys[(tg * 16 + i) * 256 + ch];
#pragma unroll
      for (int tl = 0; tl < 16; ++tl) { const int d = i - tl, dc = d < 0 ? 0 : (d > 30 ? 30 : d); if (d >= 0 && d <= 30) acc[tl] += wj[dc] * v; }
    }
#pragma unroll
    for (int tl = 0; tl < 16; ++tl) cs[(tg * 16 + tl) * 256 + ch] = acc[tl];
  }
  __syncthreads();
  const float* lng = KP(conv_ln_g) + c.l * 256; const float* lnb = KP(conv_ln_b) + c.l * 256;
#pragma unroll
  for (int q = 0; q < 4; ++q) {
    int tok = w * 4 + q;
    float v[4], s = 0.f;
#pragma unroll
    for (int i = 0; i < 4; ++i) { v[i] = cs[tok * 256 + lane + 64 * i]; s += v[i]; }
#pragma unroll
    for (int o = 1; o < 64; o <<= 1) s += shfl_xor_l(s, o, lane);
    float mu = s * (1.f / 256.f), s2 = 0.f;
#pragma unroll
    for (int i = 0; i < 4; ++i) { v[i] -= mu; s2 += v[i] * v[i]; }
#pragma unroll
    for (int o = 1; o < 64; o <<= 1) s2 += shfl_xor_l(s2, o, lane);
    float rs = rsqrtf(s2 * (1.f / 256.f) + EPS);
    u16* o = c.br + ((size_t)bl * 4096 + t0 + tok) * BRW + 256;
#pragma unroll
    for (int i = 0; i < 4; ++i) {
      int ch = lane + 64 * i;
      float y = v[i] * rs * lng[ch] + lnb[ch];
      o[ch] = f2bf(y * sigmoidf_(y));
    }
  }
}

DEVI void gla_cum8(const float (&xg)[8], float* segtot, float (&cum)[8], int tid) {
  const int lane = tid & 63, w = tid >> 6, kc = tid & 7;
#pragma unroll
  for (int j = 0; j < 8; ++j) cum[j] = logsigf_(xg[j]) * (1.f / 16.f);
#pragma unroll
  for (int j = 0; j < 8; ++j) {
    float o = shfl_up_l(cum[j], 8, lane); if (lane >= 8) cum[j] += o;
    o = shfl_up_l(cum[j], 16, lane); if (lane >= 16) cum[j] += o;
    o = shfl_up_l(cum[j], 32, lane); if (lane >= 32) cum[j] += o;
  }
  if (lane >= 56) {
    *(float4*)(segtot + w * 64 + kc * 8) = make_float4(cum[0], cum[1], cum[2], cum[3]);
    *(float4*)(segtot + w * 64 + kc * 8 + 4) = make_float4(cum[4], cum[5], cum[6], cum[7]);
  }
  __syncthreads();
#pragma unroll
  for (int ww = 0; ww < 7; ++ww) {
    float4 a = *(const float4*)(segtot + ww * 64 + kc * 8), b = *(const float4*)(segtot + ww * 64 + kc * 8 + 4);
    if (ww < w) { cum[0] += a.x; cum[1] += a.y; cum[2] += a.z; cum[3] += a.w; cum[4] += b.x; cum[5] += b.y; cum[6] += b.z; cum[7] += b.w; }
  }
}

DEVI void gla_gate8(const float4 (&gl)[4], const float* wgS, const float* bgp, int kc, float (&xg)[8]) {
  const float g[16] = {gl[0].x, gl[0].y, gl[0].z, gl[0].w, gl[1].x, gl[1].y, gl[1].z, gl[1].w, gl[2].x, gl[2].y, gl[2].z, gl[2].w, gl[3].x, gl[3].y, gl[3].z, gl[3].w};
#pragma unroll
  for (int j = 0; j < 8; ++j) xg[j] = bgp[kc * 8 + j];
#pragma unroll
  for (int r = 0; r < 16; ++r) {
    float4 a = *(const float4*)(wgS + r * 64 + kc * 8), b = *(const float4*)(wgS + r * 64 + kc * 8 + 4);
    xg[0] += g[r] * a.x; xg[1] += g[r] * a.y; xg[2] += g[r] * a.z; xg[3] += g[r] * a.w;
    xg[4] += g[r] * b.x; xg[5] += g[r] * b.y; xg[6] += g[r] * b.z; xg[7] += g[r] * b.w;
  }
}

DEVI void gla_local_item(const MixCtx& c, int unit, unsigned char* smem) {
  const int tid = otid(c.wv), w = tid >> 6, lane = tid & 63, fr = lane & 15, fq = lane >> 4;
  int ch = unit & 63, h = (unit >> 6) & 3, bl = unit >> 8, tok0 = ch * 64;
  float* segtot = (float*)smem;
  u16* keS = (u16*)(smem + 2048);
  u16* vS = (u16*)(smem + 20480);
  const u16* pj = c.proj + (size_t)bl * 4096 * NPROJ;
  const float* bgp = KP(gla_b_gate) + c.l * 256 + h * 64;
  const int t = tid >> 3, kc = tid & 7;
  const float4* glp = (const float4*)(c.glow + ((size_t)bl * 4096 + tok0 + t) * 256 + h * 64 + kc * 8);
  const float4 xg0 = glp[0], xg1 = glp[1];
  uint4 kraw = *(const uint4*)(pj + (size_t)(tok0 + t) * NPROJ + OFF_CK + h * 64 + kc * 8);
  const uint4 vraw0 = *(const uint4*)(pj + (size_t)(tok0 + (tid >> 4)) * NPROJ + OFF_CV + h * 128 + (tid & 15) * 8);
  const uint4 vraw1 = *(const uint4*)(pj + (size_t)(tok0 + 32 + (tid >> 4)) * NPROJ + OFF_CV + h * 128 + (tid & 15) * 8);
  const float xg[8] = {xg0.x, xg0.y, xg0.z, xg0.w, xg1.x, xg1.y, xg1.z, xg1.w};
  float cum[8];
  gla_cum8(xg, segtot, cum, tid);
  {
    float last[8];
#pragma unroll
    for (int j = 0; j < 8; ++j) last[j] = 0.f;
#pragma unroll
    for (int ww = 0; ww < 8; ++ww) {
      float4 a = *(const float4*)(segtot + ww * 64 + kc * 8), b = *(const float4*)(segtot + ww * 64 + kc * 8 + 4);
      last[0] += a.x; last[1] += a.y; last[2] += a.z; last[3] += a.w; last[4] += b.x; last[5] += b.y; last[6] += b.z; last[7] += b.w;
    }
    float kv[8]; unpack8(kraw, kv);
    uint4 o;
    o.x = pk2(kv[0] * __expf(last[0] - cum[0]), kv[1] * __expf(last[1] - cum[1])); o.y = pk2(kv[2] * __expf(last[2] - cum[2]), kv[3] * __expf(last[3] - cum[3]));
    o.z = pk2(kv[4] * __expf(last[4] - cum[4]), kv[5] * __expf(last[5] - cum[5])); o.w = pk2(kv[6] * __expf(last[6] - cum[6]), kv[7] * __expf(last[7] - cum[7]));
    *(uint4*)(keS + t * 72 + kc * 8) = o;
    if (tid < 8) {
      float4 e0 = make_float4(__expf(last[0]), __expf(last[1]), __expf(last[2]), __expf(last[3])), e1 = make_float4(__expf(last[4]), __expf(last[5]), __expf(last[6]), __expf(last[7]));
      *(float4*)(c.gdec + (size_t)unit * 64 + kc * 8) = e0; *(float4*)(c.gdec + (size_t)unit * 64 + kc * 8 + 4) = e1;
    }
    *(uint4*)(vS + (tid >> 4) * 136 + (tid & 15) * 8) = vraw0;
    *(uint4*)(vS + (32 + (tid >> 4)) * 136 + (tid & 15) * 8) = vraw1;
  }
  __syncthreads();
  bf16x8 af[2];
#pragma unroll
  for (int ks = 0; ks < 2; ++ks) {
    const u16* vb = vS + (ks * 32 + fq * 8 + (fr >> 2)) * 136 + 16 * w + 4 * (fr & 3);
    af[ks] = mk8(lds_tr16(vb), lds_tr16(vb + 4 * 136));
  }
  float* S = c.S + (size_t)unit * 8192;
#pragma unroll
  for (int jt = 0; jt < 4; ++jt) {
    f32x4 a = {0.f, 0.f, 0.f, 0.f};
#pragma unroll
    for (int ks = 0; ks < 2; ++ks) {
      const u16* kb = keS + (ks * 32 + fq * 8 + (fr >> 2)) * 72 + 16 * jt + 4 * (fr & 3);
      a = mfma16(af[ks], mk8(lds_tr16(kb), lds_tr16(kb + 4 * 72)), a);
    }
#pragma unroll
    for (int j = 0; j < 4; ++j) S[(16 * w + fq * 4 + j) * 64 + 16 * jt + fr] = a[j];
  }
}

DEVI void gla_scan_phase(const MixCtx& c) {
  long gtid = (long)oblk() * 512 + otid(c.wv), gsz = (long)ogrd() * 512;
  for (long idx = gtid; idx < 16L * 8192; idx += gsz) {
    int bh = (int)(idx >> 13), e = (int)(idx & 8191), k = e & 63;
    float* __restrict__ S = c.S + (size_t)bh * 64 * 8192 + e;
    const float* __restrict__ gd = c.gdec + (size_t)bh * 64 * 64 + k;
    float run = 0.f;
    for (int c0 = 0; c0 < 64; c0 += 32) {
      float loc[32], g[32];
#pragma unroll
      for (int i = 0; i < 32; ++i) { loc[i] = S[(size_t)(c0 + i) * 8192]; g[i] = gd[(c0 + i) * 64]; }
#pragma unroll
      for (int i = 0; i < 32; ++i) { S[(size_t)(c0 + i) * 8192] = run; run = g[i] * run + loc[i]; }
    }
  }
}

DEVI void gla_tok0_partials(const MixCtx& c) {
  const int tid = otid(c.wv), w = tid >> 6, lane = tid & 63;
  float* c0p = (float*)(KWS() + O_C0);
  for (int wi = oblk() * 8 + w; wi < 512; wi += ogrd() * 8) {
    int ks = wi & 15, qk = (wi >> 4) & 1, h = (wi >> 5) & 3, bl = wi >> 7, b = c.hf * 4 + bl;
    const float* xr = ((c.l == 0) ? KP(x) : (const float*)KOUT()) + (size_t)b * 4096 * 1024;
    const float* mf = (const float*)(KWS() + O_MODF) + ((size_t)c.l * 8 + b) * 6144;
    float ss = 0.f;
#pragma unroll
    for (int j = 0; j < 4; ++j) { float4 v = ((const float4*)xr)[lane + 64 * j]; ss += v.x * v.x + v.y * v.y + v.z * v.z + v.w * v.w; }
#pragma unroll
    for (int o = 1; o < 64; o <<= 1) ss += shfl_xor_l(ss, o, lane);
    float rs = rsqrtf(ss * (1.f / 1024.f) + EPS);
    int i0 = ks * 64 + lane;
    float h0 = xr[i0] * rs * mf[i0] + mf[1024 + i0];
    const float* wp = KP(w_in) + (size_t)c.l * 1024 * INW + (size_t)(ks * 64) * INW + (qk ? 3072 : 2816) + h * 64 + lane;
    float a = 0.f;
    float wrow[64];
#pragma unroll
    for (int i = 0; i < 64; ++i) wrow[i] = wp[(size_t)i * INW];
#pragma unroll
    for (int i = 0; i < 64; ++i) a += shfl_l(h0, i) * wrow[i];
    c0p[(size_t)wi * 64 + lane] = a;
  }
}

#define GLA_OUT_LOAD(U)                                                                                                  \
  {                                                                                                                        \
    const int ch_ = (U) & 63, h_ = ((U) >> 6) & 3, bl_ = (U) >> 8, tok0_ = ch_ * 64;                                        \
    const u16* pj_ = c.proj + (size_t)bl_ * 4096 * NPROJ;                                                                  \
    const u16* rowp_ = pj_ + (size_t)(tok0_ + t) * NPROJ + h_ * 64 + kc * 8;                                                \
    qraw = *(const uint4*)(rowp_ + OFF_CQ); kraw = *(const uint4*)(rowp_ + OFF_CK);                                         \
    const float4* glp_ = (const float4*)(c.glow + ((size_t)bl_ * 4096 + tok0_ + t) * 256 + h_ * 64 + kc * 8);               \
    xg0 = glp_[0]; xg1 = glp_[1];                                                                                          \
    vraw0 = *(const uint4*)(pj_ + (size_t)(tok0_ + (tid >> 4)) * NPROJ + OFF_CV + h_ * 128 + (tid & 15) * 8);               \
    vraw1 = *(const uint4*)(pj_ + (size_t)(tok0_ + 32 + (tid >> 4)) * NPROJ + OFF_CV + h_ * 128 + (tid & 15) * 8);          \
    rraw0 = *(const uint4*)(pj_ + (size_t)(tok0_ + t) * NPROJ + OFF_CR + h_ * 128 + kc * 16);                               \
    rraw1 = *(const uint4*)(pj_ + (size_t)(tok0_ + t) * NPROJ + OFF_CR + h_ * 128 + kc * 16 + 8);                           \
    const float4* Sg_ = (const float4*)(c.S + (size_t)(U) * 8192);                                                          \
    sraw0 = Sg_[tid]; sraw1 = Sg_[tid + 512]; sraw2 = Sg_[tid + 1024]; sraw3 = Sg_[tid + 1536];                             \
  }

DEVI void gla_out_phase(const MixCtx& c, unsigned char* smem) {
  const int tid = otid(c.wv), w = tid >> 6, lane = tid & 63, fr = lane & 15, fq = lane >> 4;
  float* segtot = (float*)smem;
  u16* qt = (u16*)(smem + 2048); u16* kt = (u16*)(smem + 11264); u16* vS = (u16*)(smem + 20480);
  u16* stT = (u16*)(smem + 37888); u16* att = (u16*)(smem + 56320); float* oS = (float*)(smem + 65536);
  const float* og = KP(gla_o_gain) + c.l * 128;
  const float* c0p = (const float*)(KWS() + O_C0);
  const int t = tid >> 3, kc = tid & 7;
  const int Gd = ogrd();
  uint4 qraw, kraw, vraw0, vraw1, rraw0, rraw1; float4 xg0, xg1, sraw0, sraw1, sraw2, sraw3;
  int unit = oblk();
  if (unit < 1024) GLA_OUT_LOAD(unit)
  for (; unit < 1024; unit += Gd) {
  const int ch = unit & 63, h = (unit >> 6) & 3, bl = unit >> 8, tok0 = ch * 64;
  const float xg[8] = {xg0.x, xg0.y, xg0.z, xg0.w, xg1.x, xg1.y, xg1.z, xg1.w};
  float cum[8];
  gla_cum8(xg, segtot, cum, tid);
  {
    float qv[8], kv[8]; unpack8(qraw, qv); unpack8(kraw, kv);
    float eq[8], ek[8];
#pragma unroll
    for (int j = 0; j < 8; ++j) { float e = __expf(cum[j]); eq[j] = qv[j] * 0.125f * e; ek[j] = kv[j] * __expf(-cum[j]); }
    uint4 o;
    o.x = pk2(eq[0], eq[1]); o.y = pk2(eq[2], eq[3]); o.z = pk2(eq[4], eq[5]); o.w = pk2(eq[6], eq[7]);
    *(uint4*)(qt + t * 72 + kc * 8) = o;
    o.x = pk2(ek[0], ek[1]); o.y = pk2(ek[2], ek[3]); o.z = pk2(ek[4], ek[5]); o.w = pk2(ek[6], ek[7]);
    *(uint4*)(kt + t * 72 + kc * 8) = o;
    *(uint4*)(vS + (tid >> 4) * 136 + (tid & 15) * 8) = vraw0;
    *(uint4*)(vS + (32 + (tid >> 4)) * 136 + (tid & 15) * 8) = vraw1;
    *(uint2*)(stT + (tid >> 4) * 72 + (tid & 15) * 4) = make_uint2(pk2(sraw0.x, sraw0.y), pk2(sraw0.z, sraw0.w));
    *(uint2*)(stT + (32 + (tid >> 4)) * 72 + (tid & 15) * 4) = make_uint2(pk2(sraw1.x, sraw1.y), pk2(sraw1.z, sraw1.w));
    *(uint2*)(stT + (64 + (tid >> 4)) * 72 + (tid & 15) * 4) = make_uint2(pk2(sraw2.x, sraw2.y), pk2(sraw2.z, sraw2.w));
    *(uint2*)(stT + (96 + (tid >> 4)) * 72 + (tid & 15) * 4) = make_uint2(pk2(sraw3.x, sraw3.y), pk2(sraw3.z, sraw3.w));
  }
  __syncthreads();
  const uint4 rc0 = rraw0, rc1 = rraw1;
  if (unit + Gd < 1024) GLA_OUT_LOAD(unit + Gd)
  {
    int it = w >> 1;
    bf16x8 af[2];
#pragma unroll
    for (int ks = 0; ks < 2; ++ks) af[ks] = *(const bf16x8*)(qt + (16 * it + fr) * 72 + ks * 32 + fq * 8);
#pragma unroll
    for (int jj = 0; jj < 2; ++jj) {
      int jt = 2 * (w & 1) + jj;
      f32x4 a = {0.f, 0.f, 0.f, 0.f};
#pragma unroll
      for (int ks = 0; ks < 2; ++ks) a = mfma16(af[ks], *(const bf16x8*)(kt + (16 * jt + fr) * 72 + ks * 32 + fq * 8), a);
#pragma unroll
      for (int j = 0; j < 4; ++j) { int tt = 16 * it + fq * 4 + j, ss = 16 * jt + fr; att[tt * 72 + ss] = f2bf(ss <= tt ? a[j] : 0.f); }
    }
  }
  __syncthreads();
  {
    int it = w >> 1;
    bf16x8 a1[2], a2[2];
#pragma unroll
    for (int ks = 0; ks < 2; ++ks) { a1[ks] = *(const bf16x8*)(att + (16 * it + fr) * 72 + ks * 32 + fq * 8); a2[ks] = *(const bf16x8*)(qt + (16 * it + fr) * 72 + ks * 32 + fq * 8); }
#pragma unroll
    for (int jj = 0; jj < 4; ++jj) {
      int jt = 4 * (w & 1) + jj;
      f32x4 a = {0.f, 0.f, 0.f, 0.f};
#pragma unroll
      for (int ks = 0; ks < 2; ++ks) {
        const u16* vb = vS + (ks * 32 + fq * 8 + (fr >> 2)) * 136 + 16 * jt + 4 * (fr & 3);
        a = mfma16(a1[ks], mk8(lds_tr16(vb), lds_tr16(vb + 4 * 136)), a);
        a = mfma16(a2[ks], *(const bf16x8*)(stT + (16 * jt + fr) * 72 + ks * 32 + fq * 8), a);
      }
#pragma unroll
      for (int j = 0; j < 4; ++j) oS[(16 * it + fq * 4 + j) * 132 + 16 * jt + fr] = a[j];
    }
  }
  __syncthreads();
  if (ch == 0) {
    const float* cp = c0p + (size_t)((bl * 4 + h) * 2) * 16 * 64;
    float qv = 0.f, kv = 0.f;
#pragma unroll
    for (int ks = 0; ks < 16; ++ks) { qv += cp[ks * 64 + lane]; kv += cp[1024 + ks * 64 + lane]; }
    float pr = qv * kv;
#pragma unroll
    for (int o = 1; o < 64; o <<= 1) pr += shfl_xor_l(pr, o, lane);
    if (tid < 128) oS[tid] = pr * 0.125f * bf2f(vS[tid]);
    __syncthreads();
  }
  {
    const float* ogp = og + kc * 16;
    float ov[16];
#pragma unroll
    for (int i = 0; i < 4; ++i) { float4 a = *(const float4*)(oS + t * 132 + kc * 16 + 4 * i); ov[4 * i] = a.x; ov[4 * i + 1] = a.y; ov[4 * i + 2] = a.z; ov[4 * i + 3] = a.w; }
    float ss = 0.f;
#pragma unroll
    for (int i = 0; i < 16; ++i) ss += ov[i] * ov[i];
    ss += shfl_xor_l(ss, 1, lane); ss += shfl_xor_l(ss, 2, lane); ss += shfl_xor_l(ss, 4, lane);
    float rs = rsqrtf(ss * (1.f / 128.f) + EPS);
    u16* op = c.br + ((size_t)bl * 4096 + tok0 + t) * BRW + 512 + h * 128 + kc * 16;
#pragma unroll
    for (int i = 0; i < 2; ++i) {
      float r[8]; unpack8(i ? rc1 : rc0, r);
      float y[8];
#pragma unroll
      for (int e = 0; e < 8; ++e) y[e] = ov[8 * i + e] * rs * ogp[8 * i + e] * r[e] * sigmoidf_(r[e]);
      uint4 o; o.x = pk2(y[0], y[1]); o.y = pk2(y[2], y[3]); o.z = pk2(y[4], y[5]); o.w = pk2(y[6], y[7]);
      *(uint4*)(op + 8 * i) = o;
    }
  }
  __syncthreads();
  }
}
#undef GLA_OUT_LOAD

DEVI void dswa_merge_phase(const MixCtx& c) {
  long gtid = (long)oblk() * 512 + otid(c.wv), gsz = (long)ogrd() * 512;
  for (long idx0 = gtid; idx0 < (long)MH * 32; idx0 += 2 * gsz) {
    float l0[2], l1[2], l2[2]; uint4 ra[2], rb[2], rd[2]; bool ok[2];
#pragma unroll
    for (int q = 0; q < 2; ++q) {
      const long idx = idx0 + q * gsz; ok[q] = idx < (long)MH * 32;
      const long ii = ok[q] ? idx : idx0;
      const long tok = ii >> 5; const int chunk = (int)(ii & 31), h = chunk >> 3, e0 = (chunk & 7) * 8;
      const float* ls = c.lse + tok * 12 + h;
      l0[q] = ls[0]; l1[q] = ls[4]; l2[q] = ls[8];
      const u16* pr = c.proj + tok * NPROJ + h * 64 + e0;
      ra[q] = *(const uint4*)(pr); rb[q] = *(const uint4*)(pr + 256); rd[q] = *(const uint4*)(pr + 512);
    }
#pragma unroll
    for (int q = 0; q < 2; ++q) {
      if (!ok[q]) continue;
      const long idx = idx0 + q * gsz;
      const long tok = idx >> 5; const int chunk = (int)(idx & 31), h = chunk >> 3, e0 = (chunk & 7) * 8;
      float m = fmaxf(l0[q], fmaxf(l1[q], l2[q]));
      float w0 = __expf(l0[q] - m), w1 = __expf(l1[q] - m), w2 = __expf(l2[q] - m), inv = 1.f / (w0 + w1 + w2);
      w0 *= inv; w1 *= inv; w2 *= inv;
      float a[8], b[8], d[8];
      unpack8(ra[q], a); unpack8(rb[q], b); unpack8(rd[q], d);
      uint4 o;
      o.x = pk2(w0 * a[0] + w1 * b[0] + w2 * d[0], w0 * a[1] + w1 * b[1] + w2 * d[1]);
      o.y = pk2(w0 * a[2] + w1 * b[2] + w2 * d[2], w0 * a[3] + w1 * b[3] + w2 * d[3]);
      o.z = pk2(w0 * a[4] + w1 * b[4] + w2 * d[4], w0 * a[5] + w1 * b[5] + w2 * d[5]);
      o.w = pk2(w0 * a[6] + w1 * b[6] + w2 * d[6], w0 * a[7] + w1 * b[7] + w2 * d[7]);
      *(uint4*)(c.br + tok * BRW + h * 64 + e0) = o;
    }
  }
}

#define XB_TMO      128
#define XB_XCNT(j)  (256  + 64 * (j))
#define XB_XSUB(j)  (1280 + 64 * (j))
#define XB_XGEN(j)  (2304 + 64 * (j))
#define XB_TOP      3328
#define XB_TOPGEN   3392
#define XCD_BAR_WORDS 3456
#define XB_SPIN_CAP (1u << 22)
#define LAS __attribute__((address_space(3)))
DEVI unsigned xb_ld(unsigned* p) { return __hip_atomic_load(p, __ATOMIC_RELAXED, __HIP_MEMORY_SCOPE_AGENT); }
DEVI unsigned xb_add(unsigned* p, unsigned v) { return __hip_atomic_fetch_add(p, v, __ATOMIC_RELAXED, __HIP_MEMORY_SCOPE_AGENT); }
DEVI unsigned xb_xcc_id() { return (unsigned)__builtin_amdgcn_s_getreg((3 << 11) | 20) & 0xFu; }
#define XB_SPIN(cond, bar) do { unsigned _sp = 0; while (cond) { __builtin_amdgcn_s_sleep(1); \
    if ((++_sp & 255u) == 0u) { if (xb_ld(&(bar)[XB_TMO])) break; if (_sp > XB_SPIN_CAP) { atomicAdd(&(bar)[XB_TMO], 1u); break; } } } } while (0)

DEVI void xb_complete(unsigned* bar, unsigned x, unsigned G, unsigned& nloc, unsigned& nx) {
  unsigned sum, cnt, mine, sp = 0u;
  for (;;) {
    sum = 0u; cnt = 0u; mine = 0u;
#pragma unroll
    for (unsigned j = 0; j < 16; ++j) { const unsigned cc = xb_ld(&bar[XB_XCNT(j)]); sum += cc; cnt += (cc > 0u) ? 1u : 0u; mine = (j == x) ? cc : mine; }
    if (sum == G) break;
    __builtin_amdgcn_s_sleep(1);
    if ((++sp & 255u) == 0u) { if (xb_ld(&bar[XB_TMO])) break; if (sp > XB_SPIN_CAP) { atomicAdd(&bar[XB_TMO], 1u); break; } }
  }
  nloc = mine > 0u ? mine : 1u; nx = cnt > 0u ? cnt : 1u;
}

DEVI void gbar1(int wv, unsigned& nbar, unsigned char* smem) {
  asm volatile("s_waitcnt vmcnt(0)" ::: "memory");
  __syncthreads();
  unsigned* bar = (unsigned*)(KWS() + O_BAR);
  const unsigned x = xb_xcc_id();
  if (otid(wv) == 0) {
    volatile LAS unsigned* st = (volatile LAS unsigned*)(smem + 131072);
    __builtin_amdgcn_s_waitcnt(0);
    unsigned nloc = st[0], nx = st[1];
    if (nloc == 0u) { xb_complete(bar, x, (unsigned)ogrd(), nloc, nx); st[0] = nloc; st[1] = nx; }
    const unsigned old = xb_add(&bar[XB_XSUB(x)], 1u);
    const unsigned gen = old / nloc;
    if (old + 1u == (gen + 1u) * nloc) {
      __builtin_amdgcn_fence(__ATOMIC_RELEASE, "agent");
      asm volatile("s_waitcnt vmcnt(0)" ::: "memory");
      const unsigned og = xb_add(&bar[XB_TOP], 1u);
      const unsigned tg = og / nx;
      if (og + 1u == (tg + 1u) * nx) xb_add(&bar[XB_TOPGEN], 1u);
      else XB_SPIN(xb_ld(&bar[XB_TOPGEN]) == tg, bar);
      __builtin_amdgcn_fence(__ATOMIC_ACQUIRE, "agent");
      xb_add(&bar[XB_XGEN(x)], 1u);
      asm volatile("s_waitcnt vmcnt(0)" ::: "memory");
    } else {
      XB_SPIN(xb_ld(&bar[XB_XGEN(x)]) == gen, bar);
      __builtin_amdgcn_fence(__ATOMIC_ACQUIRE, "agent");
      asm volatile("s_waitcnt vmcnt(0)" ::: "memory");
    }
  }
  __syncthreads();
}
DEVI void gbar(int wv, unsigned& nbar, unsigned char* smem) { PREP(7) gbar1(wv, nbar, smem); }

__global__ void __launch_bounds__(512) mega(Params p_unused) {
  extern __shared__ __attribute__((aligned(16))) unsigned char smem[];
  cg::grid_group grid = cg::this_grid();
  u16* shm = (u16*)smem;
  unsigned nbar = 0;
  const int wv = __builtin_amdgcn_readfirstlane((int)(threadIdx.x >> 6));
  {
    unsigned* bar0 = (unsigned*)(KWS() + O_BAR);
    const unsigned xcc0 = xb_xcc_id();
    if (otid(wv) == 0) {
      volatile LAS unsigned* st = (volatile LAS unsigned*)(smem + 131072);
      st[0] = 0u; st[1] = 0u;
      (void)xb_add(bar0 + XB_XCNT(xcc0), 1u);
    }
  }
  __syncthreads();

  PREP(0) prep_phase(wv, smem);
  grid.sync();
  PREP(0) modfinal_phase(wv);
  gbar(wv, nbar, smem);

  for (int l = 0; l < NL; ++l) {
    for (int hf = 0; hf < 2; ++hf) {
      const int row0 = hf * MH;
      const size_t o_h = (hf == 0) ? O_H : O_BR;
      if (hf == 0) {
        unsigned char* ws = KWS();
        const float* xin = (l == 0) ? KP(x) : (const float*)KOUT();
        PREP(1) norm_phase(wv, xin, row0, MH, (const float*)(ws + O_MODF) + (size_t)l * 8 * 6144, 0, (u16*)(ws + O_H));
        gbar(wv, nbar, smem);
      }
      {
        unsigned char* ws = KWS();
        EpiBf16 e; e.C = (u16*)(ws + O_PROJ); e.ldc = NPROJ; e.relu2 = 0;
        PREP(2) gemm_phase<1024>(wv, shm, (const u16*)(ws + o_h), (const u16*)(ws + O_WT) + (size_t)l * WT_L + WT_IN, MH, NPROJ, 1024, e);
        glow_phase(wv, l, (const u16*)(ws + o_h), (const u16*)(ws + O_WT) + (size_t)l * WT_L + WT_LOW, (float*)(ws + O_GLOW));
      }
      gbar(wv, nbar, smem);
      {
        MixCtx c = make_ctx(wv, l, hf);
        dswa_block_phase(c, smem);
        for (int it = oblk(); it < 1024 + 512; it += ogrd()) {
          if (it < 1024) gla_local_item(c, it, smem);
          else conv_item(c, it - 1024, smem);
          __syncthreads();
        }
        PREP(10) sb_wave_phase(c, smem);
        gla_tok0_partials(c);
      }
      gbar(wv, nbar, smem);
      { MixCtx c = make_ctx(wv, l, hf); gla_scan_phase(c); }
      gbar(wv, nbar, smem);
      {
        MixCtx c = make_ctx(wv, l, hf);
        PREP(4) { gla_out_phase(c, smem);
        dswa_merge_phase(c); }
      }
      gbar(wv, nbar, smem);
      {
        unsigned char* ws = KWS();
        PREP(5) branch_phase(wv, shm, (const u16*)(ws + O_BR), (const u16*)(ws + O_WT) + (size_t)l * WT_L + WT_BR, (const u16*)(ws + O_PROJ), (u16*)(ws + O_S));
      }
      gbar(wv, nbar, smem);
      {
        unsigned char* ws = KWS();
        EpiRes e; e.xin = (l == 0) ? KP(x) : (const float*)KOUT(); e.xout = KOUT(); e.gate = (const float*)(ws + O_MODF) + (size_t)l * 8 * 6144 + 2048; e.row0 = row0;
        gemm_phase<1024>(wv, shm, (const u16*)(ws + O_S), (const u16*)(ws + O_WT) + (size_t)l * WT_L + WT_OUT, MH, 1024, 1024, e);
        if (hf == 0) {
          const float* xin2 = (l == 0) ? KP(x) : (const float*)KOUT();
          norm_phase(wv, xin2, MH, MH, (const float*)(ws + O_MODF) + (size_t)l * 8 * 6144, 0, (u16*)(ws + O_BR));
        }
      }
      gbar(wv, nbar, smem);
    }
    {
      unsigned char* ws = KWS();
      PREP(1) norm_phase(wv, (const float*)KOUT(), 0, MTOK, (const float*)(ws + O_MODF) + (size_t)l * 8 * 6144, 3, (u16*)(ws + O_BR));
    }
    gbar(wv, nbar, smem);
    for (int hh = 0; hh < 2; ++hh) {
      {
        unsigned char* ws = KWS();
        EpiBf16 e; e.C = (u16*)(ws + O_PROJ) + (size_t)hh * MH * 4096; e.ldc = 4096; e.relu2 = 1;
        PREP(6) gemm_phase<1024>(wv, shm, (const u16*)(ws + O_BR) + (size_t)hh * MH * 1024, (const u16*)(ws + O_WT) + (size_t)l * WT_L + WT_UP, MH, 4096, 1024, e);
      }
      gbar(wv, nbar, smem);
      {
        unsigned char* ws = KWS();
        EpiRes e; e.xin = (const float*)KOUT(); e.xout = KOUT(); e.gate = (const float*)(ws + O_MODF) + (size_t)l * 8 * 6144 + 5120; e.row0 = hh * MH;
        gemm_phase<4096>(wv, shm, (const u16*)(ws + O_PROJ) + (size_t)hh * MH * 4096, (const u16*)(ws + O_WT) + (size_t)l * WT_L + WT_DOWN, MH, 1024, 4096, e);
      }
    }
    gbar(wv, nbar, smem);
  }
}

extern "C" void kernel_launch(void* const* d_in, const int* in_sizes, int n_in,
                              void* d_out, int out_size, void* d_ws, size_t ws_size,
                              hipStream_t stream) {
  static int grid_blocks = 0;
  if (!grid_blocks) {
    int dev = 0, cus = 0, per_cu = 0;
    (void)hipGetDevice(&dev);
    (void)hipDeviceGetAttribute(&cus, hipDeviceAttributeMultiprocessorCount, dev);
    (void)hipFuncSetAttribute((const void*)mega, hipFuncAttributeMaxDynamicSharedMemorySize, LDS_BYTES);
    (void)hipOccupancyMaxActiveBlocksPerMultiprocessor(&per_cu, (const void*)mega, 512, LDS_BYTES);
    if (per_cu < 1) per_cu = 1;
    grid_blocks = cus * 1;
    if (ws_size < WS_END) fprintf(stderr, "kernel_launch: workspace too small: %zu < %zu\n", ws_size, (size_t)WS_END);
  }
  (void)hipMemsetAsync((unsigned char*)d_ws + O_BAR, 0, 16384, stream);
  Params p{};
  const float** pp = (const float**)&p;
  for (int i = 0; i < 23; ++i) pp[i] = (const float*)d_in[i];
  p.out = (float*)d_out; p.ws = (unsigned char*)d_ws;
  void* args[] = {&p};
  hipError_t e = hipLaunchCooperativeKernel((void*)mega, dim3(grid_blocks), dim3(512), args, LDS_BYTES, stream);
  if (e != hipSuccess) fprintf(stderr, "cooperative launch failed: %s (grid %d)\n", hipGetErrorString(e), grid_blocks);
}
```

```cpp
#include <hip/hip_runtime.h>
#include <hip/hip_bf16.h>
#include <hip/hip_cooperative_groups.h>
#include <cstdio>
namespace cg = cooperative_groups;

#define DEVI __device__ __forceinline__
typedef unsigned short u16;
using bf16x8 = __attribute__((ext_vector_type(8))) short;
using bf16x4 = __attribute__((ext_vector_type(4))) short;
using f32x4 = __attribute__((ext_vector_type(4))) float;

constexpr int DM = 1024, NB = 8, SEQ = 4096, MTOK = NB * SEQ, NL = 2;
constexpr int MH = MTOK / 2;
constexpr int INW = 9232;
constexpr int NPROJ = 9216;
constexpr int OFF_AQ = 0, OFF_AK = 768, OFF_AV = 1536, OFF_CONV = 2304, OFF_CQ = 2816, OFF_CK = 3072, OFF_CV = 3328,
              OFF_CR = 3840, OFF_DQ = 4352, OFF_DK = 4608, OFF_DV = 4864, OFF_GATE = 5120;
constexpr int BRW = 1280;
constexpr float EPS = 1e-6f;

constexpr size_t WT_IN = 0, WT_BR = (size_t)NPROJ * 1024, WT_OUT = WT_BR + 1024 * 1280, WT_UP = WT_OUT + 1024 * 1024,
                 WT_DOWN = WT_UP + 4096 * 1024, WT_LOW = WT_DOWN + 1024 * 4096, WT_L = WT_LOW + 16 * 1024;
constexpr size_t O_WT = 0;
constexpr size_t O_MODP = O_WT + 2 * WT_L * 2;
constexpr size_t O_MODF = O_MODP + (size_t)2 * 16 * 8 * 6144 * 4;
constexpr size_t O_LSE = O_MODF + (size_t)2 * 8 * 6144 * 4;
constexpr size_t O_GDEC = O_LSE + (size_t)MH * 12 * 4;
constexpr size_t O_H = O_GDEC + (size_t)1024 * 64 * 4;
constexpr size_t O_PROJ = O_H + (size_t)MH * 1024 * 2;
constexpr size_t O_BR = O_PROJ + (size_t)MH * NPROJ * 2;
constexpr size_t O_S = O_BR + (size_t)MH * BRW * 2;
constexpr size_t O_BAR = O_S + (size_t)1024 * 8192 * 4;
constexpr size_t O_C0 = O_BAR + 16384;
constexpr size_t O_GLOW = O_C0 + (size_t)16 * 2 * 16 * 64 * 4;
constexpr size_t WS_END = O_GLOW + (size_t)MH * 256 * 4;

constexpr int LDS_BYTES = 131072 + 16;
#ifndef PROBE
#define PROBE 0
#endif
#define PREP(bit) for (int _rep = 0; _rep < (((PROBE) >> (bit)) & 1) + 1; ++_rep)

struct Params {
  const float *x, *c, *w_ada, *b_ada, *g_mix, *w_in, *q_gain, *k_gain, *conv_w, *conv_b, *conv_ln_g, *conv_ln_b,
      *gla_w_gate, *gla_b_gate, *gla_o_gain, *w_br_a, *w_br_b, *w_br_c, *w_br_d, *w_out, *g_mlp, *w_up, *w_down;
  float* out;
  unsigned char* ws;
};

template <int OFF> DEVI const void* kptr() {
  unsigned long long r;
  auto ka = __builtin_amdgcn_kernarg_segment_ptr();
  asm volatile("s_load_dwordx2 %0, %1, %2\n\ts_waitcnt lgkmcnt(0)" : "=s"(r) : "s"(ka), "i"(OFF) : "memory");
  return (const void*)(__attribute__((address_space(1))) const void*)r;
}
#define KP(field) ((const float*)kptr<(int)offsetof(Params, field)>())
#define KWS() ((unsigned char*)kptr<(int)offsetof(Params, ws)>())
#define KOUT() ((float*)kptr<(int)offsetof(Params, out)>())

DEVI int otid(int wv) { int z = 0; asm volatile("" : "+v"(z)); int lane = __builtin_amdgcn_mbcnt_hi(-1, __builtin_amdgcn_mbcnt_lo(-1, z)); return wv * 64 + lane; }
DEVI int oblk() { int b = blockIdx.x; asm volatile("" : "+s"(b)); return b; }
DEVI int ogrd() { int g = gridDim.x; asm volatile("" : "+s"(g)); return g; }

DEVI float shfl_l(float v, int src) { return __int_as_float(__builtin_amdgcn_ds_bpermute(src << 2, __float_as_int(v))); }
DEVI float shfl_xor_l(float v, int k, int lane) { return shfl_l(v, lane ^ k); }
DEVI float shfl_up_l(float v, int d, int lane) { return shfl_l(v, lane >= d ? lane - d : lane); }

DEVI u16 f2bf(float f) { unsigned r; asm("v_cvt_pk_bf16_f32 %0, %1, %1" : "=v"(r) : "v"(f)); return (u16)(r & 0xffffu); }
DEVI float bf2f(u16 h) { return __uint_as_float(((unsigned)h) << 16); }
DEVI unsigned pk2(float a, float b) { unsigned r; asm("v_cvt_pk_bf16_f32 %0, %1, %2" : "=v"(r) : "v"(a), "v"(b)); return r; }
DEVI unsigned pk2_sw(float a, float b) {
  unsigned ua = __float_as_uint(a), ub = __float_as_uint(b);
  ua += 0x7fffu + ((ua >> 16) & 1u); ub += 0x7fffu + ((ub >> 16) & 1u);
  return (ua >> 16) | (ub & 0xffff0000u);
}
DEVI float bflo(unsigned u) { return __uint_as_float(u << 16); }
DEVI float bfhi(unsigned u) { return __uint_as_float(u & 0xffff0000u); }
DEVI float sigmoidf_(float x) { return 1.f / (1.f + __expf(-x)); }
DEVI float logsigf_(float z) { return fminf(z, 0.f) - __logf(1.f + __expf(-fabsf(z))); }
typedef unsigned u32x4_t __attribute__((ext_vector_type(4)));
DEVI bf16x8 mk8(uint2 lo, uint2 hi) { u32x4_t v = {lo.x, lo.y, hi.x, hi.y}; return __builtin_bit_cast(bf16x8, v); }
DEVI f32x4 mfma16(bf16x8 a, bf16x8 b, f32x4 c) { return __builtin_amdgcn_mfma_f32_16x16x32_bf16(a, b, c, 0, 0, 0); }

constexpr int BM = 256, BK = 64, HALF = 128, HT = HALF * BK;

DEVI int lds_byte(int r, int c) {
  int st = (r >> 4) * 2 + (c >> 5), rr = r & 15, cc = c & 31, ob = rr * 64 + cc * 2;
  return st * 1024 + (ob ^ (((ob >> 9) & 1) << 5));
}
DEVI void stage_rc(int b, int& R, int& C) {
  int st = b / 1024, sb = b % 1024, swz = sb ^ (((sb >> 9) & 1) << 5);
  R = (st >> 1) * 16 + swz / 64; C = (st & 1) * 32 + (swz % 64) / 2;
}

#define G_SA(b, h) (shm + ((b) * 2 + (h)) * HT)
#define G_SB(b, h) (shm + (4 + (b) * 2 + (h)) * HT)
#define G_STAGE(P, BASE, LD, br, kt) do { const u16* _p = (BASE) + (size_t)(br) * (size_t)(LD) + (size_t)(kt) * BK; \
    __builtin_amdgcn_global_load_lds((const unsigned*)(_p + soff0), (unsigned*)((char*)(P) + tid * 16), 16, 0, 0); \
    __builtin_amdgcn_global_load_lds((const unsigned*)(_p + soff1), (unsigned*)((char*)(P) + tid * 16 + 8192), 16, 0, 0); } while (0)
#define G_LDA(dst, b, h) for (int m = 0; m < 4; ++m) for (int k = 0; k < 2; ++k) \
    dst[m][k] = *reinterpret_cast<const bf16x8*>((char*)G_SA(b, h) + lds_byte(wr * 64 + m * 16 + fr, k * 32 + fq * 8))
#define G_LDB(dst, b, h) for (int n = 0; n < 2; ++n) for (int k = 0; k < 2; ++k) \
    dst[n][k] = *reinterpret_cast<const bf16x8*>((char*)G_SB(b, h) + ldsb_base + n * 256 + k * 1024)
#define G_MMA(ai, bj, At, Bf) do { __builtin_amdgcn_s_setprio(1); \
    for (int m = 0; m < 4; ++m) for (int n = 0; n < 2; ++n) for (int k = 0; k < 2; ++k) \
      acc[ai][bj][m][n] = __builtin_amdgcn_mfma_f32_16x16x32_bf16(Bf[n][k], At[m][k], acc[ai][bj][m][n], 0, 0, 0); \
    __builtin_amdgcn_s_setprio(0); } while (0)
#define G_WAIT_V(n) asm volatile("s_waitcnt vmcnt(" #n ")" ::: "memory")
#define G_WAIT_L(n) asm volatile("s_waitcnt lgkmcnt(" #n ")" ::: "memory")
#define G_BAR __builtin_amdgcn_s_barrier()
#define G_SCHED __builtin_amdgcn_sched_barrier(0)

template <int LD, class Epi>
DEVI void gemm_tile(int wv, u16* shm, const u16* A, const u16* Bt, int K, int brow, int bcol, const Epi& epi,
                    bool pre, bool has_next, int nshift, int nbrow, int nbcol) {
  constexpr int lda = LD, ldb = LD;
  const u16* nA = A + nshift; const u16* nB = Bt + nshift;
  const int tid = otid(wv);
  int wid = tid >> 6, lane = tid & 63, wr = wid >> 2, wc = wid & 3, fr = lane & 15, fq = lane >> 4;
  const int ldsb_base = lds_byte(wc * 32 + 8 * (fr >> 2) + (fr & 3), fq * 8);
  f32x4 acc[2][2][4][2] = {};
  bf16x8 At[4][2], B0[2][2], B1[2][2];
  int nt = K / BK;
  unsigned soff0, soff1;
  { int _r, _c; stage_rc(tid * 16, _r, _c); soff0 = (unsigned)(_r * lda + _c); stage_rc(tid * 16 + 8192, _r, _c); soff1 = (unsigned)(_r * lda + _c); }
  if (!pre) {
    G_STAGE(G_SB(0, 0), Bt, ldb, bcol, 0); G_STAGE(G_SA(0, 0), A, lda, brow, 0);
    G_STAGE(G_SB(0, 1), Bt, ldb, bcol + HALF, 0); G_STAGE(G_SA(0, 1), A, lda, brow + HALF, 0);
  }
  if (wr == 1) G_BAR;
  if (pre) { if (Epi::NSTORE == 32) { G_WAIT_V(36); } else { G_WAIT_V(20); } } else { G_WAIT_V(4); } G_BAR;
  G_STAGE(G_SB(1, 0), Bt, ldb, bcol, 1); G_STAGE(G_SA(1, 0), A, lda, brow, 1); G_STAGE(G_SB(1, 1), Bt, ldb, bcol + HALF, 1);
  if (pre) { if (Epi::NSTORE == 32) { G_WAIT_V(38); } else { G_WAIT_V(22); } } else { G_WAIT_V(6); } G_BAR;
  for (int t = 0; t < nt - 2; t += 2) {
    G_LDB(B0, 0, 0); G_SCHED; G_LDA(At, 0, 0); G_STAGE(G_SA(1, 1), A, lda, brow + HALF, t + 1);
    G_WAIT_L(8); G_BAR; G_WAIT_L(0); G_MMA(0, 0, At, B0); G_BAR; G_SCHED;
    G_LDB(B1, 0, 1); G_STAGE(G_SB(0, 0), Bt, ldb, bcol, t + 2);
    G_BAR; G_WAIT_L(0); G_MMA(0, 1, At, B1); G_BAR;
    G_LDA(At, 0, 1); G_STAGE(G_SA(0, 0), A, lda, brow, t + 2);
    G_BAR; G_WAIT_L(0); G_MMA(1, 0, At, B0); G_BAR; G_SCHED;
    G_STAGE(G_SB(0, 1), Bt, ldb, bcol + HALF, t + 2);
    G_WAIT_V(6); G_BAR; G_MMA(1, 1, At, B1); G_BAR;
    G_LDB(B0, 1, 0); G_SCHED; G_LDA(At, 1, 0); G_STAGE(G_SA(0, 1), A, lda, brow + HALF, t + 2);
    G_WAIT_L(8); G_BAR; G_WAIT_L(0); G_MMA(0, 0, At, B0); G_BAR; G_SCHED;
    G_LDB(B1, 1, 1); G_STAGE(G_SB(1, 0), Bt, ldb, bcol, t + 3);
    G_BAR; G_WAIT_L(0); G_MMA(0, 1, At, B1); G_BAR;
    G_LDA(At, 1, 1); G_STAGE(G_SA(1, 0), A, lda, brow, t + 3);
    G_BAR; G_WAIT_L(0); G_MMA(1, 0, At, B0); G_BAR; G_SCHED;
    G_STAGE(G_SB(1, 1), Bt, ldb, bcol + HALF, t + 3);
    G_WAIT_V(6); G_BAR; G_MMA(1, 1, At, B1); G_BAR;
  }
  { G_LDB(B0, 0, 0); G_LDA(At, 0, 0); G_STAGE(G_SA(1, 1), A, lda, brow + HALF, nt - 1);
    G_BAR; G_WAIT_L(0); G_MMA(0, 0, At, B0); G_BAR;
    G_LDB(B1, 0, 1); G_BAR; G_WAIT_L(0); G_MMA(0, 1, At, B1); G_BAR;
    G_LDA(At, 0, 1); G_WAIT_V(4); G_BAR; G_WAIT_L(0); G_MMA(1, 0, At, B0); G_MMA(1, 1, At, B1); G_BAR; }
  { G_LDB(B0, 1, 0); G_LDA(At, 1, 0); G_WAIT_V(2); G_BAR;
    if (has_next) {
      G_STAGE(G_SB(0, 0), nB, ldb, nbcol, 0); G_STAGE(G_SA(0, 0), nA, lda, nbrow, 0);
      G_STAGE(G_SB(0, 1), nB, ldb, nbcol + HALF, 0); G_STAGE(G_SA(0, 1), nA, lda, nbrow + HALF, 0);
    }
    G_WAIT_L(0); G_MMA(0, 0, At, B0); G_BAR;
    G_LDB(B1, 1, 1); if (has_next) { G_WAIT_V(8); } else { G_WAIT_V(0); } G_BAR; G_WAIT_L(0); G_MMA(0, 1, At, B1); G_BAR;
    G_LDA(At, 1, 1); G_BAR; G_WAIT_L(0); G_MMA(1, 0, At, B0); G_MMA(1, 1, At, B1); G_BAR; }
  if (wr == 0) G_BAR;
  epi(acc, brow, bcol, wr, wc, fr, fq);
}

struct EpiBf16 {
  static constexpr int NSTORE = 16;
  u16* C; int ldc; int relu2;
  DEVI void operator()(const f32x4 (&acc)[2][2][4][2], int brow, int bcol, int wr, int wc, int fr, int fq) const {
#pragma unroll
    for (int ai = 0; ai < 2; ++ai)
#pragma unroll
      for (int bj = 0; bj < 2; ++bj)
#pragma unroll
        for (int m = 0; m < 4; ++m) {
          int row = brow + ai * HALF + wr * 64 + m * 16 + fr, col = bcol + bj * HALF + wc * 32 + fq * 8;
          f32x4 v0 = acc[ai][bj][m][0], v1 = acc[ai][bj][m][1];
          if (relu2) {
#pragma unroll
            for (int j = 0; j < 4; ++j) { float t0 = fmaxf(v0[j], 0.f), t1 = fmaxf(v1[j], 0.f); v0[j] = t0 * t0; v1[j] = t1 * t1; }
          }
          uint4 o; o.x = pk2(v0[0], v0[1]); o.y = pk2(v0[2], v0[3]); o.z = pk2(v1[0], v1[1]); o.w = pk2(v1[2], v1[3]);
          *(uint4*)(C + (size_t)row * ldc + col) = o;
        }
  }
};
struct EpiGate {
  const u16* G; int gcol0; u16* Mg; int first;
  DEVI void operator()(const f32x4 (&acc)[2][2][4][2], int brow, int bcol, int wr, int wc, int fr, int fq) const {
#pragma unroll
    for (int ai = 0; ai < 2; ++ai)
#pragma unroll
      for (int bj = 0; bj < 2; ++bj)
#pragma unroll
      for (int mh = 0; mh < 2; ++mh) {
        uint2 g[4][2], o[4][2];
#pragma unroll
        for (int m = 2 * mh; m < 2 * mh + 2; ++m)
#pragma unroll
          for (int n = 0; n < 2; ++n) {
            int row = brow + ai * HALF + wr * 64 + m * 16 + fr, col = bcol + bj * HALF + wc * 32 + n * 16 + fq * 4;
            g[m][n] = *(const uint2*)(G + (size_t)row * NPROJ + gcol0 + col);
            if (!first) o[m][n] = *(const uint2*)(Mg + (size_t)row * 1024 + col);
          }
#pragma unroll
        for (int m = 2 * mh; m < 2 * mh + 2; ++m)
#pragma unroll
          for (int n = 0; n < 2; ++n) {
            int row = brow + ai * HALF + wr * 64 + m * 16 + fr, col = bcol + bj * HALF + wc * 32 + n * 16 + fq * 4;
            f32x4 v = acc[ai][bj][m][n];
            float r0 = v[0] * sigmoidf_(bflo(g[m][n].x)), r1 = v[1] * sigmoidf_(bfhi(g[m][n].x)), r2 = v[2] * sigmoidf_(bflo(g[m][n].y)), r3 = v[3] * sigmoidf_(bfhi(g[m][n].y));
            if (!first) { r0 += bflo(o[m][n].x); r1 += bfhi(o[m][n].x); r2 += bflo(o[m][n].y); r3 += bfhi(o[m][n].y); }
            uint2 o2; o2.x = pk2(r0, r1); o2.y = pk2(r2, r3);
            *(uint2*)(Mg + (size_t)row * 1024 + col) = o2;
          }
      }
  }
};
struct EpiRes {
  const float* xin; float* xout; const float* gate; int row0;
  static constexpr int NSTORE = 32;
  DEVI void load_batch(int q, float4 (&xi)[2][2], int brow, int bcol, int wr, int wc, int fr, int fq) const {
    const int ai = q >> 2, bj = (q >> 1) & 1, mh = q & 1, col = bcol + bj * HALF + wc * 32 + fq * 8;
#pragma unroll
    for (int mm = 0; mm < 2; ++mm) {
      const int row = row0 + brow + ai * HALF + wr * 64 + (2 * mh + mm) * 16 + fr;
      xi[mm][0] = *(const float4*)(xin + (size_t)row * 1024 + col); xi[mm][1] = *(const float4*)(xin + (size_t)row * 1024 + col + 4);
    }
  }
  DEVI void operator()(const f32x4 (&acc)[2][2][4][2], int brow, int bcol, int wr, int wc, int fr, int fq) const {
    const int b = (row0 + brow) >> 12;
    float4 gt[2][2];
#pragma unroll
    for (int bj = 0; bj < 2; ++bj) {
      const int col = bcol + bj * HALF + wc * 32 + fq * 8;
      gt[bj][0] = *(const float4*)(gate + (size_t)b * 6144 + col); gt[bj][1] = *(const float4*)(gate + (size_t)b * 6144 + col + 4);
    }
    float4 xa[2][2], xb[2][2];
    load_batch(0, xa, brow, bcol, wr, wc, fr, fq);
#pragma unroll
    for (int q = 0; q < 8; ++q) {
      const int ai = q >> 2, bj = (q >> 1) & 1, mh = q & 1, col = bcol + bj * HALF + wc * 32 + fq * 8;
      if (q + 1 < 8) { if (q & 1) load_batch(q + 1, xa, brow, bcol, wr, wc, fr, fq); else load_batch(q + 1, xb, brow, bcol, wr, wc, fr, fq); }
#pragma unroll
      for (int mm = 0; mm < 2; ++mm) {
        const int row = row0 + brow + ai * HALF + wr * 64 + (2 * mh + mm) * 16 + fr;
#pragma unroll
        for (int n = 0; n < 2; ++n) {
          const f32x4 v = acc[ai][bj][2 * mh + mm][n];
          const float4 xv = (q & 1) ? xb[mm][n] : xa[mm][n];
          float4 o; o.x = xv.x + gt[bj][n].x * v[0]; o.y = xv.y + gt[bj][n].y * v[1]; o.z = xv.z + gt[bj][n].z * v[2]; o.w = xv.w + gt[bj][n].w * v[3];
          *(float4*)(xout + (size_t)row * 1024 + col + 4 * n) = o;
        }
      }
    }
  }
};

template <int LD, class Epi>
DEVI void gemm_phase(int wv, u16* shm, const u16* A, const u16* Bt, int Mrows, int N, int K, const Epi& epi) {
  int nM = Mrows / BM, nN = N / BM, ntiles = nM * nN;
  int G = ogrd(), b = oblk();
  int vb = (G % 8 == 0) ? (b % 8) * (G / 8) + b / 8 : b;
  const int nig = 8 * nN;
  bool pre = false;
  for (int base = 0; base < ntiles; base += G) {
    int id = base + vb;
    if (id >= ntiles) break;
    int gid = id / nig, rem = id % nig, pm = gid * 8 + rem % 8, pn = rem / 8;
    int nid = id + G; bool has_next = nid < ntiles;
    int ngid = nid / nig, nrem = nid % nig, npm = ngid * 8 + nrem % 8, npn = nrem / 8;
    gemm_tile<LD>(wv, shm, A, Bt, K, pm * BM, pn * BM, epi, pre, has_next, 0, npm * BM, npn * BM);
    pre = has_next;
    if (has_next) { G_BAR; } else { __syncthreads(); }
  }
}

#define BR_LDB(dst, b, h) for (int n = 0; n < 2; ++n) for (int k = 0; k < 2; ++k) \
    dst[n][k] = *reinterpret_cast<const bf16x8*>((char*)G_SB(b, h) + ldsb_base + n * 256 + k * 1024)
DEVI void branch_phase(int wv, u16* shm, const u16* br, const u16* WbrT, const u16* G, u16* Mg) {
  const int tid = otid(wv);
  const int wid = tid >> 6, lane = tid & 63, wr = wid >> 2, wc = wid & 3, fr = lane & 15, fq = lane >> 4;
  constexpr int lda = BRW, ldb = BRW;
  unsigned soff0, soff1;
  { int _r, _c; stage_rc(tid * 16, _r, _c); soff0 = (unsigned)(_r * BRW + _c); stage_rc(tid * 16 + 8192, _r, _c); soff1 = (unsigned)(_r * BRW + _c); }
  const unsigned goff = (unsigned)((wr * 64 + fr) * NPROJ + wc * 32 + fq * 8), moff = (unsigned)((wr * 64 + fr) * 1024 + wc * 32 + fq * 8);
  const int ldsb_base = lds_byte(wc * 32 + 8 * (fr >> 2) + (fr & 3), fq * 8);
  const int Gd = ogrd();
  for (int tile = oblk(); tile < (MH / 128) * 4; tile += Gd) {
    const int pm = tile >> 2, pn = tile & 3, brow = pm * 128, bcol = pn * 256;
    f32x4 mg[2][4][2];
#pragma unroll
    for (int bj = 0; bj < 2; ++bj)
#pragma unroll
      for (int m = 0; m < 4; ++m)
#pragma unroll
        for (int n = 0; n < 2; ++n) mg[bj][m][n] = (f32x4){0.f, 0.f, 0.f, 0.f};
    for (int i = 0; i < 4; ++i) {
      const int koff = (i == 3) ? 1024 : i * 256, nt = (i == 2) ? 8 : 4;
      const u16* A = br + koff; const u16* Bt = WbrT + koff;
      f32x4 acc[2][4][2];
#pragma unroll
      for (int bj = 0; bj < 2; ++bj)
#pragma unroll
        for (int m = 0; m < 4; ++m)
#pragma unroll
          for (int n = 0; n < 2; ++n) acc[bj][m][n] = (f32x4){0.f, 0.f, 0.f, 0.f};
      G_STAGE(G_SA(0, 0), A, lda, brow, 0); G_STAGE(G_SB(0, 0), Bt, ldb, bcol, 0); G_STAGE(G_SB(0, 1), Bt, ldb, bcol + HALF, 0);
      for (int kt = 0; kt < nt; ++kt) {
        const int b = kt & 1;
        if (kt + 1 < nt) {
          if (b) { G_STAGE(G_SA(0, 0), A, lda, brow, kt + 1); G_STAGE(G_SB(0, 0), Bt, ldb, bcol, kt + 1); G_STAGE(G_SB(0, 1), Bt, ldb, bcol + HALF, kt + 1); }
          else   { G_STAGE(G_SA(1, 0), A, lda, brow, kt + 1); G_STAGE(G_SB(1, 0), Bt, ldb, bcol, kt + 1); G_STAGE(G_SB(1, 1), Bt, ldb, bcol + HALF, kt + 1); }
          G_WAIT_V(6);
        } else { G_WAIT_V(0); }
        G_BAR;
        bf16x8 At[4][2], B0[2][2];
        if (b) { G_LDA(At, 1, 0); BR_LDB(B0, 1, 0); } else { G_LDA(At, 0, 0); BR_LDB(B0, 0, 0); }
        G_WAIT_L(0);
        __builtin_amdgcn_s_setprio(1);
#pragma unroll
        for (int m = 0; m < 4; ++m)
#pragma unroll
          for (int n = 0; n < 2; ++n)
#pragma unroll
            for (int k = 0; k < 2; ++k) acc[0][m][n] = __builtin_amdgcn_mfma_f32_16x16x32_bf16(B0[n][k], At[m][k], acc[0][m][n], 0, 0, 0);
        __builtin_amdgcn_s_setprio(0);
        if (b) { BR_LDB(B0, 1, 1); } else { BR_LDB(B0, 0, 1); }
        G_WAIT_L(0);
        __builtin_amdgcn_s_setprio(1);
#pragma unroll
        for (int m = 0; m < 4; ++m)
#pragma unroll
          for (int n = 0; n < 2; ++n)
#pragma unroll
            for (int k = 0; k < 2; ++k) acc[1][m][n] = __builtin_amdgcn_mfma_f32_16x16x32_bf16(B0[n][k], At[m][k], acc[1][m][n], 0, 0, 0);
        __builtin_amdgcn_s_setprio(0);
        G_BAR;
      }
#pragma unroll
      for (int bj = 0; bj < 2; ++bj) {
        uint4 g[4];
#pragma unroll
        for (int m = 0; m < 4; ++m) {
          const u16* gp = G + (size_t)(brow + m * 16) * NPROJ + OFF_GATE + i * 1024 + bcol + bj * HALF;
          g[m] = *(const uint4*)(gp + goff);
        }
#pragma unroll
        for (int m = 0; m < 4; ++m) {
          const uint4 gv = g[m];
          mg[bj][m][0][0] += acc[bj][m][0][0] * sigmoidf_(bflo(gv.x)); mg[bj][m][0][1] += acc[bj][m][0][1] * sigmoidf_(bfhi(gv.x));
          mg[bj][m][0][2] += acc[bj][m][0][2] * sigmoidf_(bflo(gv.y)); mg[bj][m][0][3] += acc[bj][m][0][3] * sigmoidf_(bfhi(gv.y));
          mg[bj][m][1][0] += acc[bj][m][1][0] * sigmoidf_(bflo(gv.z)); mg[bj][m][1][1] += acc[bj][m][1][1] * sigmoidf_(bfhi(gv.z));
          mg[bj][m][1][2] += acc[bj][m][1][2] * sigmoidf_(bflo(gv.w)); mg[bj][m][1][3] += acc[bj][m][1][3] * sigmoidf_(bfhi(gv.w));
        }
      }
    }
#pragma unroll
    for (int bj = 0; bj < 2; ++bj)
#pragma unroll
      for (int m = 0; m < 4; ++m) {
        u16* mp = Mg + (size_t)(brow + m * 16) * 1024 + bcol + bj * HALF;
        uint4 o; o.x = pk2(mg[bj][m][0][0], mg[bj][m][0][1]); o.y = pk2(mg[bj][m][0][2], mg[bj][m][0][3]);
        o.z = pk2(mg[bj][m][1][0], mg[bj][m][1][1]); o.w = pk2(mg[bj][m][1][2], mg[bj][m][1][3]);
        *(uint4*)(mp + moff) = o;
      }
  }
}
#undef BR_LDB

DEVI void transpose_tile(int wv, const float* src, int lds_, int col0, int k0, u16* dst, int ldd, int drow0, int dk0, float* sm) {
  const int t = otid(wv);
  {
    const int k = t >> 4, n4 = (t & 15) * 4;
    float4 a = *(const float4*)(src + (size_t)(k0 + k) * lds_ + col0 + n4);
    float4 b = *(const float4*)(src + (size_t)(k0 + 32 + k) * lds_ + col0 + n4);
    float* p = sm + k * 65 + n4; p[0] = a.x; p[1] = a.y; p[2] = a.z; p[3] = a.w;
    p += 32 * 65; p[0] = b.x; p[1] = b.y; p[2] = b.z; p[3] = b.w;
  }
  __syncthreads();
  {
    const int n = t >> 3, kc = (t & 7) * 8;
    const float* p = sm + kc * 65 + n;
    uint4 o; o.x = pk2(p[0], p[65]); o.y = pk2(p[2 * 65], p[3 * 65]); o.z = pk2(p[4 * 65], p[5 * 65]); o.w = pk2(p[6 * 65], p[7 * 65]);
    *(uint4*)(dst + (size_t)(drow0 + n) * ldd + dk0 + kc) = o;
  }
  __syncthreads();
}

DEVI void prep_phase(int wv, unsigned char* smem) {
  float* sm = (float*)smem;
  u16* WT = (u16*)(KWS() + O_WT);
  constexpr int T1 = 16 * 68, T2 = 16 * 76, T3 = 64, T4 = 64, T5 = 128, T6 = 64, T7 = 256, T8 = 1024, T9 = 1024;
  constexpr int TL = T1 + T2 + T3 + T4 + T5 + T6 + T7 + T8 + T9;
  for (int it = oblk(); it < 2 * TL; it += ogrd()) {
    int l = it / TL, r = it % TL;
    u16* W = WT + (size_t)l * WT_L;
    if (r < T1) { int kt = r / 68, nt = r % 68; transpose_tile(wv, KP(w_in) + (size_t)l * 1024 * INW, INW, nt * 64, kt * 64, W + WT_IN, 1024, nt * 64, kt * 64, sm); continue; } r -= T1;
    if (r < T2) { int kt = r / 76, nt = r % 76; transpose_tile(wv, KP(w_in) + (size_t)l * 1024 * INW, INW, 4368 + nt * 64, kt * 64, W + WT_IN, 1024, 4352 + nt * 64, kt * 64, sm); continue; } r -= T2;
    if (r < T3) { int kt = r / 16, nt = r % 16; transpose_tile(wv, KP(w_br_a) + (size_t)l * 256 * 1024, 1024, nt * 64, kt * 64, W + WT_BR, BRW, nt * 64, 0 + kt * 64, sm); continue; } r -= T3;
    if (r < T4) { int kt = r / 16, nt = r % 16; transpose_tile(wv, KP(w_br_b) + (size_t)l * 256 * 1024, 1024, nt * 64, kt * 64, W + WT_BR, BRW, nt * 64, 256 + kt * 64, sm); continue; } r -= T4;
    if (r < T5) { int kt = r / 16, nt = r % 16; transpose_tile(wv, KP(w_br_c) + (size_t)l * 512 * 1024, 1024, nt * 64, kt * 64, W + WT_BR, BRW, nt * 64, 512 + kt * 64, sm); continue; } r -= T5;
    if (r < T6) { int kt = r / 16, nt = r % 16; transpose_tile(wv, KP(w_br_d) + (size_t)l * 256 * 1024, 1024, nt * 64, kt * 64, W + WT_BR, BRW, nt * 64, 1024 + kt * 64, sm); continue; } r -= T6;
    if (r < T7) { int kt = r / 16, nt = r % 16; transpose_tile(wv, KP(w_out) + (size_t)l * 1024 * 1024, 1024, nt * 64, kt * 64, W + WT_OUT, 1024, nt * 64, kt * 64, sm); continue; } r -= T7;
    if (r < T8) { int kt = r / 64, nt = r % 64; transpose_tile(wv, KP(w_up) + (size_t)l * 1024 * 4096, 4096, nt * 64, kt * 64, W + WT_UP, 1024, nt * 64, kt * 64, sm); continue; } r -= T8;
    { int kt = r / 16, nt = r % 16; transpose_tile(wv, KP(w_down) + (size_t)l * 4096 * 1024, 1024, nt * 64, kt * 64, W + WT_DOWN, 4096, nt * 64, kt * 64, sm); }
  }
  long gtid = (long)oblk() * 512 + otid(wv), gsz = (long)ogrd() * 512;
  for (long idx = gtid; idx < 2L * 16 * 1024; idx += gsz) {
    int l = (int)(idx >> 14), r = (int)((idx >> 10) & 15), k = (int)(idx & 1023);
    WT[(size_t)l * WT_L + WT_LOW + (size_t)r * 1024 + k] = f2bf(KP(w_in)[(size_t)l * 1024 * INW + (size_t)k * INW + 4352 + r]);
  }
  float* modp = (float*)(KWS() + O_MODP);
  const float* cvec = KP(c);
  for (int it = oblk(); it < 2 * 16 * 12; it += ogrd()) {
    int l = it / 192, kp = (it / 12) % 16, cgp = it % 12;
    int j = cgp * 512 + otid(wv);
    float a[8];
#pragma unroll
    for (int b = 0; b < 8; ++b) a[b] = 0.f;
    const float* w = KP(w_ada) + (size_t)l * 1024 * 6144 + (size_t)(kp * 64) * 6144 + j;
    for (int k = 0; k < 64; ++k) {
      float wv = w[(size_t)k * 6144];
#pragma unroll
      for (int b = 0; b < 8; ++b) a[b] += cvec[b * 1024 + kp * 64 + k] * wv;
    }
#pragma unroll
    for (int b = 0; b < 8; ++b) modp[(((size_t)l * 16 + kp) * 8 + b) * 6144 + j] = a[b];
  }
}

DEVI void modfinal_phase(int wv) {
  long gtid = (long)oblk() * 512 + otid(wv), gsz = (long)ogrd() * 512;
  unsigned char* ws_ = KWS();
  const float* modp = (const float*)(ws_ + O_MODP);
  float* modf = (float*)(ws_ + O_MODF);
  for (long idx = gtid; idx < 2L * 8 * 1024; idx += gsz) {
    int l = (int)(idx >> 13), b = (int)((idx >> 10) & 7), col = (int)(idx & 1023);
    float v[6];
#pragma unroll
    for (int s = 0; s < 6; ++s) {
      float a = KP(b_ada)[l * 6144 + s * 1024 + col];
      for (int kp = 0; kp < 16; ++kp) a += modp[(((size_t)l * 16 + kp) * 8 + b) * 6144 + s * 1024 + col];
      v[s] = a;
    }
    float* o = modf + ((size_t)l * 8 + b) * 6144 + col;
    o[0] = KP(g_mix)[l * 1024 + col] * (1.f + v[1]); o[1024] = v[0]; o[2048] = v[2];
    o[3072] = KP(g_mlp)[l * 1024 + col] * (1.f + v[4]); o[4096] = v[3]; o[5120] = v[5];
  }
}

DEVI void norm_phase(int wv, const float* xsrc, int row0, int nrows, const float* modl  , int slot, u16* hout) {
  const int tid = otid(wv); int wave = tid >> 6, lane = tid & 63;
  int gw = oblk() * 8 + wave, NGW = ogrd() * 8;
  for (int r0 = gw * 8; r0 < nrows; r0 += NGW * 8) {
    float4 v[8][4];
#pragma unroll
    for (int q = 0; q < 8; ++q) {
      const float4* xr = (const float4*)(xsrc + (size_t)(row0 + r0 + q) * 1024);
#pragma unroll
      for (int j = 0; j < 4; ++j) v[q][j] = xr[lane + 64 * j];
    }
    const int b = (row0 + r0) >> 12;
    const float4* sc = (const float4*)(modl + (size_t)b * 6144 + slot * 1024);
    const float4* sh = (const float4*)(modl + (size_t)b * 6144 + (slot + 1) * 1024);
    float4 s4[4], h4[4];
#pragma unroll
    for (int j = 0; j < 4; ++j) { s4[j] = sc[lane + 64 * j]; h4[j] = sh[lane + 64 * j]; }
#pragma unroll
    for (int q = 0; q < 8; ++q) {
      float ss = 0.f;
#pragma unroll
      for (int j = 0; j < 4; ++j) ss += v[q][j].x * v[q][j].x + v[q][j].y * v[q][j].y + v[q][j].z * v[q][j].z + v[q][j].w * v[q][j].w;
#pragma unroll
      for (int o = 1; o < 64; o <<= 1) ss += shfl_xor_l(ss, o, lane);
      const float rs = rsqrtf(ss * (1.f / 1024.f) + EPS);
      uint2* o2 = (uint2*)(hout + (size_t)(r0 + q) * 1024);
#pragma unroll
      for (int j = 0; j < 4; ++j) {
        uint2 o; o.x = pk2(v[q][j].x * rs * s4[j].x + h4[j].x, v[q][j].y * rs * s4[j].y + h4[j].y);
        o.y = pk2(v[q][j].z * rs * s4[j].z + h4[j].z, v[q][j].w * rs * s4[j].w + h4[j].w);
        o2[lane + 64 * j] = o;
      }
    }
  }
}

DEVI void glow_phase(int wv, int l, const u16* hbuf, const u16* WlowT, float* xgout) {
  const int tid = otid(wv), w = tid >> 6, lane = tid & 63, fr = lane & 15, fq = lane >> 4;
  const float* wg = KP(gla_w_gate) + (size_t)l * 16 * 256; const float* bg = KP(gla_b_gate) + l * 256;
  for (int u = oblk() * 8 + w; u < MH / 16; u += ogrd() * 8) {
    const u16* ap = WlowT + (size_t)fr * 1024 + fq * 8;
    const u16* bp = hbuf + (size_t)(u * 16 + fr) * 1024 + fq * 8;
    f32x4 acc = {0.f, 0.f, 0.f, 0.f};
#pragma unroll 8
    for (int ks = 0; ks < 32; ++ks) acc = mfma16(*(const bf16x8*)(ap + ks * 32), *(const bf16x8*)(bp + ks * 32), acc);
    u32x4_t pbu = {pk2_sw(acc[0], acc[1]), pk2_sw(acc[2], acc[3]), 0u, 0u};
    const bf16x8 pb = __builtin_bit_cast(bf16x8, pbu);
    float* orow = xgout + (size_t)(u * 16 + fr) * 256 + fq * 4;
#pragma unroll
    for (int nt = 0; nt < 16; ++nt) {
      const float* wp = wg + (size_t)(fq * 4) * 256 + nt * 16 + fr;
      u32x4_t pau = {pk2_sw(wp[0], wp[256]), pk2_sw(wp[512], wp[768]), 0u, 0u};
      f32x4 d = mfma16(__builtin_bit_cast(bf16x8, pau), pb, (f32x4){0.f, 0.f, 0.f, 0.f});
      const float4 bb = *(const float4*)(bg + nt * 16 + fq * 4);
      *(float4*)(orow + nt * 16) = make_float4(d[0] + bb.x, d[1] + bb.y, d[2] + bb.z, d[3] + bb.w);
    }
  }
}

struct MixCtx { int wv; int l; int hf; u16* proj; u16* br; float* lse; float* S; float* gdec; float* glow; };
DEVI MixCtx make_ctx(int wv, int l, int hf) { unsigned char* ws = KWS(); MixCtx c; c.wv = wv; c.l = l; c.hf = hf; c.proj = (u16*)(ws + O_PROJ); c.br = (u16*)(ws + O_BR); c.lse = (float*)(ws + O_LSE); c.S = (float*)(ws + O_S); c.gdec = (float*)(ws + O_GDEC); c.glow = (float*)(ws + O_GLOW); return c; }

DEVI void unpack8(uint4 r, float (&v)[8]) {
  v[0] = bflo(r.x); v[1] = bfhi(r.x); v[2] = bflo(r.y); v[3] = bfhi(r.y); v[4] = bflo(r.z); v[5] = bfhi(r.z); v[6] = bflo(r.w); v[7] = bfhi(r.w);
}

DEVI void dswa_item(const MixCtx& c, int item, unsigned char* smem, bool do_store = true, bool stage_only = false) {
  const int tid = otid(c.wv), w = tid >> 6, lane = tid & 63, fr = lane & 15, fq = lane >> 4;
  int blk = item & 31, h = (item >> 5) & 3, gb = item >> 7, g = gb % 3, bl = gb / 3;
  int d = (g == 0) ? 1 : (g == 1 ? 4 : 16), nbr = 32 / d, r = blk / nbr, nbi = blk % nbr;
  u16* Qs = (u16*)smem; u16* Ks = Qs + 128 * 72; u16* VT = Ks + 256 * 72;
  u16* pj = c.proj + (size_t)bl * 4096 * NPROJ;
  const float* qg = KP(q_gain) + c.l * 64; const float* kg = KP(k_gain) + c.l * 64;
#pragma unroll
  for (int i = 0; i < 2; ++i) {
    int ci = tid + 512 * i, row = ci >> 3, ch = ci & 7, tok = (nbi * 128 + row) * d + r;
    uint4 raw = *(const uint4*)(pj + (size_t)tok * NPROJ + OFF_AQ + g * 256 + h * 64 + ch * 8);
    float v[8]; unpack8(raw, v);
    float ss = 0.f;
#pragma unroll
    for (int j = 0; j < 8; ++j) ss += v[j] * v[j];
    ss += shfl_xor_l(ss, 1, lane); ss += shfl_xor_l(ss, 2, lane); ss += shfl_xor_l(ss, 4, lane);
    float sc = rsqrtf(ss * (1.f / 64.f) + EPS);
    uint4 o; o.x = pk2(v[0] * sc * qg[ch * 8 + 0], v[1] * sc * qg[ch * 8 + 1]); o.y = pk2(v[2] * sc * qg[ch * 8 + 2], v[3] * sc * qg[ch * 8 + 3]);
    o.z = pk2(v[4] * sc * qg[ch * 8 + 4], v[5] * sc * qg[ch * 8 + 5]); o.w = pk2(v[6] * sc * qg[ch * 8 + 6], v[7] * sc * qg[ch * 8 + 7]);
    *(uint4*)(Qs + row * 72 + ch * 8) = o;
  }
#pragma unroll
  for (int i = 0; i < 4; ++i) {
    int ci = tid + 512 * i, row = ci >> 3, ch = ci & 7, sub = (nbi - 1) * 128 + row;
    bool ok = sub >= 0; int tok = ok ? sub * d + r : 0;
    uint4 raw = *(const uint4*)(pj + (size_t)tok * NPROJ + OFF_AK + g * 256 + h * 64 + ch * 8);
    uint4 rv = *(const uint4*)(pj + (size_t)tok * NPROJ + OFF_AV + g * 256 + h * 64 + ch * 8);
    if (!ok) { raw = make_uint4(0, 0, 0, 0); rv = raw; }
    float v[8]; unpack8(raw, v);
    float ss = 0.f;
#pragma unroll
    for (int j = 0; j < 8; ++j) ss += v[j] * v[j];
    ss += shfl_xor_l(ss, 1, lane); ss += shfl_xor_l(ss, 2, lane); ss += shfl_xor_l(ss, 4, lane);
    float sc = rsqrtf(ss * (1.f / 64.f) + EPS);
    uint4 o; o.x = pk2(v[0] * sc * kg[ch * 8 + 0], v[1] * sc * kg[ch * 8 + 1]); o.y = pk2(v[2] * sc * kg[ch * 8 + 2], v[3] * sc * kg[ch * 8 + 3]);
    o.z = pk2(v[4] * sc * kg[ch * 8 + 4], v[5] * sc * kg[ch * 8 + 5]); o.w = pk2(v[6] * sc * kg[ch * 8 + 6], v[7] * sc * kg[ch * 8 + 7]);
    *(uint4*)(Ks + row * 72 + ch * 8) = o;
    u16* vt = VT + (ch * 8) * 264 + row;
    vt[0 * 264] = (u16)(rv.x & 0xffff); vt[1 * 264] = (u16)(rv.x >> 16); vt[2 * 264] = (u16)(rv.y & 0xffff); vt[3 * 264] = (u16)(rv.y >> 16);
    vt[4 * 264] = (u16)(rv.z & 0xffff); vt[5 * 264] = (u16)(rv.z >> 16); vt[6 * 264] = (u16)(rv.w & 0xffff); vt[7 * 264] = (u16)(rv.w >> 16);
  }
  __syncthreads();
  if (stage_only) return;
  bf16x8 qf[2];
#pragma unroll
  for (int ks = 0; ks < 2; ++ks) qf[ks] = *(const bf16x8*)(Qs + (16 * w + fr) * 72 + ks * 32 + fq * 8);
  const int pair0 = w >> 1;
  f32x4 st[5][2];
#pragma unroll
  for (int s5 = 0; s5 < 5; ++s5)
#pragma unroll
    for (int sub = 0; sub < 2; ++sub) {
      f32x4 a = {0.f, 0.f, 0.f, 0.f};
      int kb = 32 * (pair0 + s5) + 16 * sub;
#pragma unroll
      for (int ks = 0; ks < 2; ++ks) a = mfma16(*(const bf16x8*)(Ks + (kb + fr) * 72 + ks * 32 + fq * 8), qf[ks], a);
      st[s5][sub] = a;
    }
  const float slope_d = exp2f(-8.f * (float)(g * 4 + h + 1) / 12.f) * (float)d;
  const int qi = 16 * w + fr;
  float mx = -3.0e38f;
#pragma unroll
  for (int s5 = 0; s5 < 5; ++s5)
#pragma unroll
    for (int sub = 0; sub < 2; ++sub)
#pragma unroll
      for (int j = 0; j < 4; ++j) {
        int kb = 32 * (pair0 + s5) + 16 * sub + 4 * fq + j, rel = 128 + qi - kb;
        bool ok = (rel >= 0) && (rel <= 128) && (nbi > 0 || kb >= 128);
        float s = st[s5][sub][j] * 0.125f - slope_d * (float)rel;
        s = ok ? s : -3.0e38f;
        st[s5][sub][j] = s; mx = fmaxf(mx, s);
      }
  mx = fmaxf(mx, shfl_xor_l(mx, 16, lane)); mx = fmaxf(mx, shfl_xor_l(mx, 32, lane));
  float den = 0.f;
#pragma unroll
  for (int s5 = 0; s5 < 5; ++s5)
#pragma unroll
    for (int sub = 0; sub < 2; ++sub)
#pragma unroll
      for (int j = 0; j < 4; ++j) {
        float s = st[s5][sub][j];
        float pv = (s > -1.0e38f) ? __expf(s - mx) : 0.f;
        st[s5][sub][j] = pv; den += pv;
      }
  den += shfl_xor_l(den, 16, lane); den += shfl_xor_l(den, 32, lane);
  f32x4 ot[4];
#pragma unroll
  for (int et = 0; et < 4; ++et) ot[et] = (f32x4){0.f, 0.f, 0.f, 0.f};
#pragma unroll
  for (int s5 = 0; s5 < 5; ++s5) {
    union { bf16x8 v; unsigned u[4]; } pb;
    pb.u[0] = pk2_sw(st[s5][0][0], st[s5][0][1]); pb.u[1] = pk2_sw(st[s5][0][2], st[s5][0][3]);
    pb.u[2] = pk2_sw(st[s5][1][0], st[s5][1][1]); pb.u[3] = pk2_sw(st[s5][1][2], st[s5][1][3]);
    int kb0 = 32 * (pair0 + s5);
#pragma unroll
    for (int et = 0; et < 4; ++et) {
      union { bf16x8 v; uint2 h[2]; } av;
      av.h[0] = *(const uint2*)(VT + (et * 16 + fr) * 264 + kb0 + fq * 4);
      av.h[1] = *(const uint2*)(VT + (et * 16 + fr) * 264 + kb0 + 16 + fq * 4);
      ot[et] = mfma16(av.v, pb.v, ot[et]);
    }
  }
  float inv = 1.f / den;
  int tokq = (nbi * 128 + qi) * d + r;
  if (!do_store) { if (inv == 123.456f) c.lse[0] = ot[0][0] + ot[1][1] + ot[2][2] + ot[3][3]; return; }
#pragma unroll
  for (int et = 0; et < 4; ++et) {
    uint2 o; o.x = pk2(ot[et][0] * inv, ot[et][1] * inv); o.y = pk2(ot[et][2] * inv, ot[et][3] * inv);
    *(uint2*)(pj + (size_t)tokq * NPROJ + OFF_AQ + g * 256 + h * 64 + et * 16 + fq * 4) = o;
  }
  if (fq == 0) c.lse[((size_t)bl * 4096 + tokq) * 12 + g * 4 + h] = mx + __logf(den);
}

typedef short v4i16_t __attribute__((ext_vector_type(4)));
DEVI uint2 lds_tr16(const u16* p) {
  return __builtin_bit_cast(uint2, __builtin_amdgcn_ds_read_tr16_b64_v4i16((__attribute__((address_space(3))) v4i16_t*)p));
}


DEVI void sb_wave_phase(const MixCtx& c, unsigned char* smem) {
  const int tid = otid(c.wv), w = tid >> 6, lane = tid & 63, fr = lane & 15, fq = lane >> 4;
  u16* Vs = (u16*)smem + w * (32 * 72);
  for (int wi = oblk() * 8 + w; wi < 4096; wi += ogrd() * 8) {
    const int qg = 255 - (wi & 255), h = (wi >> 8) & 3, bl = wi >> 10;
    const u16* pj = c.proj + (size_t)bl * 4096 * NPROJ;
    const int t0 = qg * 16, t = t0 + fr;
    bf16x8 qf[2];
#pragma unroll
    for (int ks = 0; ks < 2; ++ks) qf[ks] = *(const bf16x8*)(pj + (size_t)t * NPROJ + OFF_DQ + h * 64 + ks * 32 + fq * 8);
    float carry = 0.f;
    f32x4 ot[4];
#pragma unroll
    for (int et = 0; et < 4; ++et) ot[et] = (f32x4){0.f, 0.f, 0.f, 0.f};
    const int s0 = (t0 + 14) >> 5;
    bf16x8 kn00, kn01, kn10, kn11; uint4 vn0, vn1, vn2, vn3;
    {
      const u16* kp = pj + (size_t)(s0 * 32 + fr) * NPROJ + OFF_DK + h * 64 + fq * 8;
      kn00 = *(const bf16x8*)(kp); kn01 = *(const bf16x8*)(kp + 32);
      kn10 = *(const bf16x8*)(kp + (size_t)16 * NPROJ); kn11 = *(const bf16x8*)(kp + (size_t)16 * NPROJ + 32);
      const u16* vp = pj + (size_t)(s0 * 32 + (lane >> 1)) * NPROJ + OFF_DV + h * 64 + (lane & 1) * 32;
      vn0 = *(const uint4*)(vp); vn1 = *(const uint4*)(vp + 8); vn2 = *(const uint4*)(vp + 16); vn3 = *(const uint4*)(vp + 24);
    }
    for (int step = s0; step >= 0; --step) {
      const bf16x8 kf00 = kn00, kf01 = kn01, kf10 = kn10, kf11 = kn11;
      {
        u16* vd = Vs + (lane >> 1) * 72 + (lane & 1) * 32;
        *(uint4*)(vd) = vn0; *(uint4*)(vd + 8) = vn1; *(uint4*)(vd + 16) = vn2; *(uint4*)(vd + 24) = vn3;
      }
      if (step > 0) {
        const u16* kp = pj + (size_t)((step - 1) * 32 + fr) * NPROJ + OFF_DK + h * 64 + fq * 8;
        kn00 = *(const bf16x8*)(kp); kn01 = *(const bf16x8*)(kp + 32);
        kn10 = *(const bf16x8*)(kp + (size_t)16 * NPROJ); kn11 = *(const bf16x8*)(kp + (size_t)16 * NPROJ + 32);
        const u16* vp = pj + (size_t)((step - 1) * 32 + (lane >> 1)) * NPROJ + OFF_DV + h * 64 + (lane & 1) * 32;
        vn0 = *(const uint4*)(vp); vn1 = *(const uint4*)(vp + 8); vn2 = *(const uint4*)(vp + 16); vn3 = *(const uint4*)(vp + 24);
      }
      f32x4 z[2];
      z[0] = mfma16(kf01, qf[1], mfma16(kf00, qf[0], (f32x4){0.f, 0.f, 0.f, 0.f}));
      z[1] = mfma16(kf11, qf[1], mfma16(kf10, qf[0], (f32x4){0.f, 0.f, 0.f, 0.f}));
      float ls[2][4], lk[2][4], L[2];
#pragma unroll
      for (int sub = 0; sub < 2; ++sub) {
        L[sub] = 0.f;
#pragma unroll
        for (int j = 0; j < 4; ++j) {
          int key = step * 32 + 16 * sub + 4 * fq + j;
          float zz = z[sub][j] * (0.125f * 1.44269504f);
          float l_ = fminf(zz, 0.f) - __log2f(1.f + __builtin_amdgcn_exp2f(-fabsf(zz)));
          bool m = key < t;
          ls[sub][j] = m ? l_ : -3.0e38f;
          lk[sub][j] = m ? (l_ - zz) : 0.f;
          L[sub] += lk[sub][j];
        }
      }
      float a0[4], a1[4];
#pragma unroll
      for (int gq = 0; gq < 4; ++gq) { a0[gq] = shfl_l(L[0], fr + 16 * gq); a1[gq] = shfl_l(L[1], fr + 16 * gq); }
      float tot0 = a0[0] + a0[1] + a0[2] + a0[3], tot1 = a1[0] + a1[1] + a1[2] + a1[3];
      float suf0 = 0.f, suf1 = 0.f;
#pragma unroll
      for (int gq = 1; gq < 4; ++gq) { if (gq > fq) { suf0 += a0[gq]; suf1 += a1[gq]; } }
      float base[2]; base[1] = carry + suf1; base[0] = carry + tot1 + suf0;
      float wv[2][4];
#pragma unroll
      for (int sub = 0; sub < 2; ++sub) {
        float run = base[sub];
#pragma unroll
        for (int j = 3; j >= 0; --j) {
          float e = ls[sub][j] + run;
          wv[sub][j] = (ls[sub][j] > -1.0e38f) ? __builtin_amdgcn_exp2f(e) : 0.f;
          run += lk[sub][j];
        }
      }
      carry += tot0 + tot1;
      union { bf16x8 v; unsigned u[4]; } pb;
      pb.u[0] = pk2_sw(wv[0][0], wv[0][1]); pb.u[1] = pk2_sw(wv[0][2], wv[0][3]); pb.u[2] = pk2_sw(wv[1][0], wv[1][1]); pb.u[3] = pk2_sw(wv[1][2], wv[1][3]);
      const u16* vb = Vs + (fq * 4 + (fr >> 2)) * 72 + 4 * (fr & 3);
#pragma unroll
      for (int et = 0; et < 4; ++et) {
        union { bf16x8 v; uint2 h[2]; } av;
        av.h[0] = lds_tr16(vb + et * 16);
        av.h[1] = lds_tr16(vb + 16 * 72 + et * 16);
        ot[et] = mfma16(av.v, pb.v, ot[et]);
      }
      if (__all(carry < -150.04f)) break;
    }
    u16* brp = c.br + ((size_t)bl * 4096 + t) * BRW + 1024 + h * 64;
    float one = 1.f; asm volatile("" : "+v"(one));
#pragma unroll
    for (int et = 0; et < 4; ++et) {
      uint2 o; o.x = pk2(ot[et][0] * one, ot[et][1] * one); o.y = pk2(ot[et][2] * one, ot[et][3] * one);
      *(uint2*)(brp + et * 16 + fq * 4) = o;
    }
  }
}

struct DswaIt { int bl, g, h, d, r, nbi; };
DEVI DswaIt dswa_decode(int item) {
  DswaIt q; int blk = item & 31; q.h = (item >> 5) & 3; int gb = item >> 7; q.g = gb % 3; q.bl = gb / 3;
  q.d = (q.g == 0) ? 1 : (q.g == 1 ? 4 : 16); int nbr = 32 / q.d; q.r = blk / nbr; q.nbi = blk % nbr; return q;
}
#define DSWA_RAW_LOAD(ITEM)                                                                                          \
  {                                                                                                                    \
    const DswaIt q_ = dswa_decode(ITEM);                                                                               \
    const u16* pj_ = c.proj + (size_t)q_.bl * 4096 * NPROJ + q_.g * 256 + q_.h * 64 + (tid & 7) * 8;                    \
    _Pragma("unroll") for (int i_ = 0; i_ < 2; ++i_) {                                                                 \
      int row_ = (tid + 512 * i_) >> 3, tok_ = (q_.nbi * 128 + row_) * q_.d + q_.r;                                    \
      rq[i_] = *(const uint4*)(pj_ + (size_t)tok_ * NPROJ + OFF_AQ); }                                                 \
    _Pragma("unroll") for (int i_ = 0; i_ < 4; ++i_) {                                                                 \
      int row_ = (tid + 512 * i_) >> 3, sub_ = (q_.nbi - 1) * 128 + row_; bool ok_ = sub_ >= 0;                        \
      int tok_ = ok_ ? sub_ * q_.d + q_.r : 0;                                                                         \
      rk[i_] = *(const uint4*)(pj_ + (size_t)tok_ * NPROJ + OFF_AK); rv[i_] = *(const uint4*)(pj_ + (size_t)tok_ * NPROJ + OFF_AV); \
      if (!ok_) { rk[i_] = make_uint4(0, 0, 0, 0); rv[i_] = rk[i_]; } }                                                \
  }

DEVI void dswa_block_phase(const MixCtx& c, unsigned char* smem) {
  const int tid = otid(c.wv), w = tid >> 6, lane = tid & 63, fr = lane & 15, fq = lane >> 4, ch = tid & 7;
  u16* Qs = (u16*)smem; u16* Ks = Qs + 128 * 72; u16* Vs = Ks + 256 * 72;
  const float* qgp = KP(q_gain) + c.l * 64 + ch * 8; const float* kgp = KP(k_gain) + c.l * 64 + ch * 8;
  float qg[8], kg[8];
#pragma unroll
  for (int j = 0; j < 8; ++j) { qg[j] = qgp[j]; kg[j] = kgp[j]; }
  const int G = ogrd();
  int it = oblk();
  uint4 rq[2], rk[4], rv[4];
  if (it < 1536) DSWA_RAW_LOAD(it)
  for (; it < 1536; it += G) {
    const DswaIt q = dswa_decode(it);
#pragma unroll
    for (int i = 0; i < 2; ++i) {
      int row = (tid + 512 * i) >> 3;
      float v[8]; unpack8(rq[i], v);
      float ss = 0.f;
#pragma unroll
      for (int j = 0; j < 8; ++j) ss += v[j] * v[j];
      ss += shfl_xor_l(ss, 1, lane); ss += shfl_xor_l(ss, 2, lane); ss += shfl_xor_l(ss, 4, lane);
      float sc = rsqrtf(ss * (1.f / 64.f) + EPS);
      uint4 o; o.x = pk2(v[0] * sc * qg[0], v[1] * sc * qg[1]); o.y = pk2(v[2] * sc * qg[2], v[3] * sc * qg[3]);
      o.z = pk2(v[4] * sc * qg[4], v[5] * sc * qg[5]); o.w = pk2(v[6] * sc * qg[6], v[7] * sc * qg[7]);
      *(uint4*)(Qs + row * 72 + ch * 8) = o;
    }
#pragma unroll
    for (int i = 0; i < 4; ++i) {
      int row = (tid + 512 * i) >> 3;
      float v[8]; unpack8(rk[i], v);
      float ss = 0.f;
#pragma unroll
      for (int j = 0; j < 8; ++j) ss += v[j] * v[j];
      ss += shfl_xor_l(ss, 1, lane); ss += shfl_xor_l(ss, 2, lane); ss += shfl_xor_l(ss, 4, lane);
      float sc = rsqrtf(ss * (1.f / 64.f) + EPS);
      uint4 o; o.x = pk2(v[0] * sc * kg[0], v[1] * sc * kg[1]); o.y = pk2(v[2] * sc * kg[2], v[3] * sc * kg[3]);
      o.z = pk2(v[4] * sc * kg[4], v[5] * sc * kg[5]); o.w = pk2(v[6] * sc * kg[6], v[7] * sc * kg[7]);
      *(uint4*)(Ks + row * 72 + ch * 8) = o;
      *(uint4*)(Vs + row * 72 + ch * 8) = rv[i];
    }
    __syncthreads();
    if (it + G < 1536) DSWA_RAW_LOAD(it + G)
    bf16x8 qf[2];
#pragma unroll
    for (int ks = 0; ks < 2; ++ks) qf[ks] = *(const bf16x8*)(Qs + (16 * w + fr) * 72 + ks * 32 + fq * 8);
    const int pair0 = w >> 1;
    f32x4 st[5][2];
#pragma unroll
    for (int s5 = 0; s5 < 5; ++s5)
#pragma unroll
      for (int sub = 0; sub < 2; ++sub) {
        f32x4 a = {0.f, 0.f, 0.f, 0.f};
        int kb = 32 * (pair0 + s5) + 16 * sub;
        if (!(q.nbi == 0 && kb + 16 <= 128)) {
#pragma unroll
          for (int ks = 0; ks < 2; ++ks) a = mfma16(*(const bf16x8*)(Ks + (kb + fr) * 72 + ks * 32 + fq * 8), qf[ks], a);
        }
        st[s5][sub] = a;
      }
    const float slope_d = exp2f(-8.f * (float)(q.g * 4 + q.h + 1) / 12.f) * (float)q.d * 1.44269504f;
    int qi = 16 * w + fr;
    asm volatile("" : "+v"(qi));
    float mx = -3.0e38f;
#pragma unroll
    for (int s5 = 0; s5 < 5; ++s5)
#pragma unroll
      for (int sub = 0; sub < 2; ++sub)
#pragma unroll
        for (int j = 0; j < 4; ++j) {
          int kb = 32 * (pair0 + s5) + 16 * sub + 4 * fq + j, rel = 128 + qi - kb;
          bool ok = (rel >= 0) && (rel <= 128) && (q.nbi > 0 || kb >= 128);
          float sv = st[s5][sub][j] * (0.125f * 1.44269504f) - slope_d * (float)rel;
          sv = ok ? sv : -3.0e38f;
          st[s5][sub][j] = sv; mx = fmaxf(mx, sv);
        }
    mx = fmaxf(mx, shfl_xor_l(mx, 16, lane)); mx = fmaxf(mx, shfl_xor_l(mx, 32, lane));
    float den = 0.f;
#pragma unroll
    for (int s5 = 0; s5 < 5; ++s5)
#pragma unroll
      for (int sub = 0; sub < 2; ++sub)
#pragma unroll
        for (int j = 0; j < 4; ++j) {
          float sv = st[s5][sub][j];
          float pv = (sv > -1.0e38f) ? __builtin_amdgcn_exp2f(sv - mx) : 0.f;
          st[s5][sub][j] = pv; den += pv;
        }
    den += shfl_xor_l(den, 16, lane); den += shfl_xor_l(den, 32, lane);
    f32x4 ot[4];
#pragma unroll
    for (int et = 0; et < 4; ++et) ot[et] = (f32x4){0.f, 0.f, 0.f, 0.f};
#pragma unroll
    for (int s5 = 0; s5 < 5; ++s5) {
      u32x4_t pbu = {pk2_sw(st[s5][0][0], st[s5][0][1]), pk2_sw(st[s5][0][2], st[s5][0][3]), pk2_sw(st[s5][1][0], st[s5][1][1]), pk2_sw(st[s5][1][2], st[s5][1][3])};
      const bf16x8 pb = __builtin_bit_cast(bf16x8, pbu);
      const u16* vb = Vs + (32 * (pair0 + s5) + fq * 4 + (fr >> 2)) * 72 + 4 * (fr & 3);
      if (!(q.nbi == 0 && 32 * (pair0 + s5) + 32 <= 128)) {
#pragma unroll
        for (int et = 0; et < 4; ++et) ot[et] = mfma16(mk8(lds_tr16(vb + et * 16), lds_tr16(vb + 16 * 72 + et * 16)), pb, ot[et]);
      }
    }
    const float inv = 1.f / den;
    const int tokq = (q.nbi * 128 + qi) * q.d + q.r;
    u16* pj = c.proj + (size_t)q.bl * 4096 * NPROJ;
#pragma unroll
    for (int et = 0; et < 4; ++et) {
      uint2 o; o.x = pk2(ot[et][0] * inv, ot[et][1] * inv); o.y = pk2(ot[et][2] * inv, ot[et][3] * inv);
      *(uint2*)(pj + (size_t)tokq * NPROJ + OFF_AQ + q.g * 256 + q.h * 64 + et * 16 + fq * 4) = o;
    }
    if (fq == 0) c.lse[((size_t)q.bl * 4096 + tokq) * 12 + q.g * 4 + q.h] = (mx + __log2f(den)) * 0.69314718f;
    __syncthreads();
  }
}
#undef DSWA_RAW_LOAD

DEVI void dswa_wave_phase(const MixCtx& c, unsigned char* smem) {
  const int tid = otid(c.wv), w = tid >> 6, lane = tid & 63, fr = lane & 15, fq = lane >> 4;
  u16* Vs = (u16*)smem + w * (32 * 72);
  const float* qgp = KP(q_gain) + c.l * 64; const float* kgp = KP(k_gain) + c.l * 64;
  float qg[16], kg[16];
#pragma unroll
  for (int ks = 0; ks < 2; ++ks)
#pragma unroll
    for (int j = 0; j < 8; ++j) { qg[ks * 8 + j] = qgp[ks * 32 + fq * 8 + j]; kg[ks * 8 + j] = kgp[ks * 32 + fq * 8 + j]; }
  for (int wi = oblk() * 8 + w; wi < 12288; wi += ogrd() * 8) {
    const int wq = wi & 7, blk = (wi >> 3) & 31, h = (wi >> 8) & 3, gb = wi >> 10, g = gb % 3, bl = gb / 3;
    const int d = (g == 0) ? 1 : (g == 1 ? 4 : 16), nbr = 32 / d, r = blk / nbr, nbi = blk % nbr;
    u16* pj = c.proj + (size_t)bl * 4096 * NPROJ;
    const int qi = 16 * wq + fr, tokq = (nbi * 128 + qi) * d + r;
    const int colq = OFF_AQ + g * 256 + h * 64, colk = OFF_AK + g * 256 + h * 64, colv = OFF_AV + g * 256 + h * 64;
    bf16x8 qf0, qf1;
    {
      uint4 r0 = *(const uint4*)(pj + (size_t)tokq * NPROJ + colq + fq * 8), r1 = *(const uint4*)(pj + (size_t)tokq * NPROJ + colq + 32 + fq * 8);
      float a[8], b[8]; unpack8(r0, a); unpack8(r1, b);
      float ss = 0.f;
#pragma unroll
      for (int j = 0; j < 8; ++j) ss += a[j] * a[j] + b[j] * b[j];
      ss += shfl_xor_l(ss, 16, lane); ss += shfl_xor_l(ss, 32, lane);
      float sc = rsqrtf(ss * (1.f / 64.f) + EPS);
      u32x4_t p0 = {pk2(a[0] * sc * qg[0], a[1] * sc * qg[1]), pk2(a[2] * sc * qg[2], a[3] * sc * qg[3]), pk2(a[4] * sc * qg[4], a[5] * sc * qg[5]), pk2(a[6] * sc * qg[6], a[7] * sc * qg[7])};
      u32x4_t p1 = {pk2(b[0] * sc * qg[8], b[1] * sc * qg[9]), pk2(b[2] * sc * qg[10], b[3] * sc * qg[11]), pk2(b[4] * sc * qg[12], b[5] * sc * qg[13]), pk2(b[6] * sc * qg[14], b[7] * sc * qg[15])};
      qf0 = __builtin_bit_cast(bf16x8, p0); qf1 = __builtin_bit_cast(bf16x8, p1);
    }
    const int pair0 = wq >> 1, sub0 = (nbi - 1) * 128;
    const float slope_d = exp2f(-8.f * (float)(g * 4 + h + 1) / 12.f) * (float)d;
    uint4 kn00, kn01, kn10, kn11, vn0, vn1, vn2, vn3;
#define DSWA_LOAD(P)                                                                                              \
    {                                                                                                               \
      const int kbA = 32 * (pair0 + (P)) + fr, sA = sub0 + kbA, sB = sA + 16;                                        \
      const u16* pa = pj + (size_t)((sA >= 0 ? sA : 0) * d + r) * NPROJ + colk + fq * 8;                             \
      const u16* pb_ = pj + (size_t)((sB >= 0 ? sB : 0) * d + r) * NPROJ + colk + fq * 8;                            \
      kn00 = *(const uint4*)(pa); kn01 = *(const uint4*)(pa + 32); kn10 = *(const uint4*)(pb_); kn11 = *(const uint4*)(pb_ + 32); \
      if (sA < 0) { kn00 = make_uint4(0, 0, 0, 0); kn01 = kn00; }                                                    \
      if (sB < 0) { kn10 = make_uint4(0, 0, 0, 0); kn11 = kn10; }                                                    \
      const int sV = sub0 + 32 * (pair0 + (P)) + (lane >> 1);                                                        \
      const u16* pv = pj + (size_t)((sV >= 0 ? sV : 0) * d + r) * NPROJ + colv + (lane & 1) * 32;                    \
      vn0 = *(const uint4*)(pv); vn1 = *(const uint4*)(pv + 8); vn2 = *(const uint4*)(pv + 16); vn3 = *(const uint4*)(pv + 24); \
      if (sV < 0) { vn0 = make_uint4(0, 0, 0, 0); vn1 = vn0; vn2 = vn0; vn3 = vn0; }                                 \
    }
    DSWA_LOAD(0)
    float mrun = -3.0e38f, den = 0.f;
    f32x4 ot[4];
#pragma unroll
    for (int et = 0; et < 4; ++et) ot[et] = (f32x4){0.f, 0.f, 0.f, 0.f};
    for (int p = 0; p < 5; ++p) {
      const uint4 k00 = kn00, k01 = kn01, k10 = kn10, k11 = kn11;
      {
        u16* vd = Vs + (lane >> 1) * 72 + (lane & 1) * 32;
        *(uint4*)(vd) = vn0; *(uint4*)(vd + 8) = vn1; *(uint4*)(vd + 16) = vn2; *(uint4*)(vd + 24) = vn3;
      }
      if (p < 4) DSWA_LOAD(p + 1)
      bf16x8 kf[2][2];
#pragma unroll
      for (int sub = 0; sub < 2; ++sub) {
        float a[8], b[8]; unpack8(sub ? k10 : k00, a); unpack8(sub ? k11 : k01, b);
        float ss = 0.f;
#pragma unroll
        for (int j = 0; j < 8; ++j) ss += a[j] * a[j] + b[j] * b[j];
        ss += shfl_xor_l(ss, 16, lane); ss += shfl_xor_l(ss, 32, lane);
        float sc = rsqrtf(ss * (1.f / 64.f) + EPS);
        u32x4_t p0 = {pk2(a[0] * sc * kg[0], a[1] * sc * kg[1]), pk2(a[2] * sc * kg[2], a[3] * sc * kg[3]), pk2(a[4] * sc * kg[4], a[5] * sc * kg[5]), pk2(a[6] * sc * kg[6], a[7] * sc * kg[7])};
        u32x4_t p1 = {pk2(b[0] * sc * kg[8], b[1] * sc * kg[9]), pk2(b[2] * sc * kg[10], b[3] * sc * kg[11]), pk2(b[4] * sc * kg[12], b[5] * sc * kg[13]), pk2(b[6] * sc * kg[14], b[7] * sc * kg[15])};
        kf[sub][0] = __builtin_bit_cast(bf16x8, p0); kf[sub][1] = __builtin_bit_cast(bf16x8, p1);
      }
      f32x4 z[2];
      z[0] = mfma16(kf[0][1], qf1, mfma16(kf[0][0], qf0, (f32x4){0.f, 0.f, 0.f, 0.f}));
      z[1] = mfma16(kf[1][1], qf1, mfma16(kf[1][0], qf0, (f32x4){0.f, 0.f, 0.f, 0.f}));
      float sv[2][4], mx = mrun;
#pragma unroll
      for (int sub = 0; sub < 2; ++sub)
#pragma unroll
        for (int j = 0; j < 4; ++j) {
          const int kb = 32 * (pair0 + p) + 16 * sub + 4 * fq + j, rel = 128 + qi - kb;
          const bool ok = (rel >= 0) && (rel <= 128) && (nbi > 0 || kb >= 128);
          float sc_ = z[sub][j] * 0.125f - slope_d * (float)rel;
          sc_ = ok ? sc_ : -3.0e38f;
          sv[sub][j] = sc_; mx = fmaxf(mx, sc_);
        }
      mx = fmaxf(mx, shfl_xor_l(mx, 16, lane)); mx = fmaxf(mx, shfl_xor_l(mx, 32, lane));
      const float alpha = __expf(mrun - mx);
      mrun = mx;
      float ps = 0.f;
#pragma unroll
      for (int sub = 0; sub < 2; ++sub)
#pragma unroll
        for (int j = 0; j < 4; ++j) { float pv = (sv[sub][j] > -1.0e38f) ? __expf(sv[sub][j] - mx) : 0.f; sv[sub][j] = pv; ps += pv; }
      ps += shfl_xor_l(ps, 16, lane); ps += shfl_xor_l(ps, 32, lane);
      den = den * alpha + ps;
#pragma unroll
      for (int et = 0; et < 4; ++et) { ot[et][0] *= alpha; ot[et][1] *= alpha; ot[et][2] *= alpha; ot[et][3] *= alpha; }
      u32x4_t pbu = {pk2_sw(sv[0][0], sv[0][1]), pk2_sw(sv[0][2], sv[0][3]), pk2_sw(sv[1][0], sv[1][1]), pk2_sw(sv[1][2], sv[1][3])};
      const bf16x8 pb = __builtin_bit_cast(bf16x8, pbu);
      const u16* vb = Vs + (fq * 4 + (fr >> 2)) * 72 + 4 * (fr & 3);
#pragma unroll
      for (int et = 0; et < 4; ++et) ot[et] = mfma16(mk8(lds_tr16(vb + et * 16), lds_tr16(vb + 16 * 72 + et * 16)), pb, ot[et]);
    }
#undef DSWA_LOAD
    const float inv = 1.f / den;
#pragma unroll
    for (int et = 0; et < 4; ++et) {
      uint2 o; o.x = pk2(ot[et][0] * inv, ot[et][1] * inv); o.y = pk2(ot[et][2] * inv, ot[et][3] * inv);
      *(uint2*)(pj + (size_t)tokq * NPROJ + colq + et * 16 + fq * 4) = o;
    }
    if (fq == 0) c.lse[((size_t)bl * 4096 + tokq) * 12 + g * 4 + h] = mrun + __logf(den);
  }
}

DEVI void conv_item(const MixCtx& c, int item, unsigned char* smem) {
  const int tid = otid(c.wv), w = tid >> 6, lane = tid & 63;
  int bl = item >> 7, t0 = (item & 127) * 32;
  float* ys = (float*)smem; float* cs = ys + 62 * 256;
  const u16* pj = c.proj + (size_t)bl * 4096 * NPROJ;
#pragma unroll
  for (int q = 0; q < 4; ++q) {
    int ci = tid + 512 * q;
    if (ci < 62 * 32) {
      int i = ci >> 5, c8 = (ci & 31) * 8, t = t0 - 30 + i;
      float y[8];
      if (t >= 0) {
        float a[8], g[8];
        unpack8(*(const uint4*)(pj + (size_t)t * NPROJ + OFF_CONV + c8), a);
        unpack8(*(const uint4*)(pj + (size_t)t * NPROJ + OFF_CONV + 256 + c8), g);
#pragma unroll
        for (int e = 0; e < 8; ++e) y[e] = a[e] * sigmoidf_(g[e]);
      } else {
#pragma unroll
        for (int e = 0; e < 8; ++e) y[e] = 0.f;
      }
      *(float4*)(ys + i * 256 + c8) = make_float4(y[0], y[1], y[2], y[3]);
      *(float4*)(ys + i * 256 + c8 + 4) = make_float4(y[4], y[5], y[6], y[7]);
    }
  }
  __syncthreads();
  {
    int ch = tid & 255, tg = tid >> 8;
    float wj[31];
    const float* cw = KP(conv_w) + (size_t)c.l * 31 * 256 + ch;
#pragma unroll
    for (int j = 0; j < 31; ++j) wj[j] = cw[j * 256];
    float bias = KP(conv_b)[c.l * 256 + ch];
    float acc[16];
#pragma unroll
    for (int tl = 0; tl < 16; ++tl) acc[tl] = bias;
#pragma unroll
    for (int i = 0; i < 46; ++i) {
      float v = ys[(tg * 16 + i) * 256 + ch];
#pragma unroll
      for (int tl = 0; tl < 16; ++tl) { const int d = i - tl, dc = d < 0 ? 0 : (d > 30 ? 30 : d); if (d >= 0 && d <= 30) acc[tl] += wj[dc] * v; }
    }
#pragma unroll
    for (int tl = 0; tl < 16; ++tl) cs[(tg * 16 + tl) * 256 + ch] = acc[tl];
  }
  __syncthreads();
  const float* lng = KP(conv_ln_g) + c.l * 256; const float* lnb = KP(conv_ln_b) + c.l * 256;
#pragma unroll
  for (int q = 0; q < 4; ++q) {
    int tok = w * 4 + q;
    float v[4], s = 0.f;
#pragma unroll
    for (int i = 0; i < 4; ++i) { v[i] = cs[tok * 256 + lane + 64 * i]; s += v[i]; }
#pragma unroll
    for (int o = 1; o < 64; o <<= 1) s += shfl_xor_l(s, o, lane);
    float mu = s * (1.f / 256.f), s2 = 0.f;
#pragma unroll
    for (int i = 0; i < 4; ++i) { v[i] -= mu; s2 += v[i] * v[i]; }
#pragma unroll
    for (int o = 1; o < 64; o <<= 1) s2 += shfl_xor_l(s2, o, lane);
    float rs = rsqrtf(s2 * (1.f / 256.f) + EPS);
    u16* o = c.br + ((size_t)bl * 4096 + t0 + tok) * BRW + 256;
#pragma unroll
    for (int i = 0; i < 4; ++i) {
      int ch = lane + 64 * i;
      float y = v[i] * rs * lng[ch] + lnb[ch];
      o[ch] = f2bf(y * sigmoidf_(y));
    }
  }
}

DEVI void gla_cum8(const float (&xg)[8], float* segtot, float (&cum)[8], int tid) {
  const int lane = tid & 63, w = tid >> 6, kc = tid & 7;
#pragma unroll
  for (int j = 0; j < 8; ++j) cum[j] = logsigf_(xg[j]) * (1.f / 16.f);
#pragma unroll
  for (int j = 0; j < 8; ++j) {
    float o = shfl_up_l(cum[j], 8, lane); if (lane >= 8) cum[j] += o;
    o = shfl_up_l(cum[j], 16, lane); if (lane >= 16) cum[j] += o;
    o = shfl_up_l(cum[j], 32, lane); if (lane >= 32) cum[j] += o;
  }
  if (lane >= 56) {
    *(float4*)(segtot + w * 64 + kc * 8) = make_float4(cum[0], cum[1], cum[2], cum[3]);
    *(float4*)(segtot + w * 64 + kc * 8 + 4) = make_float4(cum[4], cum[5], cum[6], cum[7]);
  }
  __syncthreads();
#pragma unroll
  for (int ww = 0; ww < 7; ++ww) {
    float4 a = *(const float4*)(segtot + ww * 64 + kc * 8), b = *(const float4*)(segtot + ww * 64 + kc * 8 + 4);
    if (ww < w) { cum[0] += a.x; cum[1] += a.y; cum[2] += a.z; cum[3] += a.w; cum[4] += b.x; cum[5] += b.y; cum[6] += b.z; cum[7] += b.w; }
  }
}

DEVI void gla_gate8(const float4 (&gl)[4], const float* wgS, const float* bgp, int kc, float (&xg)[8]) {
  const float g[16] = {gl[0].x, gl[0].y, gl[0].z, gl[0].w, gl[1].x, gl[1].y, gl[1].z, gl[1].w, gl[2].x, gl[2].y, gl[2].z, gl[2].w, gl[3].x, gl[3].y, gl[3].z, gl[3].w};
#pragma unroll
  for (int j = 0; j < 8; ++j) xg[j] = bgp[kc * 8 + j];
#pragma unroll
  for (int r = 0; r < 16; ++r) {
    float4 a = *(const float4*)(wgS + r * 64 + kc * 8), b = *(const float4*)(wgS + r * 64 + kc * 8 + 4);
    xg[0] += g[r] * a.x; xg[1] += g[r] * a.y; xg[2] += g[r] * a.z; xg[3] += g[r] * a.w;
    xg[4] += g[r] * b.x; xg[5] += g[r] * b.y; xg[6] += g[r] * b.z; xg[7] += g[r] * b.w;
  }
}

DEVI void gla_local_item(const MixCtx& c, int unit, unsigned char* smem) {
  const int tid = otid(c.wv), w = tid >> 6, lane = tid & 63, fr = lane & 15, fq = lane >> 4;
  int ch = unit & 63, h = (unit >> 6) & 3, bl = unit >> 8, tok0 = ch * 64;
  float* segtot = (float*)smem;
  u16* keS = (u16*)(smem + 2048);
  u16* vS = (u16*)(smem + 20480);
  const u16* pj = c.proj + (size_t)bl * 4096 * NPROJ;
  const float* bgp = KP(gla_b_gate) + c.l * 256 + h * 64;
  const int t = tid >> 3, kc = tid & 7;
  const float4* glp = (const float4*)(c.glow + ((size_t)bl * 4096 + tok0 + t) * 256 + h * 64 + kc * 8);
  const float4 xg0 = glp[0], xg1 = glp[1];
  uint4 kraw = *(const uint4*)(pj + (size_t)(tok0 + t) * NPROJ + OFF_CK + h * 64 + kc * 8);
  const uint4 vraw0 = *(const uint4*)(pj + (size_t)(tok0 + (tid >> 4)) * NPROJ + OFF_CV + h * 128 + (tid & 15) * 8);
  const uint4 vraw1 = *(const uint4*)(pj + (size_t)(tok0 + 32 + (tid >> 4)) * NPROJ + OFF_CV + h * 128 + (tid & 15) * 8);
  const float xg[8] = {xg0.x, xg0.y, xg0.z, xg0.w, xg1.x, xg1.y, xg1.z, xg1.w};
  float cum[8];
  gla_cum8(xg, segtot, cum, tid);
  {
    float last[8];
#pragma unroll
    for (int j = 0; j < 8; ++j) last[j] = 0.f;
#pragma unroll
    for (int ww = 0; ww < 8; ++ww) {
      float4 a = *(const float4*)(segtot + ww * 64 + kc * 8), b = *(const float4*)(segtot + ww * 64 + kc * 8 + 4);
      last[0] += a.x; last[1] += a.y; last[2] += a.z; last[3] += a.w; last[4] += b.x; last[5] += b.y; last[6] += b.z; last[7] += b.w;
    }
    float kv[8]; unpack8(kraw, kv);
    uint4 o;
    o.x = pk2(kv[0] * __expf(last[0] - cum[0]), kv[1] * __expf(last[1] - cum[1])); o.y = pk2(kv[2] * __expf(last[2] - cum[2]), kv[3] * __expf(last[3] - cum[3]));
    o.z = pk2(kv[4] * __expf(last[4] - cum[4]), kv[5] * __expf(last[5] - cum[5])); o.w = pk2(kv[6] * __expf(last[6] - cum[6]), kv[7] * __expf(last[7] - cum[7]));
    *(uint4*)(keS + t * 72 + kc * 8) = o;
    if (tid < 8) {
      float4 e0 = make_float4(__expf(last[0]), __expf(last[1]), __expf(last[2]), __expf(last[3])), e1 = make_float4(__expf(last[4]), __expf(last[5]), __expf(last[6]), __expf(last[7]));
      *(float4*)(c.gdec + (size_t)unit * 64 + kc * 8) = e0; *(float4*)(c.gdec + (size_t)unit * 64 + kc * 8 + 4) = e1;
    }
    *(uint4*)(vS + (tid >> 4) * 136 + (tid & 15) * 8) = vraw0;
    *(uint4*)(vS + (32 + (tid >> 4)) * 136 + (tid & 15) * 8) = vraw1;
  }
  __syncthreads();
  bf16x8 af[2];
#pragma unroll
  for (int ks = 0; ks < 2; ++ks) {
    const u16* vb = vS + (ks * 32 + fq * 8 + (fr >> 2)) * 136 + 16 * w + 4 * (fr & 3);
    af[ks] = mk8(lds_tr16(vb), lds_tr16(vb + 4 * 136));
  }
  float* S = c.S + (size_t)unit * 8192;
#pragma unroll
  for (int jt = 0; jt < 4; ++jt) {
    f32x4 a = {0.f, 0.f, 0.f, 0.f};
#pragma unroll
    for (int ks = 0; ks < 2; ++ks) {
      const u16* kb = keS + (ks * 32 + fq * 8 + (fr >> 2)) * 72 + 16 * jt + 4 * (fr & 3);
      a = mfma16(af[ks], mk8(lds_tr16(kb), lds_tr16(kb + 4 * 72)), a);
    }
#pragma unroll
    for (int j = 0; j < 4; ++j) S[(16 * w + fq * 4 + j) * 64 + 16 * jt + fr] = a[j];
  }
}

DEVI void gla_scan_phase(const MixCtx& c) {
  long gtid = (long)oblk() * 512 + otid(c.wv), gsz = (long)ogrd() * 512;
  for (long idx = gtid; idx < 16L * 8192; idx += gsz) {
    int bh = (int)(idx >> 13), e = (int)(idx & 8191), k = e & 63;
    float* __restrict__ S = c.S + (size_t)bh * 64 * 8192 + e;
    const float* __restrict__ gd = c.gdec + (size_t)bh * 64 * 64 + k;
    float run = 0.f;
    for (int c0 = 0; c0 < 64; c0 += 32) {
      float loc[32], g[32];
#pragma unroll
      for (int i = 0; i < 32; ++i) { loc[i] = S[(size_t)(c0 + i) * 8192]; g[i] = gd[(c0 + i) * 64]; }
#pragma unroll
      for (int i = 0; i < 32; ++i) { S[(size_t)(c0 + i) * 8192] = run; run = g[i] * run + loc[i]; }
    }
  }
}

DEVI void gla_tok0_partials(const MixCtx& c) {
  const int tid = otid(c.wv), w = tid >> 6, lane = tid & 63;
  float* c0p = (float*)(KWS() + O_C0);
  for (int wi = oblk() * 8 + w; wi < 512; wi += ogrd() * 8) {
    int ks = wi & 15, qk = (wi >> 4) & 1, h = (wi >> 5) & 3, bl = wi >> 7, b = c.hf * 4 + bl;
    const float* xr = ((c.l == 0) ? KP(x) : (const float*)KOUT()) + (size_t)b * 4096 * 1024;
    const float* mf = (const float*)(KWS() + O_MODF) + ((size_t)c.l * 8 + b) * 6144;
    float ss = 0.f;
#pragma unroll
    for (int j = 0; j < 4; ++j) { float4 v = ((const float4*)xr)[lane + 64 * j]; ss += v.x * v.x + v.y * v.y + v.z * v.z + v.w * v.w; }
#pragma unroll
    for (int o = 1; o < 64; o <<= 1) ss += shfl_xor_l(ss, o, lane);
    float rs = rsqrtf(ss * (1.f / 1024.f) + EPS);
    int i0 = ks * 64 + lane;
    float h0 = xr[i0] * rs * mf[i0] + mf[1024 + i0];
    const float* wp = KP(w_in) + (size_t)c.l * 1024 * INW + (size_t)(ks * 64) * INW + (qk ? 3072 : 2816) + h * 64 + lane;
    float a = 0.f;
    float wrow[64];
#pragma unroll
    for (int i = 0; i < 64; ++i) wrow[i] = wp[(size_t)i * INW];
#pragma unroll
    for (int i = 0; i < 64; ++i) a += shfl_l(h0, i) * wrow[i];
    c0p[(size_t)wi * 64 + lane] = a;
  }
}

#define GLA_OUT_LOAD(U)                                                                                                  \
  {                                                                                                                        \
    const int ch_ = (U) & 63, h_ = ((U) >> 6) & 3, bl_ = (U) >> 8, tok0_ = ch_ * 64;                                        \
    const u16* pj_ = c.proj + (size_t)bl_ * 4096 * NPROJ;                                                                  \
    const u16* rowp_ = pj_ + (size_t)(tok0_ + t) * NPROJ + h_ * 64 + kc * 8;                                                \
    qraw = *(const uint4*)(rowp_ + OFF_CQ); kraw = *(const uint4*)(rowp_ + OFF_CK);                                         \
    const float4* glp_ = (const float4*)(c.glow + ((size_t)bl_ * 4096 + tok0_ + t) * 256 + h_ * 64 + kc * 8);               \
    xg0 = glp_[0]; xg1 = glp_[1];                                                                                          \
    vraw0 = *(const uint4*)(pj_ + (size_t)(tok0_ + (tid >> 4)) * NPROJ + OFF_CV + h_ * 128 + (tid & 15) * 8);               \
    vraw1 = *(const uint4*)(pj_ + (size_t)(tok0_ + 32 + (tid >> 4)) * NPROJ + OFF_CV + h_ * 128 + (tid & 15) * 8);          \
    rraw0 = *(const uint4*)(pj_ + (size_t)(tok0_ + t) * NPROJ + OFF_CR + h_ * 128 + kc * 16);                               \
    rraw1 = *(const uint4*)(pj_ + (size_t)(tok0_ + t) * NPROJ + OFF_CR + h_ * 128 + kc * 16 + 8);                           \
    const float4* Sg_ = (const float4*)(c.S + (size_t)(U) * 8192);                                                          \
    sraw0 = Sg_[tid]; sraw1 = Sg_[tid + 512]; sraw2 = Sg_[tid + 1024]; sraw3 = Sg_[tid + 1536];                             \
  }

DEVI void gla_out_phase(const MixCtx& c, unsigned char* smem) {
  const int tid = otid(c.wv), w = tid >> 6, lane = tid & 63, fr = lane & 15, fq = lane >> 4;
  float* segtot = (float*)smem;
  u16* qt = (u16*)(smem + 2048); u16* kt = (u16*)(smem + 11264); u16* vS = (u16*)(smem + 20480);
  u16* stT = (u16*)(smem + 37888); u16* att = (u16*)(smem + 56320); float* oS = (float*)(smem + 65536);
  const float* og = KP(gla_o_gain) + c.l * 128;
  const float* c0p = (const float*)(KWS() + O_C0);
  const int t = tid >> 3, kc = tid & 7;
  const int Gd = ogrd();
  uint4 qraw, kraw, vraw0, vraw1, rraw0, rraw1; float4 xg0, xg1, sraw0, sraw1, sraw2, sraw3;
  int unit = oblk();
  if (unit < 1024) GLA_OUT_LOAD(unit)
  for (; unit < 1024; unit += Gd) {
  const int ch = unit & 63, h = (unit >> 6) & 3, bl = unit >> 8, tok0 = ch * 64;
  const float xg[8] = {xg0.x, xg0.y, xg0.z, xg0.w, xg1.x, xg1.y, xg1.z, xg1.w};
  float cum[8];
  gla_cum8(xg, segtot, cum, tid);
  {
    float qv[8], kv[8]; unpack8(qraw, qv); unpack8(kraw, kv);
    float eq[8], ek[8];
#pragma unroll
    for (int j = 0; j < 8; ++j) { float e = __expf(cum[j]); eq[j] = qv[j] * 0.125f * e; ek[j] = kv[j] * __expf(-cum[j]); }
    uint4 o;
    o.x = pk2(eq[0], eq[1]); o.y = pk2(eq[2], eq[3]); o.z = pk2(eq[4], eq[5]); o.w = pk2(eq[6], eq[7]);
    *(uint4*)(qt + t * 72 + kc * 8) = o;
    o.x = pk2(ek[0], ek[1]); o.y = pk2(ek[2], ek[3]); o.z = pk2(ek[4], ek[5]); o.w = pk2(ek[6], ek[7]);
    *(uint4*)(kt + t * 72 + kc * 8) = o;
    *(uint4*)(vS + (tid >> 4) * 136 + (tid & 15) * 8) = vraw0;
    *(uint4*)(vS + (32 + (tid >> 4)) * 136 + (tid & 15) * 8) = vraw1;
    *(uint2*)(stT + (tid >> 4) * 72 + (tid & 15) * 4) = make_uint2(pk2(sraw0.x, sraw0.y), pk2(sraw0.z, sraw0.w));
    *(uint2*)(stT + (32 + (tid >> 4)) * 72 + (tid & 15) * 4) = make_uint2(pk2(sraw1.x, sraw1.y), pk2(sraw1.z, sraw1.w));
    *(uint2*)(stT + (64 + (tid >> 4)) * 72 + (tid & 15) * 4) = make_uint2(pk2(sraw2.x, sraw2.y), pk2(sraw2.z, sraw2.w));
    *(uint2*)(stT + (96 + (tid >> 4)) * 72 + (tid & 15) * 4) = make_uint2(pk2(sraw3.x, sraw3.y), pk2(sraw3.z, sraw3.w));
  }
  __syncthreads();
  const uint4 rc0 = rraw0, rc1 = rraw1;
  if (unit + Gd < 1024) GLA_OUT_LOAD(unit + Gd)
  {
    int it = w >> 1;
    bf16x8 af[2];
#pragma unroll
    for (int ks = 0; ks < 2; ++ks) af[ks] = *(const bf16x8*)(qt + (16 * it + fr) * 72 + ks * 32 + fq * 8);
#pragma unroll
    for (int jj = 0; jj < 2; ++jj) {
      int jt = 2 * (w & 1) + jj;
      f32x4 a = {0.f, 0.f, 0.f, 0.f};
#pragma unroll
      for (int ks = 0; ks < 2; ++ks) a = mfma16(af[ks], *(const bf16x8*)(kt + (16 * jt + fr) * 72 + ks * 32 + fq * 8), a);
#pragma unroll
      for (int j = 0; j < 4; ++j) { int tt = 16 * it + fq * 4 + j, ss = 16 * jt + fr; att[tt * 72 + ss] = f2bf(ss <= tt ? a[j] : 0.f); }
    }
  }
  __syncthreads();
  {
    int it = w >> 1;
    bf16x8 a1[2], a2[2];
#pragma unroll
    for (int ks = 0; ks < 2; ++ks) { a1[ks] = *(const bf16x8*)(att + (16 * it + fr) * 72 + ks * 32 + fq * 8); a2[ks] = *(const bf16x8*)(qt + (16 * it + fr) * 72 + ks * 32 + fq * 8); }
#pragma unroll
    for (int jj = 0; jj < 4; ++jj) {
      int jt = 4 * (w & 1) + jj;
      f32x4 a = {0.f, 0.f, 0.f, 0.f};
#pragma unroll
      for (int ks = 0; ks < 2; ++ks) {
        const u16* vb = vS + (ks * 32 + fq * 8 + (fr >> 2)) * 136 + 16 * jt + 4 * (fr & 3);
        a = mfma16(a1[ks], mk8(lds_tr16(vb), lds_tr16(vb + 4 * 136)), a);
        a = mfma16(a2[ks], *(const bf16x8*)(stT + (16 * jt + fr) * 72 + ks * 32 + fq * 8), a);
      }
#pragma unroll
      for (int j = 0; j < 4; ++j) oS[(16 * it + fq * 4 + j) * 132 + 16 * jt + fr] = a[j];
    }
  }
  __syncthreads();
  if (ch == 0) {
    const float* cp = c0p + (size_t)((bl * 4 + h) * 2) * 16 * 64;
    float qv = 0.f, kv = 0.f;
#pragma unroll
    for (int ks = 0; ks < 16; ++ks) { qv += cp[ks * 64 + lane]; kv += cp[1024 + ks * 64 + lane]; }
    float pr = qv * kv;
#pragma unroll
    for (int o = 1; o < 64; o <<= 1) pr += shfl_xor_l(pr, o, lane);
    if (tid < 128) oS[tid] = pr * 0.125f * bf2f(vS[tid]);
    __syncthreads();
  }
  {
    const float* ogp = og + kc * 16;
    float ov[16];
#pragma unroll
    for (int i = 0; i < 4; ++i) { float4 a = *(const float4*)(oS + t * 132 + kc * 16 + 4 * i); ov[4 * i] = a.x; ov[4 * i + 1] = a.y; ov[4 * i + 2] = a.z; ov[4 * i + 3] = a.w; }
    float ss = 0.f;
#pragma unroll
    for (int i = 0; i < 16; ++i) ss += ov[i] * ov[i];
    ss += shfl_xor_l(ss, 1, lane); ss += shfl_xor_l(ss, 2, lane); ss += shfl_xor_l(ss, 4, lane);
    float rs = rsqrtf(ss * (1.f / 128.f) + EPS);
    u16* op = c.br + ((size_t)bl * 4096 + tok0 + t) * BRW + 512 + h * 128 + kc * 16;
#pragma unroll
    for (int i = 0; i < 2; ++i) {
      float r[8]; unpack8(i ? rc1 : rc0, r);
      float y[8];
#pragma unroll
      for (int e = 0; e < 8; ++e) y[e] = ov[8 * i + e] * rs * ogp[8 * i + e] * r[e] * sigmoidf_(r[e]);
      uint4 o; o.x = pk2(y[0], y[1]); o.y = pk2(y[2], y[3]); o.z = pk2(y[4], y[5]); o.w = pk2(y[6], y[7]);
      *(uint4*)(op + 8 * i) = o;
    }
  }
  __syncthreads();
  }
}
#undef GLA_OUT_LOAD

DEVI void dswa_merge_phase(const MixCtx& c) {
  long gtid = (long)oblk() * 512 + otid(c.wv), gsz = (long)ogrd() * 512;
  for (long idx0 = gtid; idx0 < (long)MH * 32; idx0 += 2 * gsz) {
    float l0[2], l1[2], l2[2]; uint4 ra[2], rb[2], rd[2]; bool ok[2];
#pragma unroll
    for (int q = 0; q < 2; ++q) {
      const long idx = idx0 + q * gsz; ok[q] = idx < (long)MH * 32;
      const long ii = ok[q] ? idx : idx0;
      const long tok = ii >> 5; const int chunk = (int)(ii & 31), h = chunk >> 3, e0 = (chunk & 7) * 8;
      const float* ls = c.lse + tok * 12 + h;
      l0[q] = ls[0]; l1[q] = ls[4]; l2[q] = ls[8];
      const u16* pr = c.proj + tok * NPROJ + h * 64 + e0;
      ra[q] = *(const uint4*)(pr); rb[q] = *(const uint4*)(pr + 256); rd[q] = *(const uint4*)(pr + 512);
    }
#pragma unroll
    for (int q = 0; q < 2; ++q) {
      if (!ok[q]) continue;
      const long idx = idx0 + q * gsz;
      const long tok = idx >> 5; const int chunk = (int)(idx & 31), h = chunk >> 3, e0 = (chunk & 7) * 8;
      float m = fmaxf(l0[q], fmaxf(l1[q], l2[q]));
      float w0 = __expf(l0[q] - m), w1 = __expf(l1[q] - m), w2 = __expf(l2[q] - m), inv = 1.f / (w0 + w1 + w2);
      w0 *= inv; w1 *= inv; w2 *= inv;
      float a[8], b[8], d[8];
      unpack8(ra[q], a); unpack8(rb[q], b); unpack8(rd[q], d);
      uint4 o;
      o.x = pk2(w0 * a[0] + w1 * b[0] + w2 * d[0], w0 * a[1] + w1 * b[1] + w2 * d[1]);
      o.y = pk2(w0 * a[2] + w1 * b[2] + w2 * d[2], w0 * a[3] + w1 * b[3] + w2 * d[3]);
      o.z = pk2(w0 * a[4] + w1 * b[4] + w2 * d[4], w0 * a[5] + w1 * b[5] + w2 * d[5]);
      o.w = pk2(w0 * a[6] + w1 * b[6] + w2 * d[6], w0 * a[7] + w1 * b[7] + w2 * d[7]);
      *(uint4*)(c.br + tok * BRW + h * 64 + e0) = o;
    }
  }
}

#define XB_TMO      128
#define XB_XCNT(j)  (256  + 64 * (j))
#define XB_XSUB(j)  (1280 + 64 * (j))
#define XB_XGEN(j)  (2304 + 64 * (j))
#define XB_TOP      3328
#define XB_TOPGEN   3392
#define XCD_BAR_WORDS 3456
#define XB_SPIN_CAP (1u << 22)
#define LAS __attribute__((address_space(3)))
DEVI unsigned xb_ld(unsigned* p) { return __hip_atomic_load(p, __ATOMIC_RELAXED, __HIP_MEMORY_SCOPE_AGENT); }
DEVI unsigned xb_add(unsigned* p, unsigned v) { return __hip_atomic_fetch_add(p, v, __ATOMIC_RELAXED, __HIP_MEMORY_SCOPE_AGENT); }
DEVI unsigned xb_xcc_id() { return (unsigned)__builtin_amdgcn_s_getreg((3 << 11) | 20) & 0xFu; }
#define XB_SPIN(cond, bar) do { unsigned _sp = 0; while (cond) { __builtin_amdgcn_s_sleep(1); \
    if ((++_sp & 255u) == 0u) { if (xb_ld(&(bar)[XB_TMO])) break; if (_sp > XB_SPIN_CAP) { atomicAdd(&(bar)[XB_TMO], 1u); break; } } } } while (0)

DEVI void xb_complete(unsigned* bar, unsigned x, unsigned G, unsigned& nloc, unsigned& nx) {
  unsigned sum, cnt, mine, sp = 0u;
  for (;;) {
    sum = 0u; cnt = 0u; mine = 0u;
#pragma unroll
    for (unsigned j = 0; j < 16; ++j) { const unsigned cc = xb_ld(&bar[XB_XCNT(j)]); sum += cc; cnt += (cc > 0u) ? 1u : 0u; mine = (j == x) ? cc : mine; }
    if (sum == G) break;
    __builtin_amdgcn_s_sleep(1);
    if ((++sp & 255u) == 0u) { if (xb_ld(&bar[XB_TMO])) break; if (sp > XB_SPIN_CAP) { atomicAdd(&bar[XB_TMO], 1u); break; } }
  }
  nloc = mine > 0u ? mine : 1u; nx = cnt > 0u ? cnt : 1u;
}

DEVI void gbar1(int wv, unsigned& nbar, unsigned char* smem) {
  asm volatile("s_waitcnt vmcnt(0)" ::: "memory");
  __syncthreads();
  unsigned* bar = (unsigned*)(KWS() + O_BAR);
  const unsigned x = xb_xcc_id();
  if (otid(wv) == 0) {
    volatile LAS unsigned* st = (volatile LAS unsigned*)(smem + 131072);
    __builtin_amdgcn_s_waitcnt(0);
    unsigned nloc = st[0], nx = st[1];
    if (nloc == 0u) { xb_complete(bar, x, (unsigned)ogrd(), nloc, nx); st[0] = nloc; st[1] = nx; }
    const unsigned old = xb_add(&bar[XB_XSUB(x)], 1u);
    const unsigned gen = old / nloc;
    if (old + 1u == (gen + 1u) * nloc) {
      __builtin_amdgcn_fence(__ATOMIC_RELEASE, "agent");
      asm volatile("s_waitcnt vmcnt(0)" ::: "memory");
      const unsigned og = xb_add(&bar[XB_TOP], 1u);
      const unsigned tg = og / nx;
      if (og + 1u == (tg + 1u) * nx) xb_add(&bar[XB_TOPGEN], 1u);
      else XB_SPIN(xb_ld(&bar[XB_TOPGEN]) == tg, bar);
      __builtin_amdgcn_fence(__ATOMIC_ACQUIRE, "agent");
      xb_add(&bar[XB_XGEN(x)], 1u);
      asm volatile("s_waitcnt vmcnt(0)" ::: "memory");
    } else {
      XB_SPIN(xb_ld(&bar[XB_XGEN(x)]) == gen, bar);
      __builtin_amdgcn_fence(__ATOMIC_ACQUIRE, "agent");
      asm volatile("s_waitcnt vmcnt(0)" ::: "memory");
    }
  }
  __syncthreads();
}
DEVI void gbar(int wv, unsigned& nbar, unsigned char* smem) { PREP(7) gbar1(wv, nbar, smem); }

__global__ void __launch_bounds__(512) mega(Params p_unused) {
  extern __shared__ __attribute__((aligned(16))) unsigned char smem[];
  cg::grid_group grid = cg::this_grid();
  u16* shm = (u16*)smem;
  unsigned nbar = 0;
  const int wv = __builtin_amdgcn_readfirstlane((int)(threadIdx.x >> 6));
  {
    unsigned* bar0 = (unsigned*)(KWS() + O_BAR);
    const unsigned xcc0 = xb_xcc_id();
    if (otid(wv) == 0) {
      volatile LAS unsigned* st = (volatile LAS unsigned*)(smem + 131072);
      st[0] = 0u; st[1] = 0u;
      (void)xb_add(bar0 + XB_XCNT(xcc0), 1u);
    }
  }
  __syncthreads();

  PREP(0) prep_phase(wv, smem);
  grid.sync();
  PREP(0) modfinal_phase(wv);
  gbar(wv, nbar, smem);

  for (int l = 0; l < NL; ++l) {
    for (int hf = 0; hf < 2; ++hf) {
      const int row0 = hf * MH;
      const size_t o_h = (hf == 0) ? O_H : O_BR;
      if (hf == 0) {
        unsigned char* ws = KWS();
        const float* xin = (l == 0) ? KP(x) : (const float*)KOUT();
        PREP(1) norm_phase(wv, xin, row0, MH, (const float*)(ws + O_MODF) + (size_t)l * 8 * 6144, 0, (u16*)(ws + O_H));
        gbar(wv, nbar, smem);
      }
      {
        unsigned char* ws = KWS();
        EpiBf16 e; e.C = (u16*)(ws + O_PROJ); e.ldc = NPROJ; e.relu2 = 0;
        PREP(2) gemm_phase<1024>(wv, shm, (const u16*)(ws + o_h), (const u16*)(ws + O_WT) + (size_t)l * WT_L + WT_IN, MH, NPROJ, 1024, e);
        glow_phase(wv, l, (const u16*)(ws + o_h), (const u16*)(ws + O_WT) + (size_t)l * WT_L + WT_LOW, (float*)(ws + O_GLOW));
      }
      gbar(wv, nbar, smem);
      {
        MixCtx c = make_ctx(wv, l, hf);
        dswa_block_phase(c, smem);
        for (int it = oblk(); it < 1024 + 512; it += ogrd()) {
          if (it < 1024) gla_local_item(c, it, smem);
          else conv_item(c, it - 1024, smem);
          __syncthreads();
        }
        PREP(10) sb_wave_phase(c, smem);
        gla_tok0_partials(c);
      }
      gbar(wv, nbar, smem);
      { MixCtx c = make_ctx(wv, l, hf); gla_scan_phase(c); }
      gbar(wv, nbar, smem);
      {
        MixCtx c = make_ctx(wv, l, hf);
        PREP(4) { gla_out_phase(c, smem);
        dswa_merge_phase(c); }
      }
      gbar(wv, nbar, smem);
      {
        unsigned char* ws = KWS();
        PREP(5) branch_phase(wv, shm, (const u16*)(ws + O_BR), (const u16*)(ws + O_WT) + (size_t)l * WT_L + WT_BR, (const u16*)(ws + O_PROJ), (u16*)(ws + O_S));
      }
      gbar(wv, nbar, smem);
      {
        unsigned char* ws = KWS();
        EpiRes e; e.xin = (l == 0) ? KP(x) : (const float*)KOUT(); e.xout = KOUT(); e.gate = (const float*)(ws + O_MODF) + (size_t)l * 8 * 6144 + 2048; e.row0 = row0;
        gemm_phase<1024>(wv, shm, (const u16*)(ws + O_S), (const u16*)(ws + O_WT) + (size_t)l * WT_L + WT_OUT, MH, 1024, 1024, e);
        if (hf == 0) {
          const float* xin2 = (l == 0) ? KP(x) : (const float*)KOUT();
          norm_phase(wv, xin2, MH, MH, (const float*)(ws + O_MODF) + (size_t)l * 8 * 6144, 0, (u16*)(ws + O_BR));
        }
      }
      gbar(wv, nbar, smem);
    }
    {
      unsigned char* ws = KWS();
      PREP(1) norm_phase(wv, (const float*)KOUT(), 0, MTOK, (const float*)(ws + O_MODF) + (size_t)l * 8 * 6144, 3, (u16*)(ws + O_BR));
    }
    gbar(wv, nbar, smem);
    for (int hh = 0; hh < 2; ++hh) {
      {
        unsigned char* ws = KWS();
        EpiBf16 e; e.C = (u16*)(ws + O_PROJ) + (size_t)hh * MH * 4096; e.ldc = 4096; e.relu2 = 1;
        PREP(6) gemm_phase<1024>(wv, shm, (const u16*)(ws + O_BR) + (size_t)hh * MH * 1024, (const u16*)(ws + O_WT) + (size_t)l * WT_L + WT_UP, MH, 4096, 1024, e);
      }
      gbar(wv, nbar, smem);
      {
        unsigned char* ws = KWS();
        EpiRes e; e.xin = (const float*)KOUT(); e.xout = KOUT(); e.gate = (const float*)(ws + O_MODF) + (size_t)l * 8 * 6144 + 5120; e.row0 = hh * MH;
        gemm_phase<4096>(wv, shm, (const u16*)(ws + O_PROJ) + (size_t)hh * MH * 4096, (const u16*)(ws + O_WT) + (size_t)l * WT_L + WT_DOWN, MH, 1024, 4096, e);
      }
    }
    gbar(wv, nbar, smem);
  }
}

extern "C" void kernel_launch(void* const* d_in, const int* in_sizes, int n_in,
                              void* d_out, int out_size, void* d_ws, size_t ws_size,
                              hipStream_t stream) {
  static int grid_blocks = 0;
  if (!grid_blocks) {
    int dev = 0, cus = 0, per_cu = 0;
    (void)hipGetDevice(&dev);
    (void)hipDeviceGetAttribute(&cus, hipDeviceAttributeMultiprocessorCount, dev);
    (void)hipFuncSetAttribute((const void*)mega, hipFuncAttributeMaxDynamicSharedMemorySize, LDS_BYTES);
    (void)hipOccupancyMaxActiveBlocksPerMultiprocessor(&per_cu, (const void*)mega, 512, LDS_BYTES);
    if (per_cu < 1) per_cu = 1;
    grid_blocks = cus * 1;
    if (ws_size < WS_END) fprintf(stderr, "kernel_launch: workspace too small: %zu < %zu\n", ws_size, (size_t)WS_END);
  }
  (void)hipMemsetAsync((unsigned char*)d_ws + O_BAR, 0, 16384, stream);
  Params p{};
  const float** pp = (const float**)&p;
  for (int i = 0; i < 23; ++i) pp[i] = (const float*)d_in[i];
  p.out = (float*)d_out; p.ws = (unsigned char*)d_ws;
  void* args[] = {&p};
  hipError_t e = hipLaunchCooperativeKernel((void*)mega, dim3(grid_blocks), dim3(512), args, LDS_BYTES, stream);
  if (e != hipSuccess) fprintf(stderr, "cooperative launch failed: %s (grid %d)\n", hipGetErrorString(e), grid_blocks);
}
```
